# Optimizing an MI355X kernel written in HIP

```python
import jax, jax.numpy as jnp
from jax import lax
import numpy as np

D_MODEL = 2048
BATCH = 2
SEQ = 4096
DEPTH = 1

D_MIX = D_MODEL
D_CONV = D_MIX // 2
N_CONV_GROUPS = 8
CONV_WIDTH = 3
D_SGU = D_MIX - D_CONV
N_SGU_HEADS = 8
SGU_HEAD_DIM = D_SGU // N_SGU_HEADS
CHUNK = 128
D_IN_PROJ = 3 * D_CONV + 2 * D_SGU

N_EXPERTS = 32
TOP_K = 4
D_FF = D_MODEL
SWIGLU_LIMIT = 7.0
SWIGLU_ALPHA = 1.702
EXPERT_BLOCK = 128

RMS_EPS = 1e-5
LN_EPS = 1e-5

kernel_name = "hybrid_shortconv_sgu_moe_block"


def rms_norm(x, g):
    xf = x.astype(jnp.float32)
    y = xf * lax.rsqrt(jnp.mean(xf * xf, axis=-1, keepdims=True) + RMS_EPS)
    return (y * g.astype(jnp.float32)).astype(x.dtype)


def group_rms_norm(x, g, n_groups):
    shp = x.shape
    xf = x.astype(jnp.float32).reshape(shp[:-1] + (n_groups, shp[-1] // n_groups))
    y = xf * lax.rsqrt(jnp.mean(xf * xf, axis=-1, keepdims=True) + RMS_EPS)
    return (y.reshape(shp) * g.astype(jnp.float32)).astype(x.dtype)


def group_layer_norm(x, g, b, n_groups):
    shp = x.shape
    xf = x.astype(jnp.float32).reshape(shp[:-1] + (n_groups, shp[-1] // n_groups))
    mu = jnp.mean(xf, axis=-1, keepdims=True)
    xc = xf - mu
    y = xc * lax.rsqrt(jnp.mean(xc * xc, axis=-1, keepdims=True) + LN_EPS)
    return (y.reshape(shp) * g.astype(jnp.float32) + b.astype(jnp.float32)).astype(x.dtype)


def causal_dwconv(z, w):
    s = z.shape[1]
    zp = jnp.pad(z, ((0, 0), (CONV_WIDTH - 1, 0), (0, 0)))
    return sum(zp[:, k:k + s, :] * w[k] for k in range(CONV_WIDTH))


def spatial_gating(u, v, sgu_ln_g, sgu_ln_b, sgu_w, sgu_b):
    bsz, s, _ = v.shape
    n_chunks = s // CHUNK
    vn = group_layer_norm(v, sgu_ln_g, sgu_ln_b, N_SGU_HEADS)
    vc = vn.reshape(bsz, n_chunks, CHUNK, N_SGU_HEADS, SGU_HEAD_DIM)
    causal = jnp.tril(jnp.ones((CHUNK, CHUNK), dtype=bool))
    w_masked = jnp.where(causal[None], sgu_w, jnp.zeros_like(sgu_w))
    mixed = jnp.einsum('hts,bcshd->bcthd', w_masked, vc)
    mixed = mixed + jnp.transpose(sgu_b)[None, None, :, :, None]
    return u * mixed.reshape(bsz, s, D_SGU)


def hybrid_mixer(xn, w_in, conv_w, sgu_ln_g, sgu_ln_b, sgu_w, sgu_b, gn_conv, gn_sgu, w_out):
    proj = jnp.einsum('bsd,de->bse', xn, w_in)
    b_gate, c_gate, h, u, v = jnp.split(
        proj, [D_CONV, 2 * D_CONV, 3 * D_CONV, 3 * D_CONV + D_SGU], axis=-1)
    y_conv = b_gate * causal_dwconv(c_gate * h, conv_w)
    y_sgu = spatial_gating(jax.nn.gelu(u, approximate=False),
                           jax.nn.gelu(v, approximate=False),
                           sgu_ln_g, sgu_ln_b, sgu_w, sgu_b)
    y = jnp.concatenate([group_rms_norm(y_conv, gn_conv, N_CONV_GROUPS),
                         group_rms_norm(y_sgu, gn_sgu, N_SGU_HEADS)], axis=-1)
    return jnp.einsum('bse,ed->bsd', y, w_out)


def moe_ffn(xn, w_router, b_router, w_gate_up, b_gate_up, w_down, b_down):
    bsz, s, d = xn.shape
    n_tok = bsz * s
    xt = xn.reshape(n_tok, d)
    logits = (xt @ w_router + b_router).astype(jnp.float32)
    top_vals, top_idx = lax.top_k(logits, TOP_K)
    gates = jax.nn.softmax(top_vals, axis=-1).astype(xn.dtype)

    m = n_tok * TOP_K
    flat_e = top_idx.reshape(m).astype(jnp.int32)
    flat_tok = jnp.repeat(jnp.arange(n_tok, dtype=jnp.int32), TOP_K)
    flat_g = gates.reshape(m)
    order = jnp.argsort(flat_e, stable=True)
    sorted_e = flat_e[order]
    sorted_tok = flat_tok[order]
    sorted_g = flat_g[order]
    sizes = jnp.bincount(flat_e, length=N_EXPERTS).astype(jnp.int32)
    padded = ((sizes + EXPERT_BLOCK - 1) // EXPERT_BLOCK) * EXPERT_BLOCK
    starts = jnp.cumsum(sizes) - sizes
    padded_ends = jnp.cumsum(padded)
    padded_starts = padded_ends - padded
    dest = padded_starts[sorted_e] + jnp.arange(m, dtype=jnp.int32) - starts[sorted_e]
    n_blocks = -(-(m + N_EXPERTS * EXPERT_BLOCK) // EXPERT_BLOCK)
    p_rows = n_blocks * EXPERT_BLOCK
    buf_tok = jnp.full((p_rows,), n_tok, dtype=jnp.int32).at[dest].set(sorted_tok)
    buf_g = jnp.zeros((p_rows,), dtype=xn.dtype).at[dest].set(sorted_g)
    block_start = jnp.arange(n_blocks, dtype=jnp.int32) * EXPERT_BLOCK
    block_expert = jnp.minimum(
        jnp.searchsorted(padded_ends, block_start, side='right'), N_EXPERTS - 1).astype(jnp.int32)
    x_pad = jnp.concatenate([xt, jnp.zeros((1, d), dtype=xt.dtype)], axis=0)
    buf_x = x_pad[buf_tok].reshape(n_blocks, EXPERT_BLOCK, d)

    def expert_block(args):
        xb, e = args
        gu = xb @ w_gate_up[e] + b_gate_up[e]
        gate, up = jnp.split(gu, 2, axis=-1)
        gate = jnp.minimum(gate, SWIGLU_LIMIT)
        up = jnp.clip(up, -SWIGLU_LIMIT, SWIGLU_LIMIT)
        glu = gate * jax.nn.sigmoid(gate * SWIGLU_ALPHA)
        return ((up + 1.0) * glu) @ w_down[e] + b_down[e]

    out = lax.map(expert_block, (buf_x, block_expert)).reshape(p_rows, d)
    out = out * buf_g[:, None]
    y = jax.ops.segment_sum(out, buf_tok, num_segments=n_tok + 1)[:n_tok]
    return y.reshape(bsz, s, d)


def setup_inputs(seed: int = 0) -> dict:
    key = jax.random.key(seed)
    ks = jax.random.split(key, 20)
    f32 = jnp.float32

    def nrm(k, shape, scale):
        return jax.random.normal(k, shape, dtype=f32) * scale

    def gain(k, n):
        return 1.0 + 0.02 * jax.random.normal(k, (n,), dtype=f32)

    return {
        "x": jax.random.normal(ks[0], (BATCH, SEQ, D_MODEL), dtype=f32),
        "ln_mix_g": gain(ks[1], D_MODEL),
        "w_in": nrm(ks[2], (D_MODEL, D_IN_PROJ), D_MODEL ** -0.5),
        "conv_w": nrm(ks[3], (CONV_WIDTH, D_CONV), CONV_WIDTH ** -0.5),
        "sgu_ln_g": gain(ks[4], D_SGU),
        "sgu_ln_b": nrm(ks[5], (D_SGU,), 0.02),
        "sgu_w": nrm(ks[6], (N_SGU_HEADS, CHUNK, CHUNK), CHUNK ** -0.5),
        "sgu_b": 1.0 + nrm(ks[7], (N_SGU_HEADS, CHUNK), 0.02),
        "gn_conv": gain(ks[8], D_CONV),
        "gn_sgu": gain(ks[9], D_SGU),
        "w_out": nrm(ks[10], (D_MIX, D_MODEL), D_MIX ** -0.5),
        "ln_ffn_g": gain(ks[11], D_MODEL),
        "w_router": nrm(ks[12], (D_MODEL, N_EXPERTS), D_MODEL ** -0.5),
        "b_router": nrm(ks[13], (N_EXPERTS,), 0.01),
        "w_gate_up": nrm(ks[14], (N_EXPERTS, D_MODEL, 2 * D_FF), D_MODEL ** -0.5),
        "b_gate_up": nrm(ks[15], (N_EXPERTS, 2 * D_FF), 0.02),
        "w_down": nrm(ks[16], (N_EXPERTS, D_FF, D_MODEL), D_FF ** -0.5),
        "b_down": nrm(ks[17], (N_EXPERTS, D_MODEL), 0.02),
        "ln_final_g": gain(ks[18], D_MODEL),
    }


def reference(x, ln_mix_g, w_in, conv_w, sgu_ln_g, sgu_ln_b, sgu_w, sgu_b, gn_conv, gn_sgu,
              w_out, ln_ffn_g, w_router, b_router, w_gate_up, b_gate_up, w_down, b_down,
              ln_final_g):
    h = x
    for _ in range(DEPTH):
        h = h + hybrid_mixer(rms_norm(h, ln_mix_g), w_in, conv_w, sgu_ln_g, sgu_ln_b,
                             sgu_w, sgu_b, gn_conv, gn_sgu, w_out)
        h = h + moe_ffn(rms_norm(h, ln_ffn_g), w_router, b_router, w_gate_up, b_gate_up,
                        w_down, b_down)
    return rms_norm(h, ln_final_g)
```

```cpp
#include <hip/hip_runtime.h>
#include <stdint.h>
#include <stdio.h>

namespace {
constexpr int T = 8192, D = 2048, DIN = 5120, DC = 1024, NE = 32, DFF = 2048, SEQ = 4096;
constexpr float EPS = 1e-5f;

__device__ __forceinline__ float wave_sum(float v) {
#pragma unroll
    for (int o = 32; o > 0; o >>= 1) v += __shfl_xor(v, o);
    return v;
}
__device__ __forceinline__ float block_sum256(float v, float* red) {
    v = wave_sum(v);
    __syncthreads();
    if ((threadIdx.x & 63) == 0) red[threadIdx.x >> 6] = v;
    __syncthreads();
    return red[0] + red[1] + red[2] + red[3];
}
__device__ __forceinline__ float gelu_exact(float x) { return 0.5f * x * (1.0f + erff(x * 0.70710678118654752f)); }

__global__ void __launch_bounds__(256) k_rmsnorm(const float* __restrict__ x, const float* __restrict__ g, float* __restrict__ y) {
    __shared__ float red[4];
    const int t = blockIdx.x;
    const float* xr = x + (size_t)t * D;
    float s = 0.f;
    for (int i = threadIdx.x; i < D; i += 256) { float v = xr[i]; s += v * v; }
    s = block_sum256(s, red);
    const float r = rsqrtf(s * (1.0f / D) + EPS);
    for (int i = threadIdx.x; i < D; i += 256) y[(size_t)t * D + i] = xr[i] * r * g[i];
}

struct GP {
    const float* A; int lda; const float* B; int ldb; float* C; int ldc; int M, N, K;
    const float* R; const float* bias; const int* list; const int* cnt;
};
template <int MODE>
__global__ void __launch_bounds__(256) k_gemm(GP p) {
    __shared__ float As[16][68];
    __shared__ float Bs[16][68];
    __shared__ float Bs2[(MODE == 2) ? 16 : 1][68];
    const int tid = threadIdx.x, tx = tid & 15, ty = tid >> 4;
    int M = p.M;
    const float* B = p.B; const float* bias = p.bias;
    const int* list = nullptr;
    if (MODE >= 2) {
        const int e = blockIdx.z;
        M = p.cnt[e];
        if ((int)blockIdx.y * 64 >= M) return;
        B += (size_t)e * p.K * p.ldb;
        bias += (size_t)e * (MODE == 2 ? 2 * DFF : D);
        list = p.list + (size_t)e * T;
    }
    const int m0 = blockIdx.y * 64, n0 = blockIdx.x * 64;
    const int ar = tid >> 2, ak = (tid & 3) * 4;
    int arow = m0 + ar; if (arow >= M) arow = M - 1;
    const float* Ap;
    if (MODE == 2) Ap = p.A + (size_t)(list[arow] >> 2) * p.lda;
    else if (MODE == 3) Ap = p.A + (size_t)list[arow] * p.lda;
    else Ap = p.A + (size_t)arow * p.lda;
    const int bk = tid >> 4, bn = (tid & 15) * 4;
    float acc[4][4] = {}, acc2[4][4] = {};
    for (int k0 = 0; k0 < p.K; k0 += 16) {
        const float4 av = *(const float4*)(Ap + k0 + ak);
        const float4 bv = *(const float4*)(B + (size_t)(k0 + bk) * p.ldb + n0 + bn);
        float4 bv2;
        if (MODE == 2) bv2 = *(const float4*)(B + (size_t)(k0 + bk) * p.ldb + n0 + DFF + bn);
        __syncthreads();
        As[ak + 0][ar] = av.x; As[ak + 1][ar] = av.y; As[ak + 2][ar] = av.z; As[ak + 3][ar] = av.w;
        *(float4*)&Bs[bk][bn] = bv;
        if (MODE == 2) *(float4*)&Bs2[bk][bn] = bv2;
        __syncthreads();
#pragma unroll
        for (int kk = 0; kk < 16; ++kk) {
            const float4 a = *(const float4*)&As[kk][ty * 4];
            const float4 b = *(const float4*)&Bs[kk][tx * 4];
            const float aa[4] = {a.x, a.y, a.z, a.w}, bb[4] = {b.x, b.y, b.z, b.w};
#pragma unroll
            for (int i = 0; i < 4; ++i)
#pragma unroll
                for (int j = 0; j < 4; ++j) acc[i][j] += aa[i] * bb[j];
            if (MODE == 2) {
                const float4 b2 = *(const float4*)&Bs2[kk][tx * 4];
                const float bb2[4] = {b2.x, b2.y, b2.z, b2.w};
#pragma unroll
                for (int i = 0; i < 4; ++i)
#pragma unroll
                    for (int j = 0; j < 4; ++j) acc2[i][j] += aa[i] * bb2[j];
            }
        }
    }
#pragma unroll
    for (int i = 0; i < 4; ++i) {
        const int r = m0 + ty * 4 + i;
        if (r >= M) continue;
        size_t crow = (MODE >= 2) ? (size_t)list[r] : (size_t)r;
#pragma unroll
        for (int j = 0; j < 4; ++j) {
            const int n = n0 + tx * 4 + j;
            float v = acc[i][j];
            if (MODE == 1) v += p.R[(size_t)r * p.ldc + n];
            if (MODE == 2) {
                float gate = v + bias[n], up = acc2[i][j] + bias[n + DFF];
                gate = fminf(gate, 7.0f);
                up = fminf(fmaxf(up, -7.0f), 7.0f);
                const float glu = gate * (1.0f / (1.0f + __expf(-1.702f * gate)));
                v = (up + 1.0f) * glu;
            }
            if (MODE == 3) v += bias[n];
            p.C[crow * p.ldc + n] = v;
        }
    }
}

__global__ void __launch_bounds__(256) k_mixer(const float* __restrict__ proj, const float* __restrict__ conv_w,
        const float* __restrict__ ln_g, const float* __restrict__ ln_b, const float* __restrict__ sgu_w, const float* __restrict__ sgu_b,
        const float* __restrict__ gn_conv, const float* __restrict__ gn_sgu, float* __restrict__ y) {
    extern __shared__ float lds[];
    float* V = lds;
    float* Y = lds + 128 * 128;
    __shared__ float rstd[128];
    const int chunk = blockIdx.x, g = blockIdx.y, tid = threadIdx.x;
    const int d = tid & 127, half = tid >> 7;
    const int t0 = chunk * 128;
    if (g < 8) {
        const int c = g * 128 + d;
        const float w0 = conv_w[c], w1 = conv_w[DC + c], w2 = conv_w[2 * DC + c];
        for (int tt = half; tt < 128; tt += 2) {
            const int t = t0 + tt, s = t % SEQ;
            const float* pr = proj + (size_t)t * DIN;
            const float z0 = pr[DC + c] * pr[2 * DC + c];
            const float z1 = (s >= 1) ? pr[-DIN + DC + c] * pr[-DIN + 2 * DC + c] : 0.f;
            const float z2 = (s >= 2) ? pr[-2 * DIN + DC + c] * pr[-2 * DIN + 2 * DC + c] : 0.f;
            Y[tt * 128 + d] = pr[c] * (w0 * z2 + w1 * z1 + w2 * z0);
        }
    } else {
        const int hd = g - 8, j = hd * 128 + d;
        for (int tt = half; tt < 128; tt += 2) {
            const float* pr = proj + (size_t)(t0 + tt) * DIN;
            V[tt * 128 + d] = gelu_exact(pr[4096 + j]);
        }
        __syncthreads();
        {
            const int row = tid >> 1, hh = tid & 1;
            float s = 0.f;
            for (int i = 0; i < 64; ++i) s += V[row * 128 + hh * 64 + i];
            s += __shfl_xor(s, 1);
            const float mu = s * (1.0f / 128.0f);
            float q = 0.f;
            for (int i = 0; i < 64; ++i) { const float dv = V[row * 128 + hh * 64 + i] - mu; q += dv * dv; }
            q += __shfl_xor(q, 1);
            const float rs = rsqrtf(q * (1.0f / 128.0f) + EPS);
            for (int i = 0; i < 64; ++i) {
                const int dd = hh * 64 + i;
                V[row * 128 + dd] = (V[row * 128 + dd] - mu) * rs * ln_g[hd * 128 + dd] + ln_b[hd * 128 + dd];
            }
        }
        __syncthreads();
        const float* W = sgu_w + (size_t)hd * 128 * 128;
        for (int tt = half; tt < 128; tt += 2) {
            float m = 0.f;
            for (int sp = 0; sp <= tt; ++sp) m += W[tt * 128 + sp] * V[sp * 128 + d];
            m += sgu_b[hd * 128 + tt];
            const float* pr = proj + (size_t)(t0 + tt) * DIN;
            Y[tt * 128 + d] = gelu_exact(pr[3072 + j]) * m;
        }
    }
    __syncthreads();
    {
        const int row = tid >> 1, hh = tid & 1;
        float q = 0.f;
        for (int i = 0; i < 64; ++i) { const float v = Y[row * 128 + hh * 64 + i]; q += v * v; }
        q += __shfl_xor(q, 1);
        if (hh == 0) rstd[row] = rsqrtf(q * (1.0f / 128.0f) + EPS);
    }
    __syncthreads();
    const float gg = (g < 8) ? gn_conv[g * 128 + d] : gn_sgu[(g - 8) * 128 + d];
    for (int tt = half; tt < 128; tt += 2)
        y[(size_t)(t0 + tt) * D + g * 128 + d] = Y[tt * 128 + d] * rstd[tt] * gg;
}

__global__ void __launch_bounds__(256) k_router(const float* __restrict__ h, const float* __restrict__ g, const float* __restrict__ wr,
        const float* __restrict__ br, float* __restrict__ xn2, float* __restrict__ gates, int* __restrict__ cnt, int* __restrict__ list) {
    __shared__ float red[4];
    __shared__ float xs[D];
    __shared__ float part[8][32];
    __shared__ float lgs[32];
    __shared__ int sel_e[4];
    __shared__ float sel_x[4];
    const int t = blockIdx.x, tid = threadIdx.x;
    const float* hr = h + (size_t)t * D;
    float s = 0.f;
    for (int i = tid; i < D; i += 256) { float v = hr[i]; s += v * v; }
    s = block_sum256(s, red);
    const float r = rsqrtf(s * (1.0f / D) + EPS);
    for (int i = tid; i < D; i += 256) { const float v = hr[i] * r * g[i]; xs[i] = v; xn2[(size_t)t * D + i] = v; }
    __syncthreads();
    const int e = tid & 31, sl = tid >> 5;
    float a = 0.f;
    for (int k = sl * 256; k < sl * 256 + 256; ++k) a += xs[k] * wr[k * 32 + e];
    part[sl][e] = a;
    __syncthreads();
    if (tid < 32) { float v = br[tid]; for (int q = 0; q < 8; ++q) v += part[q][tid]; lgs[tid] = v; }
    __syncthreads();
    if (tid == 0) {
        float v0 = 0.f, se = 0.f;
        for (int k = 0; k < 4; ++k) {
            int bi = 0; float bv = -3.0e38f;
            for (int i = 0; i < 32; ++i) { const float l = lgs[i]; if (l > bv) { bv = l; bi = i; } }
            lgs[bi] = -3.4e38f;
            if (k == 0) v0 = bv;
            const float ex = __expf(bv - v0); se += ex;
            sel_e[k] = bi; sel_x[k] = ex;
        }
        for (int k = 0; k < 4; ++k) {
            const int ee = sel_e[k];
            gates[t * 4 + k] = sel_x[k] / se;
            const int slot = atomicAdd(&cnt[ee], 1);
            list[ee * T + slot] = t * 4 + k;
        }
    }
}

__global__ void __launch_bounds__(256) k_final(const float* __restrict__ h, const float* __restrict__ outp, const float* __restrict__ gates,
        const float* __restrict__ g, float* __restrict__ out) {
    __shared__ float red[4];
    const int t = blockIdx.x, tid = threadIdx.x;
    float v[8]; float s = 0.f;
    const float g0 = gates[t * 4], g1 = gates[t * 4 + 1], g2 = gates[t * 4 + 2], g3 = gates[t * 4 + 3];
#pragma unroll
    for (int i = 0; i < 8; ++i) {
        const int c = tid + i * 256;
        float x = h[(size_t)t * D + c];
        x += g0 * outp[((size_t)t * 4 + 0) * D + c] + g1 * outp[((size_t)t * 4 + 1) * D + c]
           + g2 * outp[((size_t)t * 4 + 2) * D + c] + g3 * outp[((size_t)t * 4 + 3) * D + c];
        v[i] = x; s += x * x;
    }
    s = block_sum256(s, red);
    const float r = rsqrtf(s * (1.0f / D) + EPS);
#pragma unroll
    for (int i = 0; i < 8; ++i) { const int c = tid + i * 256; out[(size_t)t * D + c] = v[i] * r * g[c]; }
}
}

extern "C" void kernel_launch(void* const* d_in, const int* in_sizes, int n_in, void* d_out, int out_size, void* d_ws, size_t ws_size,
                              hipStream_t stream) {
    const float* x = (const float*)d_in[0];
    const float* ln_mix_g = (const float*)d_in[1];
    const float* w_in = (const float*)d_in[2];
    const float* conv_w = (const float*)d_in[3];
    const float* sgu_ln_g = (const float*)d_in[4];
    const float* sgu_ln_b = (const float*)d_in[5];
    const float* sgu_w = (const float*)d_in[6];
    const float* sgu_b = (const float*)d_in[7];
    const float* gn_conv = (const float*)d_in[8];
    const float* gn_sgu = (const float*)d_in[9];
    const float* w_out = (const float*)d_in[10];
    const float* ln_ffn_g = (const float*)d_in[11];
    const float* w_router = (const float*)d_in[12];
    const float* b_router = (const float*)d_in[13];
    const float* w_gate_up = (const float*)d_in[14];
    const float* b_gate_up = (const float*)d_in[15];
    const float* w_down = (const float*)d_in[16];
    const float* b_down = (const float*)d_in[17];
    const float* ln_final_g = (const float*)d_in[18];
    float* out = (float*)d_out;

    char* ws = (char*)d_ws;
    size_t off = 0;
    auto take = [&](size_t bytes) { char* p = ws + off; off += (bytes + 255) & ~(size_t)255; return p; };
    int* cnt = (int*)take(256);
    int* list = (int*)take((size_t)NE * T * 4);
    float* gates = (float*)take((size_t)T * 4 * 4);
    float* xn = (float*)take((size_t)T * D * 4);
    float* proj = (float*)take((size_t)T * DIN * 4);
    float* y = (float*)take((size_t)T * D * 4);
    float* h = (float*)take((size_t)T * D * 4);
    float* xn2 = (float*)take((size_t)T * D * 4);
    float* act = (float*)take((size_t)T * 4 * DFF * 4);
    float* outp = (float*)take((size_t)T * 4 * D * 4);
    if (off > ws_size) { fprintf(stderr, "workspace too small: need %zu have %zu\n", off, ws_size); return; }

    hipMemsetAsync(cnt, 0, 256, stream);
    k_rmsnorm<<<T, 256, 0, stream>>>(x, ln_mix_g, xn);
    { GP p{}; p.A = xn; p.lda = D; p.B = w_in; p.ldb = DIN; p.C = proj; p.ldc = DIN; p.M = T; p.N = DIN; p.K = D;
      k_gemm<0><<<dim3(DIN / 64, T / 64, 1), 256, 0, stream>>>(p); }
    static bool attr = false;
    if (!attr) { hipFuncSetAttribute((const void*)k_mixer, hipFuncAttributeMaxDynamicSharedMemorySize, 2 * 128 * 128 * 4); attr = true; }
    k_mixer<<<dim3(T / 128, 16), 256, 2 * 128 * 128 * 4, stream>>>(proj, conv_w, sgu_ln_g, sgu_ln_b, sgu_w, sgu_b, gn_conv, gn_sgu, y);
    { GP p{}; p.A = y; p.lda = D; p.B = w_out; p.ldb = D; p.C = h; p.ldc = D; p.M = T; p.N = D; p.K = D; p.R = x;
      k_gemm<1><<<dim3(D / 64, T / 64, 1), 256, 0, stream>>>(p); }
    k_router<<<T, 256, 0, stream>>>(h, ln_ffn_g, w_router, b_router, xn2, gates, cnt, list);
    { GP p{}; p.A = xn2; p.lda = D; p.B = w_gate_up; p.ldb = 2 * DFF; p.C = act; p.ldc = DFF; p.M = T; p.N = DFF; p.K = D;
      p.bias = b_gate_up; p.list = list; p.cnt = cnt;
      k_gemm<2><<<dim3(DFF / 64, T / 64, NE), 256, 0, stream>>>(p); }
    { GP p{}; p.A = act; p.lda = DFF; p.B = w_down; p.ldb = D; p.C = outp; p.ldc = D; p.M = T; p.N = D; p.K = DFF;
      p.bias = b_down; p.list = list; p.cnt = cnt;
      k_gemm<3><<<dim3(D / 64, T / 64, NE), 256, 0, stream>>>(p); }
    k_final<<<T, 256, 0, stream>>>(h, outp, gates, ln_final_g, out);
}
```

```cpp
#include <hip/hip_runtime.h>
#include <stdint.h>
#include <stdio.h>

namespace {
constexpr int T = 8192, D = 2048, DIN = 5120, DC = 1024, NE = 32, DFF = 2048, SEQ = 4096;
constexpr int NPAIR = T * 4, ACT_ROWS = NPAIR + 256;
constexpr float EPS = 1e-5f;

#define LAS3 __attribute__((address_space(3)))
typedef short bf16x8 __attribute__((ext_vector_type(8)));
typedef float f32x4 __attribute__((ext_vector_type(4)));
typedef unsigned u32x4 __attribute__((ext_vector_type(4)));
typedef unsigned u32x2 __attribute__((ext_vector_type(2)));
typedef unsigned short bf16_t;

constexpr int GBK = 64, GHTB = 128 * 64 * 2;
constexpr int GEMM_LDS = 8 * GHTB;

__device__ __forceinline__ unsigned cvt_pk_bf16(float lo, float hi) {
    unsigned r; asm("v_cvt_pk_bf16_f32 %0, %1, %2" : "=v"(r) : "v"(lo), "v"(hi)); return r;
}
__device__ __forceinline__ float bf16_lo(unsigned u) { return __uint_as_float(u << 16); }
__device__ __forceinline__ float bf16_hi(unsigned u) { return __uint_as_float(u & 0xffff0000u); }

#define G_WAIT_V(n) asm volatile("s_waitcnt vmcnt(" #n ")" ::: "memory")
#define G_WAIT_L(n) asm volatile("s_waitcnt lgkmcnt(" #n ")" ::: "memory")
#define G_BAR do { asm volatile("" ::: "memory"); __builtin_amdgcn_s_barrier(); asm volatile("" ::: "memory"); } while (0)
#define G_SCHED __builtin_amdgcn_sched_barrier(0)

template <int LDB>
__device__ __forceinline__ void gemm_kloop(f32x4 (&acc)[2][2][4][2], const bf16_t* __restrict__ A, const unsigned (&aoff)[2][2],
                                           const float* __restrict__ B, unsigned boff, int nt, LAS3 char* lds) {
    const int tid = threadIdx.x, wid = tid >> 6, lane = tid & 63, wr = wid >> 2, wc = wid & 3, fr = lane & 15, fq = lane >> 4;
    const int c0 = fq ^ (fr >> 1);
    const int a_rd0 = (wr * 64 + fr) * 128 + c0 * 16, a_rd1 = (wr * 64 + fr) * 128 + (c0 ^ 4) * 16;
    const int b_rd0 = (wc * 32 + fr) * 128 + c0 * 16, b_rd1 = (wc * 32 + fr) * 128 + (c0 ^ 4) * 16;
    const int k8 = tid & 7, n4 = tid >> 3, bhalf = n4 >> 5, nloc = (n4 & 31) * 4;
    const int sw0 = ((n4 & 3) * 2) & 7, sw1 = ((n4 & 3) * 2 + 1) & 7;
    const int b_wr0 = (4 + bhalf) * GHTB + nloc * 128 + ((k8 ^ sw0) << 4);
    const int b_wr1 = (4 + bhalf) * GHTB + (nloc + 2) * 128 + ((k8 ^ sw1) << 4);
    const unsigned boffb = boff * 4u;
    const unsigned lds_u = (unsigned)(unsigned long)lds;
    const unsigned bw_a0 = lds_u + (unsigned)b_wr0, bw_a1 = lds_u + (unsigned)b_wr1;
    const int a_dma0 = wid * 1024, a_dma1 = (8 + wid) * 1024;

#define SA_(b, h) (((b) * 2 + (h)) * GHTB)
#define SB_(b, h) ((4 + (b) * 2 + (h)) * GHTB)
#define STAGE_A(b, h, kt) do { const bf16_t* _g = A + (size_t)(kt) * GBK; \
        __builtin_amdgcn_global_load_lds((const void*)(_g + aoff[h][0]), (LAS3 void*)(lds + SA_(b, h) + a_dma0), 16, 0, 0); \
        __builtin_amdgcn_global_load_lds((const void*)(_g + aoff[h][1]), (LAS3 void*)(lds + SA_(b, h) + a_dma1), 16, 0, 0); } while (0)
#define BLOAD(kt) do { const float* _g = B + (size_t)(kt) * GBK * LDB; \
        _Pragma("unroll") for (int _j = 0; _j < 8; ++_j) \
            asm volatile("global_load_dwordx4 %0, %1, %2" : "=v"(breg[_j]) : "v"(boffb), "s"(_g + (size_t)_j * LDB) : "memory"); } while (0)
#define BWAIT(n) asm volatile("s_waitcnt vmcnt(" #n ")" : "+v"(breg[0]), "+v"(breg[1]), "+v"(breg[2]), "+v"(breg[3]), \
                              "+v"(breg[4]), "+v"(breg[5]), "+v"(breg[6]), "+v"(breg[7]) :: "memory")
#define BWRITE(b) do { \
        _Pragma("unroll") for (int _i = 0; _i < 4; ++_i) { u32x4 _w; \
            _w.x = cvt_pk_bf16(breg[0][_i], breg[1][_i]); _w.y = cvt_pk_bf16(breg[2][_i], breg[3][_i]); \
            _w.z = cvt_pk_bf16(breg[4][_i], breg[5][_i]); _w.w = cvt_pk_bf16(breg[6][_i], breg[7][_i]); \
            asm volatile("ds_write_b128 %0, %1 offset:%2" :: "v"((_i < 2) ? bw_a0 : bw_a1), "v"(_w), "n"((b) * 2 * GHTB + (_i & 1) * 128) : "memory"); } } while (0)
#define LDA(dst, b, h) do { _Pragma("unroll") for (int _m = 0; _m < 4; ++_m) { \
        dst[_m][0] = *(LAS3 const bf16x8*)(lds + SA_(b, h) + a_rd0 + _m * 2048); \
        dst[_m][1] = *(LAS3 const bf16x8*)(lds + SA_(b, h) + a_rd1 + _m * 2048); } } while (0)
#define LDB_(dst, b, h) do { _Pragma("unroll") for (int _n = 0; _n < 2; ++_n) { \
        dst[_n][0] = *(LAS3 const bf16x8*)(lds + SB_(b, h) + b_rd0 + _n * 2048); \
        dst[_n][1] = *(LAS3 const bf16x8*)(lds + SB_(b, h) + b_rd1 + _n * 2048); } } while (0)
#define MMA(ai, bj, Af, Bf) do { __builtin_amdgcn_s_setprio(1); \
        _Pragma("unroll") for (int _m = 0; _m < 4; ++_m) _Pragma("unroll") for (int _n = 0; _n < 2; ++_n) _Pragma("unroll") for (int _k = 0; _k < 2; ++_k) \
            acc[ai][bj][_m][_n] = __builtin_amdgcn_mfma_f32_16x16x32_bf16(Bf[_n][_k], Af[_m][_k], acc[ai][bj][_m][_n], 0, 0, 0); \
        __builtin_amdgcn_s_setprio(0); } while (0)

    f32x4 breg[8];
    bf16x8 At[4][2], B0[2][2], B1[2][2];
#pragma unroll
    for (int ai = 0; ai < 2; ++ai)
#pragma unroll
        for (int bj = 0; bj < 2; ++bj)
#pragma unroll
            for (int m = 0; m < 4; ++m)
#pragma unroll
                for (int n = 0; n < 2; ++n) acc[ai][bj][m][n] = (f32x4){0.f, 0.f, 0.f, 0.f};

    BLOAD(0); STAGE_A(0, 0, 0); STAGE_A(0, 1, 0);
    BWAIT(4); BWRITE(0); BLOAD(1); STAGE_A(1, 0, 1);
    BWAIT(2); BWRITE(1); BLOAD(2 < nt ? 2 : nt - 1);
    G_WAIT_V(8);
    G_WAIT_L(0);
    if (wr == 1) G_BAR;
    G_BAR;
    for (int t = 0; t < nt; t += 2) {
        const int t1 = t + 1, t2 = (t + 2 < nt) ? t + 2 : nt - 1, t3 = (t + 3 < nt) ? t + 3 : nt - 1, t4 = (t + 4 < nt) ? t + 4 : nt - 1;
        LDB_(B0, 0, 0); G_SCHED; LDA(At, 0, 0); STAGE_A(1, 1, t1);
        G_WAIT_L(8); G_BAR; G_WAIT_L(0); MMA(0, 0, At, B0); G_BAR; G_SCHED;
        LDB_(B1, 0, 1);
        G_BAR; G_WAIT_L(0); MMA(0, 1, At, B1); G_BAR;
        LDA(At, 0, 1); STAGE_A(0, 0, t2);
        G_BAR; G_WAIT_L(0); MMA(1, 0, At, B0); G_BAR; G_SCHED;
        BWAIT(4); BWRITE(0); BLOAD(t3);
        G_WAIT_V(10); G_BAR; MMA(1, 1, At, B1); G_BAR;
        LDB_(B0, 1, 0); G_SCHED; LDA(At, 1, 0); STAGE_A(0, 1, t2);
        G_WAIT_L(8); G_BAR; G_WAIT_L(0); MMA(0, 0, At, B0); G_BAR; G_SCHED;
        LDB_(B1, 1, 1);
        G_BAR; G_WAIT_L(0); MMA(0, 1, At, B1); G_BAR;
        LDA(At, 1, 1); STAGE_A(1, 0, t3);
        G_BAR; G_WAIT_L(0); MMA(1, 0, At, B0); G_BAR; G_SCHED;
        BWAIT(4); BWRITE(1); BLOAD(t4);
        G_WAIT_V(10); G_BAR; MMA(1, 1, At, B1); G_BAR;
    }
    G_WAIT_V(0); G_WAIT_L(0);
    if (wr == 0) G_BAR;
    G_BAR;
#undef SA_
#undef SB_
#undef STAGE_A
#undef BLOAD
#undef BWRITE
#undef BWAIT
#undef LDA
#undef LDB_
#undef MMA
}


__device__ __forceinline__ float wave_sum(float v) {
#pragma unroll
    for (int o = 32; o > 0; o >>= 1) v += __shfl_xor(v, o);
    return v;
}
__device__ __forceinline__ float gelu_exact(float x) { return 0.5f * x * (1.0f + erff(x * 0.70710678118654752f)); }
__device__ __forceinline__ float bf2f(bf16_t v) { return __uint_as_float((unsigned)v << 16); }
__device__ __forceinline__ bf16_t f2bf(float v) { return (bf16_t)(cvt_pk_bf16(v, 0.f) & 0xffffu); }

__global__ void __launch_bounds__(256) k_rmsnorm_bf16(const float* __restrict__ x, const float* __restrict__ g, bf16_t* __restrict__ y) {
    const int wid = threadIdx.x >> 6, lane = threadIdx.x & 63;
    const int t = blockIdx.x * 4 + wid;
    const float* xr = x + (size_t)t * D;
    f32x4 v[8]; float s = 0.f;
#pragma unroll
    for (int j = 0; j < 8; ++j) { v[j] = *(const f32x4*)(xr + j * 256 + lane * 4); s += v[j][0] * v[j][0] + v[j][1] * v[j][1] + v[j][2] * v[j][2] + v[j][3] * v[j][3]; }
    s = wave_sum(s);
    const float r = rsqrtf(s * (1.0f / D) + EPS);
#pragma unroll
    for (int j = 0; j < 8; ++j) {
        const f32x4 gg = *(const f32x4*)(g + j * 256 + lane * 4);
        u32x2 o; o.x = cvt_pk_bf16(v[j][0] * r * gg[0], v[j][1] * r * gg[1]); o.y = cvt_pk_bf16(v[j][2] * r * gg[2], v[j][3] * r * gg[3]);
        *(u32x2*)(y + (size_t)t * D + j * 256 + lane * 4) = o;
    }
}

struct GemmArgs {
    const bf16_t* A; const float* B; const float* bias; const float* R;
    void* C;
    const int* list; const int* cnt;
};
template <int EPI>
__device__ __forceinline__ void gemm_tile(const GemmArgs& g, int pm, int pn, int e, int ebase, int ecnt, LAS3 char* lds) {
    constexpr int LDB = (EPI == 0) ? DIN : (EPI == 2) ? 2 * DFF : D;
    const int tid = threadIdx.x, wid = tid >> 6, lane = tid & 63;
    unsigned aoff[2][2];
#pragma unroll
    for (int h = 0; h < 2; ++h)
#pragma unroll
        for (int i = 0; i < 2; ++i) {
            const int rih = (i * 8 + wid) * 8 + (lane >> 3);
            const int chunk = (lane & 7) ^ ((rih >> 1) & 7);
            int r = pm * 256 + h * 128 + rih;
            unsigned grow;
            if (EPI == 2) { if (r >= ecnt) r = ecnt - 1; grow = (unsigned)(g.list[e * T + r] >> 2); }
            else if (EPI == 3) { grow = (unsigned)(ebase + r); }
            else grow = (unsigned)r;
            aoff[h][i] = grow * (unsigned)D + (unsigned)(chunk * 8);
        }
    const int k8 = tid & 7, n4 = tid >> 3;
    int col;
    if (EPI == 2) col = (n4 < 32) ? pn * 128 + n4 * 4 : DFF + pn * 128 + (n4 - 32) * 4;
    else col = pn * 256 + n4 * 4;
    const unsigned boff = (unsigned)(k8 * 8) * (unsigned)LDB + (unsigned)col;
    const float* Bp = g.B;
    if (EPI == 2) Bp += (size_t)e * D * (2 * DFF);
    if (EPI == 3) Bp += (size_t)e * DFF * D;
    f32x4 acc[2][2][4][2];
    gemm_kloop<LDB>(acc, g.A, aoff, Bp, boff, D / GBK, lds);
    int tz = threadIdx.x; asm volatile("" : "+v"(tz));
    const int wid2 = tz >> 6, lane2 = tz & 63;
    const int row0 = (wid2 >> 2) * 64 + (lane2 & 15), colw = (wid2 & 3) * 32 + (lane2 >> 4) * 4;
    if (EPI == 0) {
        bf16_t* C = (bf16_t*)g.C;
#pragma unroll
        for (int ai = 0; ai < 2; ++ai)
#pragma unroll
            for (int m = 0; m < 4; ++m) {
                bf16_t* rp = C + (size_t)(pm * 256 + ai * 128 + row0 + m * 16) * DIN + pn * 256 + colw;
#pragma unroll
                for (int bj = 0; bj < 2; ++bj)
#pragma unroll
                    for (int n = 0; n < 2; ++n) { const f32x4 v = acc[ai][bj][m][n]; u32x2 o; o.x = cvt_pk_bf16(v[0], v[1]); o.y = cvt_pk_bf16(v[2], v[3]);
                        *(u32x2*)(rp + bj * 128 + n * 16) = o; }
            }
    } else if (EPI == 1) {
        float* C = (float*)g.C;
#pragma unroll
        for (int ai = 0; ai < 2; ++ai)
#pragma unroll
            for (int m = 0; m < 4; ++m) {
                const size_t ro = (size_t)(pm * 256 + ai * 128 + row0 + m * 16) * D + pn * 256 + colw;
#pragma unroll
                for (int bj = 0; bj < 2; ++bj)
#pragma unroll
                    for (int n = 0; n < 2; ++n) { const f32x4 xr = *(const f32x4*)(g.R + ro + bj * 128 + n * 16);
                        *(f32x4*)(C + ro + bj * 128 + n * 16) = acc[ai][bj][m][n] + xr; }
            }
    } else if (EPI == 2) {
        bf16_t* C = (bf16_t*)g.C;
        const float* bg = g.bias + (size_t)e * (2 * DFF) + pn * 128 + colw;
        f32x4 bgate[2], bup[2];
#pragma unroll
        for (int n = 0; n < 2; ++n) { bgate[n] = *(const f32x4*)(bg + n * 16); bup[n] = *(const f32x4*)(bg + DFF + n * 16); }
#pragma unroll
        for (int ai = 0; ai < 2; ++ai)
#pragma unroll
            for (int m = 0; m < 4; ++m) {
                const int r = pm * 256 + ai * 128 + row0 + m * 16;
                if (r < ecnt) {
                    bf16_t* rp = C + (size_t)(ebase + r) * DFF + pn * 128 + colw;
#pragma unroll
                    for (int n = 0; n < 2; ++n) {
                        float o[4];
#pragma unroll
                        for (int j = 0; j < 4; ++j) {
                            float gate = acc[ai][0][m][n][j] + bgate[n][j], up = acc[ai][1][m][n][j] + bup[n][j];
                            gate = fminf(gate, 7.0f); up = fminf(fmaxf(up, -7.0f), 7.0f);
                            const float glu = gate * __builtin_amdgcn_rcpf(1.0f + __expf(-1.702f * gate));
                            o[j] = (up + 1.0f) * glu;
                        }
                        u32x2 w; w.x = cvt_pk_bf16(o[0], o[1]); w.y = cvt_pk_bf16(o[2], o[3]);
                        *(u32x2*)(rp + n * 16) = w;
                    }
                }
            }
    } else {
        bf16_t* C = (bf16_t*)g.C;
        const float* bd = g.bias + (size_t)e * D + pn * 256 + colw;
        f32x4 bv[2][2];
#pragma unroll
        for (int bj = 0; bj < 2; ++bj)
#pragma unroll
            for (int n = 0; n < 2; ++n) bv[bj][n] = *(const f32x4*)(bd + bj * 128 + n * 16);
#pragma unroll
        for (int ai = 0; ai < 2; ++ai)
#pragma unroll
            for (int m = 0; m < 4; ++m) {
                const int r = pm * 256 + ai * 128 + row0 + m * 16;
                if (r < ecnt) {
                    bf16_t* rp = C + (size_t)(ebase + r) * D + pn * 256 + colw;
#pragma unroll
                    for (int bj = 0; bj < 2; ++bj)
#pragma unroll
                        for (int n = 0; n < 2; ++n) { const f32x4 v = acc[ai][bj][m][n] + bv[bj][n]; u32x2 o; o.x = cvt_pk_bf16(v[0], v[1]); o.y = cvt_pk_bf16(v[2], v[3]);
                            *(u32x2*)(rp + bj * 128 + n * 16) = o; }
                }
            }
    }
}

template <int EPI>
__global__ void __launch_bounds__(512, 2) k_gemm_fast(GemmArgs g) {
    extern __shared__ __attribute__((aligned(16))) char smem[];
    LAS3 char* lds = (LAS3 char*)smem;
    if (EPI <= 1) {
        gemm_tile<EPI>(g, blockIdx.y, blockIdx.x, 0, 0, T, lds);
    } else {
        const int e = blockIdx.z;
        const int ecnt = g.cnt[e];
        if ((int)blockIdx.y * 256 >= ecnt) return;
        int ebase = 0;
        for (int i = 0; i < e; ++i) ebase += g.cnt[i];
        gemm_tile<EPI>(g, blockIdx.y, blockIdx.x, e, ebase, ecnt, lds);
    }
}

__global__ void __launch_bounds__(256) k_mixer(const bf16_t* __restrict__ proj, const float* __restrict__ conv_w,
        const float* __restrict__ ln_g, const float* __restrict__ ln_b, const float* __restrict__ sgu_w, const float* __restrict__ sgu_b,
        const float* __restrict__ gn_conv, const float* __restrict__ gn_sgu, bf16_t* __restrict__ y) {
    extern __shared__ float ldsf[];
    float* V = ldsf;
    float* Y = ldsf + 128 * 128;
    __shared__ float rstd[128];
    const int chunk = blockIdx.x, g = blockIdx.y, tid = threadIdx.x;
    const int d = tid & 127, half = tid >> 7;
    const int t0 = chunk * 128;
    if (g < 8) {
        const int c = g * 128 + d;
        const float w0 = conv_w[c], w1 = conv_w[DC + c], w2 = conv_w[2 * DC + c];
        for (int tt = half; tt < 128; tt += 2) {
            const int t = t0 + tt, s = t % SEQ;
            const bf16_t* pr = proj + (size_t)t * DIN;
            const float z0 = bf2f(pr[DC + c]) * bf2f(pr[2 * DC + c]);
            const float z1 = (s >= 1) ? bf2f(pr[-DIN + DC + c]) * bf2f(pr[-DIN + 2 * DC + c]) : 0.f;
            const float z2 = (s >= 2) ? bf2f(pr[-2 * DIN + DC + c]) * bf2f(pr[-2 * DIN + 2 * DC + c]) : 0.f;
            Y[tt * 128 + d] = bf2f(pr[c]) * (w0 * z2 + w1 * z1 + w2 * z0);
        }
    } else {
        const int hd = g - 8, j = hd * 128 + d;
        for (int tt = half; tt < 128; tt += 2) {
            const bf16_t* pr = proj + (size_t)(t0 + tt) * DIN;
            V[tt * 128 + d] = gelu_exact(bf2f(pr[4096 + j]));
        }
        __syncthreads();
        {
            const int row = tid >> 1, hh = tid & 1;
            float s = 0.f;
            for (int i = 0; i < 64; ++i) s += V[row * 128 + hh * 64 + i];
            s += __shfl_xor(s, 1);
            const float mu = s * (1.0f / 128.0f);
            float q = 0.f;
            for (int i = 0; i < 64; ++i) { const float dv = V[row * 128 + hh * 64 + i] - mu; q += dv * dv; }
            q += __shfl_xor(q, 1);
            const float rs = rsqrtf(q * (1.0f / 128.0f) + EPS);
            for (int i = 0; i < 64; ++i) {
                const int dd = hh * 64 + i;
                V[row * 128 + dd] = (V[row * 128 + dd] - mu) * rs * ln_g[hd * 128 + dd] + ln_b[hd * 128 + dd];
            }
        }
        __syncthreads();
        const float* W = sgu_w + (size_t)hd * 128 * 128;
        for (int tt = half; tt < 128; tt += 2) {
            float m = 0.f;
            for (int sp = 0; sp <= tt; ++sp) m += W[tt * 128 + sp] * V[sp * 128 + d];
            m += sgu_b[hd * 128 + tt];
            const bf16_t* pr = proj + (size_t)(t0 + tt) * DIN;
            Y[tt * 128 + d] = gelu_exact(bf2f(pr[3072 + j])) * m;
        }
    }
    __syncthreads();
    {
        const int row = tid >> 1, hh = tid & 1;
        float q = 0.f;
        for (int i = 0; i < 64; ++i) { const float v = Y[row * 128 + hh * 64 + i]; q += v * v; }
        q += __shfl_xor(q, 1);
        if (hh == 0) rstd[row] = rsqrtf(q * (1.0f / 128.0f) + EPS);
    }
    __syncthreads();
    const float gg = (g < 8) ? gn_conv[g * 128 + d] : gn_sgu[(g - 8) * 128 + d];
    for (int tt = half; tt < 128; tt += 2)
        y[(size_t)(t0 + tt) * D + g * 128 + d] = f2bf(Y[tt * 128 + d] * rstd[tt] * gg);
}

__global__ void __launch_bounds__(256) k_router(const float* __restrict__ h, const float* __restrict__ g, const float* __restrict__ wr,
        const float* __restrict__ br, bf16_t* __restrict__ xn2, float* __restrict__ gates, int* __restrict__ sel, int* __restrict__ cnt, int* __restrict__ list) {
    __shared__ float red[4];
    __shared__ float xs[D];
    __shared__ float part[8][32];
    __shared__ float lgs[32];
    __shared__ int sel_e[4];
    __shared__ float sel_x[4];
    const int t = blockIdx.x, tid = threadIdx.x;
    const float* hr = h + (size_t)t * D;
    float s = 0.f;
    for (int i = tid; i < D; i += 256) { float v = hr[i]; s += v * v; }
    s = wave_sum(s);
    if ((tid & 63) == 0) red[tid >> 6] = s;
    __syncthreads();
    s = red[0] + red[1] + red[2] + red[3];
    const float r = rsqrtf(s * (1.0f / D) + EPS);
    for (int i = tid; i < D; i += 256) { const float v = hr[i] * r * g[i]; xs[i] = v; xn2[(size_t)t * D + i] = f2bf(v); }
    __syncthreads();
    const int e = tid & 31, sl = tid >> 5;
    float a = 0.f;
    for (int k = sl * 256; k < sl * 256 + 256; ++k) a += xs[k] * wr[k * 32 + e];
    part[sl][e] = a;
    __syncthreads();
    if (tid < 32) { float v = br[tid]; for (int q = 0; q < 8; ++q) v += part[q][tid]; lgs[tid] = v; }
    __syncthreads();
    if (tid == 0) {
        float v0 = 0.f, se = 0.f;
        for (int k = 0; k < 4; ++k) {
            int bi = 0; float bv = -3.0e38f;
            for (int i = 0; i < 32; ++i) { const float l = lgs[i]; if (l > bv) { bv = l; bi = i; } }
            lgs[bi] = -3.4e38f;
            if (k == 0) v0 = bv;
            const float ex = __expf(bv - v0); se += ex;
            sel_e[k] = bi; sel_x[k] = ex;
        }
        for (int k = 0; k < 4; ++k) {
            const int ee = sel_e[k];
            gates[t * 4 + k] = sel_x[k] / se;
            const int slot = atomicAdd(&cnt[ee], 1);
            list[ee * T + slot] = t * 4 + k;
            sel[t * 4 + k] = (ee << 16) | slot;
        }
    }
}

__global__ void __launch_bounds__(256) k_final(const float* __restrict__ h, const bf16_t* __restrict__ outp, const float* __restrict__ gates,
        const int* __restrict__ sel, const int* __restrict__ cnt, const float* __restrict__ g, float* __restrict__ out) {
    __shared__ int base[NE];
    if (threadIdx.x == 0) { int a = 0; for (int i = 0; i < NE; ++i) { base[i] = a; a += cnt[i]; } }
    __syncthreads();
    const int wid = threadIdx.x >> 6, lane = threadIdx.x & 63;
    const int t = blockIdx.x * 4 + wid;
    float gk[4]; const bf16_t* op[4];
#pragma unroll
    for (int k = 0; k < 4; ++k) { const int s = sel[t * 4 + k]; gk[k] = gates[t * 4 + k]; op[k] = outp + (size_t)(base[s >> 16] + (s & 0xffff)) * D; }
    f32x4 v[8]; float ss = 0.f;
#pragma unroll
    for (int j = 0; j < 8; ++j) {
        const int c = j * 256 + lane * 4;
        f32x4 a = *(const f32x4*)(h + (size_t)t * D + c);
#pragma unroll
        for (int k = 0; k < 4; ++k) { const u32x2 o = *(const u32x2*)(op[k] + c);
            a[0] += gk[k] * bf16_lo(o.x); a[1] += gk[k] * bf16_hi(o.x); a[2] += gk[k] * bf16_lo(o.y); a[3] += gk[k] * bf16_hi(o.y); }
        v[j] = a; ss += a[0] * a[0] + a[1] * a[1] + a[2] * a[2] + a[3] * a[3];
    }
    ss = wave_sum(ss);
    const float r = rsqrtf(ss * (1.0f / D) + EPS);
#pragma unroll
    for (int j = 0; j < 8; ++j) { const int c = j * 256 + lane * 4; const f32x4 gg = *(const f32x4*)(g + c);
        f32x4 o; o[0] = v[j][0] * r * gg[0]; o[1] = v[j][1] * r * gg[1]; o[2] = v[j][2] * r * gg[2]; o[3] = v[j][3] * r * gg[3];
        *(f32x4*)(out + (size_t)t * D + c) = o; }
}
}

extern "C" void kernel_launch(void* const* d_in, const int* in_sizes, int n_in, void* d_out, int out_size, void* d_ws, size_t ws_size,
                              hipStream_t stream) {
    const float* x = (const float*)d_in[0];
    const float* ln_mix_g = (const float*)d_in[1];
    const float* w_in = (const float*)d_in[2];
    const float* conv_w = (const float*)d_in[3];
    const float* sgu_ln_g = (const float*)d_in[4];
    const float* sgu_ln_b = (const float*)d_in[5];
    const float* sgu_w = (const float*)d_in[6];
    const float* sgu_b = (const float*)d_in[7];
    const float* gn_conv = (const float*)d_in[8];
    const float* gn_sgu = (const float*)d_in[9];
    const float* w_out = (const float*)d_in[10];
    const float* ln_ffn_g = (const float*)d_in[11];
    const float* w_router = (const float*)d_in[12];
    const float* b_router = (const float*)d_in[13];
    const float* w_gate_up = (const float*)d_in[14];
    const float* b_gate_up = (const float*)d_in[15];
    const float* w_down = (const float*)d_in[16];
    const float* b_down = (const float*)d_in[17];
    const float* ln_final_g = (const float*)d_in[18];
    float* out = (float*)d_out;

    char* ws = (char*)d_ws;
    size_t off = 0;
    auto take = [&](size_t bytes) { char* p = ws + off; off += (bytes + 255) & ~(size_t)255; return p; };
    int* cnt = (int*)take(256);
    int* list = (int*)take((size_t)NE * T * 4);
    int* sel = (int*)take((size_t)NPAIR * 4);
    float* gates = (float*)take((size_t)NPAIR * 4);
    bf16_t* xn = (bf16_t*)take((size_t)T * D * 2);
    bf16_t* proj = (bf16_t*)take((size_t)T * DIN * 2);
    bf16_t* y = (bf16_t*)take((size_t)T * D * 2);
    float* h = (float*)take((size_t)T * D * 4);
    bf16_t* xn2 = (bf16_t*)take((size_t)T * D * 2);
    bf16_t* act = (bf16_t*)take((size_t)ACT_ROWS * DFF * 2);
    bf16_t* outp = (bf16_t*)take((size_t)ACT_ROWS * D * 2);
    if (off > ws_size) { fprintf(stderr, "workspace too small: need %zu have %zu\n", off, ws_size); return; }

    static bool attr = false;
    if (!attr) {
        (void)hipFuncSetAttribute((const void*)k_mixer, hipFuncAttributeMaxDynamicSharedMemorySize, 2 * 128 * 128 * 4);
        (void)hipFuncSetAttribute((const void*)k_gemm_fast<0>, hipFuncAttributeMaxDynamicSharedMemorySize, GEMM_LDS);
        (void)hipFuncSetAttribute((const void*)k_gemm_fast<1>, hipFuncAttributeMaxDynamicSharedMemorySize, GEMM_LDS);
        (void)hipFuncSetAttribute((const void*)k_gemm_fast<2>, hipFuncAttributeMaxDynamicSharedMemorySize, GEMM_LDS);
        (void)hipFuncSetAttribute((const void*)k_gemm_fast<3>, hipFuncAttributeMaxDynamicSharedMemorySize, GEMM_LDS);
        attr = true;
    }
    (void)hipMemsetAsync(cnt, 0, 256, stream);
    k_rmsnorm_bf16<<<T / 4, 256, 0, stream>>>(x, ln_mix_g, xn);
    { GemmArgs g{}; g.A = xn; g.B = w_in; g.C = proj;
      k_gemm_fast<0><<<dim3(DIN / 256, T / 256, 1), 512, GEMM_LDS, stream>>>(g); }
    k_mixer<<<dim3(T / 128, 16), 256, 2 * 128 * 128 * 4, stream>>>(proj, conv_w, sgu_ln_g, sgu_ln_b, sgu_w, sgu_b, gn_conv, gn_sgu, y);
    { GemmArgs g{}; g.A = y; g.B = w_out; g.C = h; g.R = x;
      k_gemm_fast<1><<<dim3(D / 256, T / 256, 1), 512, GEMM_LDS, stream>>>(g); }
    k_router<<<T, 256, 0, stream>>>(h, ln_ffn_g, w_router, b_router, xn2, gates, sel, cnt, list);
    { GemmArgs g{}; g.A = xn2; g.B = w_gate_up; g.C = act; g.bias = b_gate_up; g.list = list; g.cnt = cnt;
      k_gemm_fast<2><<<dim3(DFF / 128, T / 256, NE), 512, GEMM_LDS, stream>>>(g); }
    { GemmArgs g{}; g.A = act; g.B = w_down; g.C = outp; g.bias = b_down; g.list = list; g.cnt = cnt;
      k_gemm_fast<3><<<dim3(D / 256, T / 256, NE), 512, GEMM_LDS, stream>>>(g); }
    k_final<<<T / 4, 256, 0, stream>>>(h, outp, gates, sel, cnt, ln_final_g, out);
}
```

```cpp
#include <hip/hip_runtime.h>
#include <stdint.h>
#include <stdio.h>

namespace {
constexpr int T = 8192, D = 2048, DIN = 5120, DC = 1024, NE = 32, DFF = 2048, SEQ = 4096;
constexpr int NPAIR = T * 4, ACT_ROWS = NPAIR + 256;
constexpr float EPS = 1e-5f;

#define LAS3 __attribute__((address_space(3)))
typedef short bf16x8 __attribute__((ext_vector_type(8)));
typedef float f32x4 __attribute__((ext_vector_type(4)));
typedef unsigned u32x4 __attribute__((ext_vector_type(4)));
typedef unsigned u32x2 __attribute__((ext_vector_type(2)));
typedef unsigned short bf16_t;

constexpr int GBK = 64, GHTB = 128 * 64 * 2;
constexpr int GEMM_LDS = 8 * GHTB;

__device__ __forceinline__ unsigned cvt_pk_bf16(float lo, float hi) {
    unsigned r; asm("v_cvt_pk_bf16_f32 %0, %1, %2" : "=v"(r) : "v"(lo), "v"(hi)); return r;
}
__device__ __forceinline__ float bf16_lo(unsigned u) { return __uint_as_float(u << 16); }
__device__ __forceinline__ float bf16_hi(unsigned u) { return __uint_as_float(u & 0xffff0000u); }

__device__ __forceinline__ void dma16(const void* sbase, unsigned voff, unsigned lds_dst) {
    unsigned keep;
    asm volatile("s_mov_b32 %0, m0\n\ts_mov_b32 m0, %3\n\ts_nop 2\n\tglobal_load_lds_dwordx4 %1, %2\n\ts_mov_b32 m0, %0"
                 : "=&s"(keep) : "v"(voff), "s"(sbase), "s"(lds_dst) : "memory");
}
#define G_WAIT_V(n) asm volatile("s_waitcnt vmcnt(" #n ")" ::: "memory")
#define G_WAIT_L(n) asm volatile("s_waitcnt lgkmcnt(" #n ")" ::: "memory")
#define G_BAR do { asm volatile("" ::: "memory"); __builtin_amdgcn_s_barrier(); asm volatile("" ::: "memory"); } while (0)
#define G_SCHED __builtin_amdgcn_sched_barrier(0)

template <int LDB, int VAR = 0>
__device__ __forceinline__ void gemm_kloop(f32x4 (&acc)[2][2][4][2], const bf16_t* __restrict__ A, const unsigned (&aoff)[2][2],
                                           const float* __restrict__ B, unsigned boff, int nt, LAS3 char* lds, int tid, int wid, size_t astep = GBK, size_t bstep = (size_t)GBK * LDB) {
    const int lane = tid & 63, wr = wid >> 2, wc = wid & 3, fr = lane & 15, fq = lane >> 4;
    const int c0 = fq ^ (fr >> 1);
    const int a_rd0 = (wr * 64 + fr) * 128 + c0 * 16, a_rd1 = (wr * 64 + fr) * 128 + (c0 ^ 4) * 16;
    const int b_rd0 = (wc * 16 + fr) * 128 + ((c0 ^ (wc & 1)) * 16), b_rd1 = (wc * 16 + fr) * 128 + ((c0 ^ (wc & 1) ^ 4) * 16);
    const int k8 = wid, n4 = tid & 63, bhalf = n4 >> 5, nloc = (n4 & 31) * 4;
    const int sw0 = (((n4 & 3) * 2) & 7) ^ ((n4 >> 2) & 1), sw1 = (((n4 & 3) * 2 + 1) & 7) ^ ((n4 >> 2) & 1);
    const int b_wr0 = (4 + bhalf) * GHTB + nloc * 128 + ((k8 ^ sw0) << 4);
    const int b_wr1 = (4 + bhalf) * GHTB + (nloc + 2) * 128 + ((k8 ^ sw1) << 4);
    const unsigned boffb = boff * 4u;
    const unsigned lds_u = (unsigned)(unsigned long)lds;
    const unsigned bw_a0 = lds_u + (unsigned)b_wr0, bw_a1 = lds_u + (unsigned)b_wr1;
    const int a_dma0 = wid * 1024, a_dma1 = (8 + wid) * 1024;

#define SA_(b, h) (((b) * 2 + (h)) * GHTB)
#define SB_(b, h) ((4 + (b) * 2 + (h)) * GHTB)
#define STAGE_A(b, h, kt) do { const bf16_t* _g = A + (size_t)(kt) * astep; \
        dma16((const void*)_g, aoff[h][0], lds_u + SA_(b, h) + a_dma0); \
        dma16((const void*)_g, aoff[h][1], lds_u + SA_(b, h) + a_dma1); } while (0)
#define BLOAD2(R, kt, j0) asm volatile("s_nop 4\n\tglobal_load_dwordx4 %0, %2, %3\n\tglobal_load_dwordx4 %1, %2, %4" \
        : "=&v"(R[(j0) & 3]), "=&v"(R[((j0) & 3) + 1]) : "v"(boffb), "s"(B + (size_t)(kt) * bstep + (size_t)(j0) * LDB), "s"(B + (size_t)(kt) * bstep + (size_t)((j0) + 1) * LDB) : "memory")
#define BWAIT(R, n) asm volatile("s_waitcnt vmcnt(" #n ")" : "+v"(R[0]), "+v"(R[1]), "+v"(R[2]), "+v"(R[3]) :: "memory")
#define BWRITE_H(R, b, hi) do { _Pragma("unroll") for (int _i = 0; _i < 4; ++_i) { u32x2 _w; \
            _w.x = cvt_pk_bf16(R[0][_i], R[1][_i]); _w.y = cvt_pk_bf16(R[2][_i], R[3][_i]); \
            asm volatile("ds_write_b64 %0, %1 offset:%2" :: "v"((_i < 2) ? bw_a0 : bw_a1), "v"(_w), "n"((b) * 2 * GHTB + (_i & 1) * 128 + (hi) * 8) : "memory"); } } while (0)
#define LDA(dst, b, h) do { _Pragma("unroll") for (int _m = 0; _m < 4; ++_m) { \
        dst[_m][0] = *(LAS3 const bf16x8*)(lds + SA_(b, h) + a_rd0 + _m * 2048); \
        dst[_m][1] = *(LAS3 const bf16x8*)(lds + SA_(b, h) + a_rd1 + _m * 2048); } } while (0)
#define LDB_(dst, b, h) do { _Pragma("unroll") for (int _n = 0; _n < 2; ++_n) { \
        dst[_n][0] = *(LAS3 const bf16x8*)(lds + SB_(b, h) + b_rd0 + _n * 8192); \
        dst[_n][1] = *(LAS3 const bf16x8*)(lds + SB_(b, h) + b_rd1 + _n * 8192); } } while (0)
#define MMA(ai, bj, Af, Bf) do { __builtin_amdgcn_s_setprio(1); \
        _Pragma("unroll") for (int _m = 0; _m < 4; ++_m) _Pragma("unroll") for (int _n = 0; _n < 2; ++_n) _Pragma("unroll") for (int _k = 0; _k < 2; ++_k) \
            acc[ai][bj][_m][_n] = __builtin_amdgcn_mfma_f32_16x16x32_bf16(Bf[_n][_k], Af[_m][_k], acc[ai][bj][_m][_n], 0, 0, 0); \
        __builtin_amdgcn_s_setprio(0); } while (0)

    f32x4 blo[4], bhi[4];
    bf16x8 At[4][2], B0[2][2], B1[2][2];
#pragma unroll
    for (int ai = 0; ai < 2; ++ai)
#pragma unroll
        for (int bj = 0; bj < 2; ++bj)
#pragma unroll
            for (int m = 0; m < 4; ++m)
#pragma unroll
                for (int n = 0; n < 2; ++n) acc[ai][bj][m][n] = (f32x4){0.f, 0.f, 0.f, 0.f};

    __builtin_amdgcn_s_waitcnt(0);
    const int p1 = (1 < nt) ? 1 : 0;
    BLOAD2(blo, 0, 0); BLOAD2(blo, 0, 2); BLOAD2(bhi, 0, 4); BLOAD2(bhi, 0, 6); STAGE_A(0, 0, 0); STAGE_A(0, 1, 0);
    BWAIT(blo, 4); BWAIT(bhi, 4); BWRITE_H(blo, 0, 0); BWRITE_H(bhi, 0, 1);
    BLOAD2(blo, p1, 0); BLOAD2(blo, p1, 2); STAGE_A(1, 0, p1); BLOAD2(bhi, p1, 4);
    G_WAIT_V(2);
    G_WAIT_L(0);
    { int wr1 = wid >> 2; asm volatile("" : "+s"(wr1)); if (wr1 == 1) G_BAR; }
    G_BAR;
    for (int t = 0; t < nt; t += 2) {
        const int t1 = (t + 1 < nt) ? t + 1 : nt - 1, t2 = (t + 2 < nt) ? t + 2 : nt - 1, t3 = (t + 3 < nt) ? t + 3 : nt - 1;
        LDB_(B0, 0, 0); G_SCHED; LDA(At, 0, 0); BLOAD2(bhi, t1, 6); STAGE_A(1, 1, t1);
        G_WAIT_L(8); G_BAR; G_WAIT_L(0); MMA(0, 0, At, B0); G_BAR; G_SCHED;
        LDB_(B1, 0, 1); BWAIT(blo, 8); BWRITE_H(blo, 1, 0); BLOAD2(blo, t2, 0);
        G_BAR; G_WAIT_L(0); MMA(0, 1, At, B1); G_BAR;
        LDA(At, 0, 1); BLOAD2(blo, t2, 2); STAGE_A(0, 0, t2);
        G_BAR; G_WAIT_L(0); MMA(1, 0, At, B0); G_BAR; G_SCHED;
        BWAIT(bhi, 8); BWRITE_H(bhi, 1, 1); BLOAD2(bhi, t2, 4);
        G_WAIT_V(8); G_WAIT_L(0); G_BAR; MMA(1, 1, At, B1); G_BAR;
        LDB_(B0, 1, 0); G_SCHED; LDA(At, 1, 0); BLOAD2(bhi, t2, 6); STAGE_A(0, 1, t2);
        G_WAIT_L(8); G_BAR; G_WAIT_L(0); MMA(0, 0, At, B0); G_BAR; G_SCHED;
        LDB_(B1, 1, 1); BWAIT(blo, 8); BWRITE_H(blo, 0, 0); BLOAD2(blo, t3, 0);
        G_BAR; G_WAIT_L(0); MMA(0, 1, At, B1); G_BAR;
        LDA(At, 1, 1); BLOAD2(blo, t3, 2); STAGE_A(1, 0, t3);
        G_BAR; G_WAIT_L(0); MMA(1, 0, At, B0); G_BAR; G_SCHED;
        BWAIT(bhi, 8); BWRITE_H(bhi, 0, 1); BLOAD2(bhi, t3, 4);
        G_WAIT_V(8); G_WAIT_L(0); G_BAR; MMA(1, 1, At, B1); G_BAR;
    }
    G_WAIT_V(0); G_WAIT_L(0);
    { int wr0 = wid >> 2; asm volatile("" : "+s"(wr0)); if (wr0 == 0) G_BAR; }
    G_BAR;
#undef SA_
#undef SB_
#undef STAGE_A
#undef BLOAD2
#undef BWRITE_H
#undef BWAIT
#undef LDA
#undef LDB_
#undef MMA
}

typedef int v8i32 __attribute__((ext_vector_type(8)));
typedef short v2s16 __attribute__((ext_vector_type(2)));
typedef int i32x4 __attribute__((ext_vector_type(4)));
#ifndef F8_WSCALE
#define F8_WSCALE 0.00390625f
#endif
template <int LDB, int ROWB = 0>
__device__ __forceinline__ void gemm_kloop_f8(f32x4 (&acc)[2][2][4][2], const unsigned char* __restrict__ A, const unsigned (&aoff)[2][2],
                                              const float* __restrict__ B, unsigned boff, int nt, LAS3 char* lds, int tid, int wid, unsigned char* __restrict__ img, int pam = 1, int pbm = 1) {
    const int lane = tid & 63, wr = wid >> 2, wc = wid & 3, fr = lane & 15, fq = lane >> 4;
    const int c0 = fq ^ (fr >> 1);
    const int a_rd0 = (wr * 64 + fr) * 128 + c0 * 16, a_rd1 = (wr * 64 + fr) * 128 + (c0 ^ 4) * 16;
    const int b_rd0 = (wc * 16 + fr) * 128 + ((c0 ^ (wc & 1)) * 16), b_rd1 = (wc * 16 + fr) * 128 + ((c0 ^ (wc & 1) ^ 4) * 16);
    const int k8 = wid, n4 = tid & 63, bhalf = n4 >> 5, nloc = (n4 & 31) * 4;
    const int sw0 = (((n4 & 3) * 2) & 7) ^ ((n4 >> 2) & 1), sw1 = (((n4 & 3) * 2 + 1) & 7) ^ ((n4 >> 2) & 1);
    const int b_wr0 = (4 + bhalf) * GHTB + nloc * 128 + ((k8 ^ sw0) << 4);
    const int b_wr1 = (4 + bhalf) * GHTB + (nloc + 2) * 128 + ((k8 ^ sw1) << 4);
    const unsigned boffb = boff * 4u;
    const unsigned lds_u = (unsigned)(unsigned long)lds;
    const unsigned bw_a0 = lds_u + (unsigned)b_wr0, bw_a1 = lds_u + (unsigned)b_wr1;
    const int a_dma0 = wid * 1024, a_dma1 = (8 + wid) * 1024;
    const size_t bstep = (size_t)128 * LDB * pbm, astepb = (size_t)128 * pam;
    const unsigned cp_lds = lds_u + 4 * GHTB + (unsigned)wid * 4096u + (unsigned)lane * 16u;
    const unsigned char* cp_g = (const unsigned char*)((uintptr_t)img - (uintptr_t)(lds_u + 4 * GHTB));
    u32x4 cp0, cp1;
#define CPRD(b, h) asm volatile("ds_read_b128 %0, %2 offset:%3\n\tds_read_b128 %1, %2 offset:%4" : "=&v"(cp0), "=&v"(cp1) : "v"(cp_lds), "n"((b) * 2 * GHTB + (h) * 2048), "n"((b) * 2 * GHTB + (h) * 2048 + 1024) : "memory")
#define CPST(tc, h) asm volatile("s_nop 4\n\tglobal_store_dwordx4 %2, %0, %3\n\tglobal_store_dwordx4 %2, %1, %3 offset:1024" :: "v"(cp0), "v"(cp1), "v"(cp_lds), "s"(cp_g + (size_t)(tc) * 32768 + (h) * 2048) : "memory")

#define SA_(b, h) (((b) * 2 + (h)) * GHTB)
#define SB_(b, h) ((4 + (b) * 2 + (h)) * GHTB)
#define STAGE_A(b, h, kt) do { const unsigned char* _g = A + (size_t)(kt) * astepb; \
        dma16((const void*)(_g + (size_t)((h) * 128) * ROWB), ROWB ? aoff[0][0] : aoff[h][0], lds_u + SA_(b, h) + a_dma0); \
        dma16((const void*)(_g + (size_t)((h) * 128 + 64) * ROWB), ROWB ? aoff[0][0] : aoff[h][1], lds_u + SA_(b, h) + a_dma1); } while (0)
#define QLOAD(R, kt, q) do { \
        asm volatile("s_nop 4\n\tglobal_load_dwordx4 %0, %2, %3\n\tglobal_load_dwordx4 %1, %2, %4" : "=&v"(R[0]), "=&v"(R[1]) \
            : "v"(boffb), "s"(B + (size_t)(kt) * bstep + (size_t)(4 * (q)) * LDB), "s"(B + (size_t)(kt) * bstep + (size_t)(4 * (q) + 1) * LDB) : "memory"); \
        asm volatile("s_nop 4\n\tglobal_load_dwordx4 %0, %2, %3\n\tglobal_load_dwordx4 %1, %2, %4" : "=&v"(R[2]), "=&v"(R[3]) \
            : "v"(boffb), "s"(B + (size_t)(kt) * bstep + (size_t)(4 * (q) + 2) * LDB), "s"(B + (size_t)(kt) * bstep + (size_t)(4 * (q) + 3) * LDB) : "memory"); } while (0)
#define QWAIT4(R, n) QWAIT(R, n)
#define QWAIT(R, n) asm volatile("s_waitcnt vmcnt(" #n ")" : "+v"(R[0]), "+v"(R[1]), "+v"(R[2]), "+v"(R[3]) :: "memory")
#define QCVTW(R, b, q) do { _Pragma("unroll") for (int _i = 0; _i < 4; ++_i) { \
            cvd = __builtin_amdgcn_cvt_scalef32_pk_fp8_f32(cvd, R[0][_i], R[1][_i], F8_WSCALE, false); \
            cvd = __builtin_amdgcn_cvt_scalef32_pk_fp8_f32(cvd, R[2][_i], R[3][_i], F8_WSCALE, true); \
            asm volatile("ds_write_b32 %0, %1 offset:%2" :: "v"((_i < 2) ? bw_a0 : bw_a1), "v"(cvd), "n"((b) * 2 * GHTB + (_i & 1) * 128 + (q) * 4) : "memory"); } } while (0)
#define LDA1(dst, b, h, m) do { \
        dst.lo = *(LAS3 const i32x4*)(lds + SA_(b, h) + a_rd0 + (m) * 2048); \
        dst.hi = *(LAS3 const i32x4*)(lds + SA_(b, h) + a_rd1 + (m) * 2048); } while (0)
#define LDB4(dst, b) do { _Pragma("unroll") for (int _h = 0; _h < 2; ++_h) _Pragma("unroll") for (int _n = 0; _n < 2; ++_n) { \
        dst[_h * 2 + _n].lo = *(LAS3 const i32x4*)(lds + SB_(b, _h) + b_rd0 + _n * 8192); \
        dst[_h * 2 + _n].hi = *(LAS3 const i32x4*)(lds + SB_(b, _h) + b_rd1 + _n * 8192); } } while (0)
#define MF4(ai, m, slot) do { _Pragma("unroll") for (int _j = 0; _j < 4; ++_j) \
            acc[ai][_j >> 1][m][_j & 1] = __builtin_amdgcn_mfma_scale_f32_16x16x128_f8f6f4(Bx[_j], slot, acc[ai][_j >> 1][m][_j & 1], 0, 0, 0, 0x7f7f7f77, 1, 0x7f7f7f77); } while (0)
#define MMA16(ai, b, h) do { __builtin_amdgcn_s_setprio(1); MF4(ai, 0, A0); G_SCHED; LDA1(A0, b, h, 2); G_SCHED; MF4(ai, 1, A1); G_SCHED; LDA1(A1, b, h, 3); G_SCHED; \
        G_WAIT_L(2); MF4(ai, 2, A0); G_SCHED; G_WAIT_L(0); MF4(ai, 3, A1); __builtin_amdgcn_s_setprio(0); } while (0)
#define MMA16C(ai, b, h, tc) do { __builtin_amdgcn_s_setprio(1); MF4(ai, 0, A0); G_SCHED; LDA1(A0, b, h, 2); CPRD(b, 0); G_SCHED; MF4(ai, 1, A1); G_SCHED; LDA1(A1, b, h, 3); G_SCHED; \
        G_WAIT_L(2); MF4(ai, 2, A0); G_SCHED; CPST(tc, 0); CPRD(b, 1); G_WAIT_L(2); MF4(ai, 3, A1); G_SCHED; G_WAIT_L(0); CPST(tc, 1); __builtin_amdgcn_s_setprio(0); } while (0)

    f32x4 s0[4], s1[4];
    v2s16 cvd; asm("" : "=v"(cvd));
    v8i32 A0, A1, Bx[4];
#pragma unroll
    for (int ai = 0; ai < 2; ++ai)
#pragma unroll
        for (int bj = 0; bj < 2; ++bj)
#pragma unroll
            for (int m = 0; m < 4; ++m)
#pragma unroll
                for (int n = 0; n < 2; ++n) acc[ai][bj][m][n] = (f32x4){0.f, 0.f, 0.f, 0.f};

    const int p1 = (1 < nt) ? 1 : 0;
    QLOAD(acc[0][0][0], 0, 0); QLOAD(acc[0][0][2], 0, 1); QLOAD(acc[0][1][0], 0, 2); QLOAD(acc[0][1][2], 0, 3);
    STAGE_A(0, 0, 0); STAGE_A(0, 1, 0);
    QLOAD(s0, p1, 0); QLOAD(s1, p1, 1);
    __builtin_amdgcn_s_waitcnt(0);
    QWAIT4(acc[0][0][0], 0); QWAIT4(acc[0][0][2], 0); QWAIT4(acc[0][1][0], 0); QWAIT4(acc[0][1][2], 0); QWAIT(s0, 0); QWAIT(s1, 0);
    QCVTW(acc[0][0][0], 0, 0); QCVTW(acc[0][0][2], 0, 1); QCVTW(acc[0][1][0], 0, 2); QCVTW(acc[0][1][2], 0, 3);
#pragma unroll
    for (int bj = 0; bj < 2; ++bj)
#pragma unroll
        for (int m = 0; m < 4; ++m)
#pragma unroll
            for (int n = 0; n < 2; ++n) acc[0][bj][m][n] = (f32x4){0.f, 0.f, 0.f, 0.f};
    G_WAIT_L(0);
    { int wr1 = wid >> 2; asm volatile("" : "+s"(wr1)); if (wr1 == 1) G_BAR; }
    G_BAR;
#define KTILE(b, tc, tn1, tn2) do { \
          \
        LDB4(Bx, b); G_SCHED; LDA1(A0, b, 0, 0); LDA1(A1, b, 0, 1); \
        QWAIT(s0, 6); QCVTW(s0, (b) ^ 1, 0); QLOAD(s0, tn1, 2); QWAIT(s1, 6); QCVTW(s1, (b) ^ 1, 1); QLOAD(s1, tn1, 3); STAGE_A((b) ^ 1, 0, tn1); \
        G_WAIT_V(10); G_BAR; G_WAIT_L(0); MMA16C(0, b, 0, tc); G_BAR; G_SCHED; \
          \
        LDA1(A0, b, 1, 0); LDA1(A1, b, 1, 1); \
        QWAIT(s0, 10); QCVTW(s0, (b) ^ 1, 2); QLOAD(s0, tn2, 0); QWAIT(s1, 10); QCVTW(s1, (b) ^ 1, 3); QLOAD(s1, tn2, 1); STAGE_A((b) ^ 1, 1, tn1); \
        G_WAIT_V(14); G_WAIT_L(0); G_BAR; MMA16(1, b, 1); G_BAR; G_SCHED; } while (0)
    for (int t = 0; t < nt; t += 2) {
        const int t1 = (t + 1 < nt) ? t + 1 : nt - 1, t2 = (t + 2 < nt) ? t + 2 : nt - 1, t3 = (t + 3 < nt) ? t + 3 : nt - 1;
        KTILE(0, t, t1, t2);
        KTILE(1, t1, t2, t3);
    }
    G_WAIT_V(0); G_WAIT_L(0);
    { int wr0 = wid >> 2; asm volatile("" : "+s"(wr0)); if (wr0 == 0) G_BAR; }
    G_BAR;
#undef KTILE
#undef SA_
#undef SB_
#undef STAGE_A
#undef QLOAD
#undef QWAIT
#undef QCVTW
#undef LDA1
#undef MF4
#undef MMA16
#undef MMA16C
#undef LDB4
#undef QWAIT4
#undef CPRD
#undef CPST
}


__device__ __forceinline__ int lane_id() { int r; asm volatile("v_mbcnt_lo_u32_b32 %0, -1, 0\n\tv_mbcnt_hi_u32_b32 %0, -1, %0" : "=v"(r)); return r; }
#define SWZ_XOR(v, o) __int_as_float(__builtin_amdgcn_ds_swizzle(__float_as_int(v), ((o) << 10) | 0x1F))
__device__ __forceinline__ float half_sum32(float v) {
    v += SWZ_XOR(v, 16); v += SWZ_XOR(v, 8); v += SWZ_XOR(v, 4); v += SWZ_XOR(v, 2); v += SWZ_XOR(v, 1);
    return v;
}
__device__ __forceinline__ float xor32(float v) { const int l = lane_id(); return __int_as_float(__builtin_amdgcn_ds_bpermute((l ^ 32) << 2, __float_as_int(v))); }
__device__ __forceinline__ float wave_sum(float v) { v = half_sum32(v); return v + xor32(v); }
typedef int v8i32d __attribute__((ext_vector_type(8)));
typedef int i32x4d __attribute__((ext_vector_type(4)));
template <bool F8, bool BSW = false, int ROWB = 0, bool ACCUM = false>
__device__ __forceinline__ void gemm_kloop_dma(f32x4 (&acc)[2][2][4][2], const unsigned char* __restrict__ A, const unsigned (&aoff)[2][2],
                                               const unsigned char* __restrict__ img, int nt, LAS3 char* lds, int tid, int wid, int kbase = 0) {
    constexpr int KMASK = F8 ? 15 : 31;
#define KT_(kt) ((kbase + (kt)) & KMASK)
    const int lane = tid & 63, wr = wid >> 2, wc = wid & 3, fr = lane & 15, fq = lane >> 4;
    const int c0 = fq ^ (fr >> 1);
    const int a_rd0 = (wr * 64 + fr) * 128 + c0 * 16, a_rd1 = (wr * 64 + fr) * 128 + (c0 ^ 4) * 16;
    const int cb = BSW ? (c0 ^ (wc & 1)) : c0;
    const int b_rd0 = (wc * 16 + fr) * 128 + cb * 16, b_rd1 = (wc * 16 + fr) * 128 + (cb ^ 4) * 16;
    const unsigned lds_u = (unsigned)(unsigned long)lds;
    LAS3 const char* ap0 = lds + a_rd0; LAS3 const char* ap1 = lds + a_rd1; LAS3 const char* bp0 = lds + 4 * GHTB + b_rd0; LAS3 const char* bp1 = lds + 4 * GHTB + b_rd1;
    asm volatile("" : "+v"(ap0), "+v"(ap1), "+v"(bp0), "+v"(bp1));
    const int dma0 = wid * 1024, dma1 = (8 + wid) * 1024;
    const unsigned boffl = (unsigned)lane * 16u;

#define SA_(b, h) (((b) * 2 + (h)) * GHTB)
#define SB_(b, h) ((4 + (b) * 2 + (h)) * GHTB)
#define STG_A(b, h, kt) do { const unsigned char* _g = A + (size_t)KT_(kt) * 128; \
        dma16((const void*)(_g + (size_t)((h) * 128) * ROWB), ROWB ? aoff[0][0] : aoff[h][0], lds_u + SA_(b, h) + dma0); \
        dma16((const void*)(_g + (size_t)((h) * 128 + 64) * ROWB), ROWB ? aoff[0][0] : aoff[h][1], lds_u + SA_(b, h) + dma1); } while (0)
#define STG_B(b, h, kt) do { const unsigned char* _g = img + (size_t)KT_(kt) * 32768 + (h) * 16384; \
        dma16((const void*)(_g + dma0), boffl, lds_u + SB_(b, h) + dma0); \
        dma16((const void*)(_g + dma1), boffl, lds_u + SB_(b, h) + dma1); } while (0)
#define LDA_(dst, b, h) do { _Pragma("unroll") for (int _m = 0; _m < 4; ++_m) { \
        dst[_m].lo = *(LAS3 const i32x4d*)(ap0 + SA_(b, h) + _m * 2048); \
        dst[_m].hi = *(LAS3 const i32x4d*)(ap1 + SA_(b, h) + _m * 2048); } } while (0)
#define LDBF(dst, b, h) do { _Pragma("unroll") for (int _n = 0; _n < 2; ++_n) { \
        dst[_n].lo = *(LAS3 const i32x4d*)(bp0 + (SB_(b, h) - 4 * GHTB) + _n * 8192); \
        dst[_n].hi = *(LAS3 const i32x4d*)(bp1 + (SB_(b, h) - 4 * GHTB) + _n * 8192); } } while (0)
#define MMAD(ai, bj, Af, Bf) do { __builtin_amdgcn_s_setprio(1); \
        _Pragma("unroll") for (int _m = 0; _m < 4; ++_m) _Pragma("unroll") for (int _n = 0; _n < 2; ++_n) { \
            if (F8) acc[ai][bj][_m][_n] = __builtin_amdgcn_mfma_scale_f32_16x16x128_f8f6f4(Bf[_n], Af[_m], acc[ai][bj][_m][_n], 0, 0, 0, 0x7f7f7f77, 1, 0x7f7f7f77); \
            else { const i32x4d _bl = Bf[_n].lo, _bh = Bf[_n].hi, _al = Af[_m].lo, _ah = Af[_m].hi;     \
                   acc[ai][bj][_m][_n] = __builtin_amdgcn_mfma_f32_16x16x32_bf16(__builtin_bit_cast(bf16x8, _bl), __builtin_bit_cast(bf16x8, _al), acc[ai][bj][_m][_n], 0, 0, 0); \
                   acc[ai][bj][_m][_n] = __builtin_amdgcn_mfma_f32_16x16x32_bf16(__builtin_bit_cast(bf16x8, _bh), __builtin_bit_cast(bf16x8, _ah), acc[ai][bj][_m][_n], 0, 0, 0); } } \
        __builtin_amdgcn_s_setprio(0); } while (0)

    v8i32d At[4], B0[2], B1[2];
    if (!ACCUM)
#pragma unroll
    for (int ai = 0; ai < 2; ++ai)
#pragma unroll
        for (int bj = 0; bj < 2; ++bj)
#pragma unroll
            for (int m = 0; m < 4; ++m)
#pragma unroll
                for (int n = 0; n < 2; ++n) acc[ai][bj][m][n] = (f32x4){0.f, 0.f, 0.f, 0.f};
    STG_B(0, 0, 0); STG_A(0, 0, 0); STG_B(0, 1, 0); STG_A(0, 1, 0);
    __builtin_amdgcn_s_waitcnt(0);
    { int wr1 = wid >> 2; asm volatile("" : "+s"(wr1)); if (wr1 == 1) G_BAR; }
    G_BAR;
    { const int p1 = (1 < nt) ? 1 : 0; STG_B(1, 0, p1); STG_A(1, 0, p1); STG_B(1, 1, p1); }
    G_WAIT_V(6); G_BAR;
    for (int t = 0; t < nt; t += 2) {
        const int t1 = (t + 1 < nt) ? t + 1 : nt - 1, t2 = (t + 2 < nt) ? t + 2 : nt - 1, t3 = (t + 3 < nt) ? t + 3 : nt - 1;
        LDBF(B0, 0, 0); G_SCHED; LDA_(At, 0, 0); STG_A(1, 1, t1);
        G_WAIT_L(8); G_BAR; G_WAIT_L(0); MMAD(0, 0, At, B0); G_BAR; G_SCHED;
        LDBF(B1, 0, 1); STG_B(0, 0, t2);
        G_BAR; G_WAIT_L(0); MMAD(0, 1, At, B1); G_BAR;
        LDA_(At, 0, 1); STG_A(0, 0, t2);
        G_BAR; G_WAIT_L(0); MMAD(1, 0, At, B0); G_BAR; G_SCHED;
        STG_B(0, 1, t2);
        G_WAIT_V(6); G_BAR; MMAD(1, 1, At, B1); G_BAR;
        LDBF(B0, 1, 0); G_SCHED; LDA_(At, 1, 0); STG_A(0, 1, t2);
        G_WAIT_L(8); G_BAR; G_WAIT_L(0); MMAD(0, 0, At, B0); G_BAR; G_SCHED;
        LDBF(B1, 1, 1); STG_B(1, 0, t3);
        G_BAR; G_WAIT_L(0); MMAD(0, 1, At, B1); G_BAR;
        LDA_(At, 1, 1); STG_A(1, 0, t3);
        G_BAR; G_WAIT_L(0); MMAD(1, 0, At, B0); G_BAR; G_SCHED;
        STG_B(1, 1, t3);
        G_WAIT_V(6); G_BAR; MMAD(1, 1, At, B1); G_BAR;
    }
    G_WAIT_V(0); G_WAIT_L(0);
    { int wr0 = wid >> 2; asm volatile("" : "+s"(wr0)); if (wr0 == 0) G_BAR; }
    G_BAR;
#undef SA_
#undef SB_
#undef STG_A
#undef STG_B
#undef LDA_
#undef LDBF
#undef MMAD
#undef KT_
}

template <bool F8, int LDB>
__device__ __forceinline__ void convert_tile(const float* __restrict__ W, int col0, int col1, int nkt, unsigned char* __restrict__ img, LAS3 char* lds, int wid) {
    constexpr int RPT = F8 ? 16 : 8;
    int lane = lane_id(); asm volatile("" : "+v"(lane));
    const int n4 = lane, half = n4 >> 5, nloc = (n4 & 31) * 4;
    const float* src = W + (size_t)(wid * RPT) * LDB + ((n4 < 32) ? col0 + n4 * 4 : col1 + (n4 - 32) * 4);
    for (int kt = 0; kt < nkt; ++kt) {
        f32x4 r[RPT];
#pragma unroll
        for (int j = 0; j < RPT; ++j) r[j] = *(const f32x4*)(src + (size_t)(kt * (RPT * 8) + j) * LDB);
        LAS3 char* buf = lds + (kt & 1) * 32768;
#pragma unroll
        for (int i = 0; i < 4; ++i) {
            u32x4 w;
            if (F8) {
#pragma unroll
                for (int q = 0; q < 4; ++q) {
                    int d = __builtin_amdgcn_cvt_pk_fp8_f32(r[4 * q][i] * 256.0f, r[4 * q + 1][i] * 256.0f, 0, false);
                    d = __builtin_amdgcn_cvt_pk_fp8_f32(r[4 * q + 2][i] * 256.0f, r[4 * q + 3][i] * 256.0f, d, true);
                    w[q] = (unsigned)d;
                }
            } else {
                w.x = cvt_pk_bf16(r[0][i], r[1][i]); w.y = cvt_pk_bf16(r[2][i], r[3][i]); w.z = cvt_pk_bf16(r[4][i], r[5][i]); w.w = cvt_pk_bf16(r[6][i], r[7][i]);
            }
            const int row = nloc + i;
            *(LAS3 u32x4*)(buf + half * 16384 + row * 128 + ((wid ^ ((row >> 1) & 7)) << 4)) = w;
        }
        __syncthreads();
#pragma unroll
        for (int j = 0; j < 4; ++j) {
            const u32x4 v = *(LAS3 const u32x4*)(buf + wid * 4096 + j * 1024 + lane * 16);
            *(u32x4*)(img + (size_t)kt * 32768 + wid * 4096 + j * 1024 + lane * 16) = v;
        }
    }
    __syncthreads();
}

__device__ __forceinline__ float gelu_exact(float x) { return 0.5f * x * (1.0f + erff(x * 0.70710678118654752f)); }
__device__ __forceinline__ float bf2f(bf16_t v) { return __uint_as_float((unsigned)v << 16); }
__device__ __forceinline__ bf16_t f2bf(float v) { return (bf16_t)(cvt_pk_bf16(v, 0.f) & 0xffffu); }

struct GemmArgs {
    const bf16_t* A; const float* B; const float* bias; const float* R;
    void* C;
    const int* list; const int* cnt;
    int* done;
};

constexpr int EST_BF16 = 528;
constexpr int EST_F8 = 144;
constexpr int LDS_BIAS = 256 * EST_BF16 + 3072;
__device__ __forceinline__ void epi_stage_bf16(const f32x4 (&v)[2][2], int r, int colw, LAS3 char* lds) {
#pragma unroll
    for (int bj = 0; bj < 2; ++bj)
#pragma unroll
        for (int n = 0; n < 2; ++n) { u32x2 o; o.x = cvt_pk_bf16(v[bj][n][0], v[bj][n][1]); o.y = cvt_pk_bf16(v[bj][n][2], v[bj][n][3]);
            *(LAS3 u32x2*)(lds + r * EST_BF16 + (bj * 128 + n * 64 + colw) * 2) = o; }
}
__device__ __forceinline__ void epi_flush_bf16(bf16_t* C, size_t ld, int grow0, int col0, int nvalid, LAS3 char* lds, int tid) {
    __syncthreads();
    const int chunk = tid & 31, r0 = tid >> 5;
#pragma unroll 4
    for (int it = 0; it < 16; ++it) { const int row = it * 16 + r0;
        if (row < nvalid) { const u32x4 q = *(LAS3 const u32x4*)(lds + row * EST_BF16 + chunk * 16); *(u32x4*)(C + (size_t)(grow0 + row) * ld + col0 + chunk * 8) = q; } }
    __syncthreads();
}
__device__ __forceinline__ void epi_flush_f8(unsigned char* C, size_t ld, int grow0, int col0, int nvalid, LAS3 char* lds, int tid) {
    __syncthreads();
    const int chunk = tid & 7, r0 = tid >> 3;
#pragma unroll
    for (int it = 0; it < 4; ++it) { const int row = it * 64 + r0;
        if (row < nvalid) { const u32x4 q = *(LAS3 const u32x4*)(lds + row * EST_F8 + chunk * 16);
            const unsigned off = (unsigned)(grow0 + row) * (unsigned)ld + (unsigned)(col0 + chunk * 16);
            asm volatile("s_nop 4\n\tglobal_store_dwordx4 %0, %1, %2 sc1\n\ts_nop 1" :: "v"(off), "v"(q), "s"(C) : "memory"); } }
    asm volatile("s_waitcnt vmcnt(0)" ::: "memory");
    __syncthreads();
}

constexpr int EST_F8W = 272;
__device__ __forceinline__ void epi_flush_f8w(unsigned char* C, size_t ld, int grow0, int col0, int nvalid, LAS3 char* lds, int tid) {
    __syncthreads();
    const int chunk = tid & 15, r0 = tid >> 4;
#pragma unroll
    for (int it = 0; it < 8; ++it) { const int row = it * 32 + r0;
        if (row < nvalid) { const u32x4 q = *(LAS3 const u32x4*)(lds + row * EST_F8W + chunk * 16); *(u32x4*)(C + (size_t)(grow0 + row) * ld + col0 + chunk * 16) = q; } }
    __syncthreads();
}
template <int EPI, int VAR = 0>
__device__ __forceinline__ void gemm_tile(const GemmArgs& g, int pm, int pn, int e, int ebase, int ecnt, LAS3 char* lds, int wid, unsigned char* img) {
    constexpr int LDB = (EPI == 0) ? DIN : (EPI == 2) ? 2 * DFF : D;
    int tid = wid * 64 + lane_id(); asm volatile("" : "+v"(tid));
    const int lane = tid & 63;
    unsigned aoff[2][2];
#pragma unroll
    for (int h = 0; h < 2; ++h)
#pragma unroll
        for (int i = 0; i < 2; ++i) {
            const int rih = (i * 8 + wid) * 8 + (lane >> 3);
            const int chunk = (lane & 7) ^ ((rih >> 1) & 7);
            int r = pm * 256 + h * 128 + rih;
            unsigned grow;
            if (EPI == 2) { if (r >= ecnt) r = ecnt - 1; grow = (unsigned)(g.list[e * T + r] >> 2); }
            else if (EPI == 3) { if (r >= ecnt) r = ecnt - 1; grow = (unsigned)(ebase + r); }
            else grow = (unsigned)r;
            aoff[h][i] = (EPI >= 2) ? (grow * (unsigned)D + (unsigned)(chunk * 16)) : (grow * (unsigned)D + (unsigned)(chunk * 8)) * 2u;
        }
    const int k8 = wid, n4 = tid & 63;
    int col;
    if (EPI == 2) col = (n4 < 32) ? pn * 128 + n4 * 4 : DFF + pn * 128 + (n4 - 32) * 4;
    else col = pn * 256 + n4 * 4;
    const unsigned boff = (unsigned)(k8 * ((EPI >= 2) ? 16 : 8)) * (unsigned)LDB + (unsigned)col;
    const float* Bp = g.B;
    if (EPI == 2) Bp += (size_t)e * D * (2 * DFF);
    if (EPI == 3) Bp += (size_t)e * DFF * D;
    if (EPI >= 2 && tid < 256) {
        float bvv;
        if (EPI == 2) bvv = (tid < 128) ? g.bias[(size_t)e * (2 * DFF) + pn * 128 + tid] : g.bias[(size_t)e * (2 * DFF) + DFF + pn * 128 + (tid - 128)] + 1.0f;
        else bvv = g.bias[(size_t)e * D + pn * 256 + tid];
        *(LAS3 float*)(lds + LDS_BIAS + tid * 4) = bvv;
    }
    if (EPI == 3) {
        if (tid == 0) { const int need = 16 * ((ecnt + 255) >> 8); unsigned sp = 0;
            while (__hip_atomic_load(g.done + e, __ATOMIC_RELAXED, __HIP_MEMORY_SCOPE_AGENT) < need) { __builtin_amdgcn_s_sleep(8); if (++sp > (1u << 20)) break; }
            __builtin_amdgcn_fence(__ATOMIC_ACQUIRE, "agent"); asm volatile("s_waitcnt vmcnt(0)" ::: "memory"); }
        __syncthreads();
    }
    f32x4 acc[2][2][4][2];
    if (EPI >= 2) gemm_kloop_f8<LDB, 0>(acc, (const unsigned char*)g.A, aoff, Bp, boff, D / 128, lds, tid, wid, img);
    else gemm_kloop<LDB, VAR>(acc, g.A, aoff, Bp, boff, D / GBK, lds, tid, wid);
    int tz = wid * 64 + lane_id(); asm volatile("" : "+v"(tz));
    const int wid2 = tz >> 6, lane2 = tz & 63;
    const int row0 = (wid2 >> 2) * 64 + (lane2 & 15), colw = (wid2 & 3) * 16 + (lane2 >> 4) * 4;
    if (EPI == 0) {
#pragma unroll
        for (int ai = 0; ai < 2; ++ai)
#pragma unroll
            for (int m = 0; m < 4; ++m) {
                f32x4 v[2][2];
#pragma unroll
                for (int bj = 0; bj < 2; ++bj)
#pragma unroll
                    for (int n = 0; n < 2; ++n) v[bj][n] = acc[ai][bj][m][n];
                epi_stage_bf16(v, ai * 128 + row0 + m * 16, colw, lds);
            }
        epi_flush_bf16((bf16_t*)g.C, DIN, pm * 256, pn * 256, 256, lds, tz);
    } else if (EPI == 1) {
        float* C = (float*)g.C;
#pragma unroll
        for (int ai = 0; ai < 2; ++ai)
#pragma unroll
            for (int m = 0; m < 4; ++m) {
                const size_t ro = (size_t)(pm * 256 + ai * 128 + row0 + m * 16) * D + pn * 256 + colw;
#pragma unroll
                for (int bj = 0; bj < 2; ++bj)
#pragma unroll
                    for (int n = 0; n < 2; ++n) { const f32x4 xr = *(const f32x4*)(g.R + ro + bj * 128 + n * 64);
                        *(f32x4*)(C + ro + bj * 128 + n * 64) = acc[ai][bj][m][n] + xr; }
            }
    } else if (EPI == 2) {
        unsigned char* C = (unsigned char*)g.C;
        f32x4 bgate[2], bup1[2];
#pragma unroll
        for (int n = 0; n < 2; ++n) { bgate[n] = *(LAS3 const f32x4*)(lds + LDS_BIAS + (n * 64 + colw) * 4); bup1[n] = *(LAS3 const f32x4*)(lds + LDS_BIAS + (128 + n * 64 + colw) * 4); }
#pragma unroll
        for (int ai = 0; ai < 2; ++ai)
#pragma unroll
            for (int m = 0; m < 4; ++m) {
                const int r = pm * 256 + ai * 128 + row0 + m * 16;
                {
                    LAS3 char* rp = lds + (ai * 128 + row0 + m * 16) * EST_F8 + colw;
#pragma unroll
                    for (int n = 0; n < 2; ++n) {
                        float o[4];
#pragma unroll
                        for (int j = 0; j < 4; j += 2) {
                            typedef float f32x2 __attribute__((ext_vector_type(2)));
                            f32x2 gt = (f32x2){acc[ai][0][m][n][j], acc[ai][0][m][n][j + 1]} + (f32x2){bgate[n][j], bgate[n][j + 1]};
                            f32x2 up = (f32x2){acc[ai][1][m][n][j], acc[ai][1][m][n][j + 1]} + (f32x2){bup1[n][j], bup1[n][j + 1]};
                            gt.x = fminf(gt.x, 7.0f); gt.y = fminf(gt.y, 7.0f);
                            up.x = __builtin_amdgcn_fmed3f(up.x, -6.0f, 8.0f); up.y = __builtin_amdgcn_fmed3f(up.y, -6.0f, 8.0f);
                            const f32x2 xe = gt * (-2.45546696f);
                            f32x2 ex; ex.x = __builtin_amdgcn_exp2f(xe.x); ex.y = __builtin_amdgcn_exp2f(xe.y);
                            const f32x2 den = ex + 1.0f;
                            f32x2 rc; rc.x = __builtin_amdgcn_rcpf(den.x); rc.y = __builtin_amdgcn_rcpf(den.y);
                            const f32x2 res = (gt * rc) * up;
                            o[j] = res.x; o[j + 1] = res.y;
                        }
                        int w = __builtin_amdgcn_cvt_pk_fp8_f32(o[0], o[1], 0, false);
                        w = __builtin_amdgcn_cvt_pk_fp8_f32(o[2], o[3], w, true);
                        *(LAS3 int*)(rp + n * 64) = w;
                    }
                }
            }
        { const int nv = ecnt - pm * 256; epi_flush_f8(C, DFF, ebase + pm * 256, pn * 128, nv < 256 ? nv : 256, lds, tz); }
        if (tz == 0) __hip_atomic_fetch_add(g.done + e, 1, __ATOMIC_RELAXED, __HIP_MEMORY_SCOPE_AGENT);
    } else {
        bf16_t* C = (bf16_t*)g.C;
        f32x4 bv[2][2];
#pragma unroll
        for (int bj = 0; bj < 2; ++bj)
#pragma unroll
            for (int n = 0; n < 2; ++n) bv[bj][n] = *(LAS3 const f32x4*)(lds + LDS_BIAS + (bj * 128 + n * 64 + colw) * 4);
#pragma unroll
        for (int ai = 0; ai < 2; ++ai)
#pragma unroll
            for (int m = 0; m < 4; ++m) {
                LAS3 char* rp = lds + (ai * 128 + row0 + m * 16) * EST_F8W + colw;
#pragma unroll
                for (int bj = 0; bj < 2; ++bj)
#pragma unroll
                    for (int n = 0; n < 2; ++n) { const f32x4 v = acc[ai][bj][m][n] + bv[bj][n];
                        int w = __builtin_amdgcn_cvt_pk_fp8_f32(v[0], v[1], 0, false); w = __builtin_amdgcn_cvt_pk_fp8_f32(v[2], v[3], w, true);
                        *(LAS3 int*)(rp + bj * 128 + n * 64) = w; }
            }
        { const int nv = ecnt - pm * 256; epi_flush_f8w((unsigned char*)g.C, D, ebase + pm * 256, pn * 256, nv < 256 ? nv : 256, lds, tz); }
    }
}


template <int EPI>
__device__ __forceinline__ void gemm_tile_img(const GemmArgs& g, int pm, int pn, int e, int ebase, int ecnt, LAS3 char* lds, int wid, const unsigned char* img, int kh = -1) {
    int tid = wid * 64 + lane_id(); asm volatile("" : "+v"(tid));
    const int lane = tid & 63;
    unsigned aoff[2][2];
#pragma unroll
    for (int h = 0; h < 2; ++h)
#pragma unroll
        for (int i = 0; i < 2; ++i) {
            const int rih = (i * 8 + wid) * 8 + (lane >> 3);
            const int chunk = (lane & 7) ^ ((rih >> 1) & 7);
            int r = pm * 256 + h * 128 + rih;
            unsigned grow;
            if (EPI == 2) { if (r >= ecnt) r = ecnt - 1; grow = (unsigned)(g.list[e * T + r] >> 2); }
            else if (EPI == 3) { if (r >= ecnt) r = ecnt - 1; grow = (unsigned)(ebase + r); }
            else grow = (unsigned)r;
            aoff[h][i] = (EPI >= 2) ? (grow * (unsigned)D + (unsigned)(chunk * 16)) : (grow * (unsigned)D + (unsigned)(chunk * 8)) * 2u;
        }
    if (EPI >= 2) {
        if (tid < 256) {
            float bvv;
            if (EPI == 2) bvv = (tid < 128) ? g.bias[(size_t)e * (2 * DFF) + pn * 128 + tid] : g.bias[(size_t)e * (2 * DFF) + DFF + pn * 128 + (tid - 128)] + 1.0f;
            else bvv = g.bias[(size_t)e * D + pn * 256 + tid];
            *(LAS3 float*)(lds + LDS_BIAS + tid * 4) = bvv;
        }
        if (EPI == 3) {
            if (tid == 0) { const int need = 16 * ((ecnt + 255) >> 8); unsigned sp = 0;
                while (__hip_atomic_load(g.done + e, __ATOMIC_RELAXED, __HIP_MEMORY_SCOPE_AGENT) < need) { __builtin_amdgcn_s_sleep(8); if (++sp > (1u << 20)) break; }
                __builtin_amdgcn_fence(__ATOMIC_ACQUIRE, "agent"); asm volatile("s_waitcnt vmcnt(0)" ::: "memory"); }
            __syncthreads();
        }
    }
    f32x4 acc[2][2][4][2];
    gemm_kloop_dma<(EPI >= 2), (EPI >= 2), (EPI >= 2) ? 0 : 2 * D>(acc, (const unsigned char*)g.A, aoff, img, (EPI >= 2) ? D / 128 : (EPI == 0 && kh >= 0) ? D / 128 : D / 64, lds, tid, wid, (EPI == 0 && kh > 0) ? D / 128 : 0);
    int tz = wid * 64 + lane_id(); asm volatile("" : "+v"(tz));
    const int wid2 = tz >> 6, lane2 = tz & 63;
    const int row0 = (wid2 >> 2) * 64 + (lane2 & 15), colw = (wid2 & 3) * 16 + (lane2 >> 4) * 4;
    if (EPI == 0) {
#pragma unroll
        for (int ai = 0; ai < 2; ++ai)
#pragma unroll
            for (int m = 0; m < 4; ++m) {
                f32x4 v[2][2];
#pragma unroll
                for (int bj = 0; bj < 2; ++bj)
#pragma unroll
                    for (int n = 0; n < 2; ++n) v[bj][n] = acc[ai][bj][m][n];
                epi_stage_bf16(v, ai * 128 + row0 + m * 16, colw, lds);
            }
        if (kh > 0) epi_flush_bf16((bf16_t*)g.R, DIN - 4096, pm * 256, pn * 256 - 4096, 256, lds, tz);
        else epi_flush_bf16((bf16_t*)g.C, DIN, pm * 256, pn * 256, 256, lds, tz);
    } else if (EPI == 1) {
        float* C = (float*)g.C;
#pragma unroll
        for (int ai = 0; ai < 2; ++ai)
#pragma unroll
            for (int m = 0; m < 4; ++m) {
                const size_t ro = (size_t)(pm * 256 + ai * 128 + row0 + m * 16) * D + pn * 256 + colw;
#pragma unroll
                for (int bj = 0; bj < 2; ++bj)
#pragma unroll
                    for (int n = 0; n < 2; ++n) { const f32x4 xr = *(const f32x4*)(g.R + ro + bj * 128 + n * 64);
                        *(f32x4*)(C + ro + bj * 128 + n * 64) = acc[ai][bj][m][n] + xr; }
            }
    } else if (EPI == 2) {
        unsigned char* C = (unsigned char*)g.C;
        f32x4 bgate[2], bup1[2];
#pragma unroll
        for (int n = 0; n < 2; ++n) { bgate[n] = *(LAS3 const f32x4*)(lds + LDS_BIAS + (n * 64 + colw) * 4); bup1[n] = *(LAS3 const f32x4*)(lds + LDS_BIAS + (128 + n * 64 + colw) * 4); }
#pragma unroll
        for (int ai = 0; ai < 2; ++ai)
#pragma unroll
            for (int m = 0; m < 4; ++m) {
                const int r = pm * 256 + ai * 128 + row0 + m * 16;
                {
                    LAS3 char* rp = lds + (ai * 128 + row0 + m * 16) * EST_F8 + colw;
#pragma unroll
                    for (int n = 0; n < 2; ++n) {
                        float o[4];
#pragma unroll
                        for (int j = 0; j < 4; j += 2) {
                            typedef float f32x2 __attribute__((ext_vector_type(2)));
                            f32x2 gt = (f32x2){acc[ai][0][m][n][j], acc[ai][0][m][n][j + 1]} + (f32x2){bgate[n][j], bgate[n][j + 1]};
                            f32x2 up = (f32x2){acc[ai][1][m][n][j], acc[ai][1][m][n][j + 1]} + (f32x2){bup1[n][j], bup1[n][j + 1]};
                            gt.x = fminf(gt.x, 7.0f); gt.y = fminf(gt.y, 7.0f);
                            up.x = __builtin_amdgcn_fmed3f(up.x, -6.0f, 8.0f); up.y = __builtin_amdgcn_fmed3f(up.y, -6.0f, 8.0f);
                            const f32x2 xe = gt * (-2.45546696f);
                            f32x2 ex; ex.x = __builtin_amdgcn_exp2f(xe.x); ex.y = __builtin_amdgcn_exp2f(xe.y);
                            const f32x2 den = ex + 1.0f;
                            f32x2 rc; rc.x = __builtin_amdgcn_rcpf(den.x); rc.y = __builtin_amdgcn_rcpf(den.y);
                            const f32x2 res = (gt * rc) * up;
                            o[j] = res.x; o[j + 1] = res.y;
                        }
                        int w = __builtin_amdgcn_cvt_pk_fp8_f32(o[0], o[1], 0, false);
                        w = __builtin_amdgcn_cvt_pk_fp8_f32(o[2], o[3], w, true);
                        *(LAS3 int*)(rp + n * 64) = w;
                    }
                }
            }
        { const int nv = ecnt - pm * 256; epi_flush_f8(C, DFF, ebase + pm * 256, pn * 128, nv < 256 ? nv : 256, lds, tz); }
        if (tz == 0) __hip_atomic_fetch_add(g.done + e, 1, __ATOMIC_RELAXED, __HIP_MEMORY_SCOPE_AGENT);
    } else {
        bf16_t* C = (bf16_t*)g.C;
        f32x4 bv[2][2];
#pragma unroll
        for (int bj = 0; bj < 2; ++bj)
#pragma unroll
            for (int n = 0; n < 2; ++n) bv[bj][n] = *(LAS3 const f32x4*)(lds + LDS_BIAS + (bj * 128 + n * 64 + colw) * 4);
#pragma unroll
        for (int ai = 0; ai < 2; ++ai)
#pragma unroll
            for (int m = 0; m < 4; ++m) {
                LAS3 char* rp = lds + (ai * 128 + row0 + m * 16) * EST_F8W + colw;
#pragma unroll
                for (int bj = 0; bj < 2; ++bj)
#pragma unroll
                    for (int n = 0; n < 2; ++n) { const f32x4 v = acc[ai][bj][m][n] + bv[bj][n];
                        int w = __builtin_amdgcn_cvt_pk_fp8_f32(v[0], v[1], 0, false); w = __builtin_amdgcn_cvt_pk_fp8_f32(v[2], v[3], w, true);
                        *(LAS3 int*)(rp + bj * 128 + n * 64) = w; }
            }
        { const int nv = ecnt - pm * 256; epi_flush_f8w((unsigned char*)g.C, D, ebase + pm * 256, pn * 256, nv < 256 ? nv : 256, lds, tz); }
    }
}

#define XB_TMO      128
#define XB_XCNT(j)  (256  + 64 * (j))
#define XB_XSUB(j)  (1280 + 64 * (j))
#define XB_XGEN(j)  (2304 + 64 * (j))
#define XB_TOP      3328
#define XB_TOPGEN   3392
#define XCD_BAR_WORDS 3456
#define XB_SPIN_CAP (1u << 18)
#define LAS __attribute__((address_space(3)))

__device__ __forceinline__ unsigned xb_ld(unsigned* p)              { return __hip_atomic_load(p, __ATOMIC_RELAXED, __HIP_MEMORY_SCOPE_AGENT); }
__device__ __forceinline__ unsigned xb_add(unsigned* p, unsigned v) { return __hip_atomic_fetch_add(p, v, __ATOMIC_RELAXED, __HIP_MEMORY_SCOPE_AGENT); }
__device__ __forceinline__ unsigned xb_xcc_id() { return (unsigned)__builtin_amdgcn_s_getreg((3 << 11) | 20) & 0xFu; }
#define XB_SPIN(cond, bar) do { unsigned _sp = 0; while (cond) { __builtin_amdgcn_s_sleep(1); \
    if ((++_sp & 255u) == 0u) { if (xb_ld(&(bar)[XB_TMO])) break; if (_sp > XB_SPIN_CAP) { atomicAdd(&(bar)[XB_TMO], 1u); break; } } } } while (0)

struct XcdBarrier {
    unsigned* bar; unsigned x;
    volatile LAS unsigned* st;
};
__device__ __forceinline__ XcdBarrier xcd_barrier_post(unsigned* bar, volatile LAS unsigned* st, int tid) {
    XcdBarrier b; b.bar = bar; b.x = xb_xcc_id(); b.st = st;
    if (tid == 0) (void)xb_add(&bar[XB_XCNT(b.x)], 1u);
    return b;
}
__device__ __forceinline__ void xcd_barrier_complete(unsigned* bar, unsigned x, unsigned& nloc, unsigned& nx) {
    const unsigned G = gridDim.x * gridDim.y * gridDim.z;
    unsigned sum, cnt, mine, sp = 0u;
    for (;;) {
        sum = 0u; cnt = 0u; mine = 0u;
#pragma unroll
        for (unsigned j = 0; j < 16; ++j) { const unsigned c = xb_ld(&bar[XB_XCNT(j)]); sum += c; cnt += (c > 0u) ? 1u : 0u; mine = (j == x) ? c : mine; }
        if (sum == G) break;
        __builtin_amdgcn_s_sleep(1);
        if ((++sp & 255u) == 0u) { if (xb_ld(&bar[XB_TMO])) break; if (sp > XB_SPIN_CAP) { atomicAdd(&bar[XB_TMO], 1u); break; } }
    }
    nloc = mine > 0u ? mine : 1u; nx = cnt > 0u ? cnt : 1u;
}
__device__ __forceinline__ void xcd_barrier(const XcdBarrier& b, int tid) {
    asm volatile("s_waitcnt vmcnt(0)" ::: "memory");
    __syncthreads();
    if (tid == 0) {
        unsigned* bar = b.bar;
        __builtin_amdgcn_s_waitcnt(0);
        unsigned nloc = b.st[0], nx = b.st[1];
        if (nloc == 0u) { xcd_barrier_complete(bar, b.x, nloc, nx); b.st[0] = nloc; b.st[1] = nx; }
        const unsigned old = xb_add(&bar[XB_XSUB(b.x)], 1u);
        const unsigned gen = old / nloc;
        if (old + 1u == (gen + 1u) * nloc) {
            __builtin_amdgcn_fence(__ATOMIC_RELEASE, "agent");
            asm volatile("s_waitcnt vmcnt(0)" ::: "memory");
            const unsigned og = xb_add(&bar[XB_TOP], 1u);
            const unsigned tg = og / nx;
            if (og + 1u == (tg + 1u) * nx) xb_add(&bar[XB_TOPGEN], 1u);
            else XB_SPIN(xb_ld(&bar[XB_TOPGEN]) == tg, bar);
            __builtin_amdgcn_fence(__ATOMIC_ACQUIRE, "agent");
            xb_add(&bar[XB_XGEN(b.x)], 1u);
            asm volatile("s_waitcnt vmcnt(0)" ::: "memory");
        } else {
            XB_SPIN(xb_ld(&bar[XB_XGEN(b.x)]) == gen, bar);
            __builtin_amdgcn_fence(__ATOMIC_ACQUIRE, "agent");
            asm volatile("s_waitcnt vmcnt(0)" ::: "memory");
        }
    }
    __syncthreads();
}

struct Params {
    const float *x, *ln_mix_g, *w_in, *conv_w, *sgu_ln_g, *sgu_ln_b, *sgu_w, *sgu_b, *gn_conv, *gn_sgu, *w_out, *ln_ffn_g, *w_router, *b_router,
                *w_gate_up, *b_gate_up, *w_down, *b_down, *ln_final_g;
    float* out;
    unsigned* bar; int* cnt; int* list; int* sel; float* gates; int* done;
    unsigned char* img_moe;
    int* np;
    bf16_t *xn, *proj, *proj2, *y, *xn2, *act, *outp; float* h;
    unsigned char *img_in, *img_out;
};
constexpr int LDS_MISC = 256 * EST_BF16;
constexpr int LDS_TOTAL = LDS_MISC + 4096;

__device__ __forceinline__ void phase_rmsnorm(const float* __restrict__ x, const float* __restrict__ g, bf16_t* __restrict__ y, int wid) {
    int lane = lane_id(); asm volatile("" : "+v"(lane));
    for (int t = blockIdx.x * 8 + wid; t < T; t += gridDim.x * 8) {
        const float* xr = x + (size_t)t * D;
        f32x4 v[8]; float s = 0.f;
#pragma unroll
        for (int j = 0; j < 8; ++j) { v[j] = *(const f32x4*)(xr + j * 256 + lane * 4); s += v[j][0] * v[j][0] + v[j][1] * v[j][1] + v[j][2] * v[j][2] + v[j][3] * v[j][3]; }
        s = wave_sum(s);
        const float r = rsqrtf(s * (1.0f / D) + EPS);
#pragma unroll
        for (int j = 0; j < 8; ++j) {
            const f32x4 gg = *(const f32x4*)(g + j * 256 + lane * 4);
            u32x2 o; o.x = cvt_pk_bf16(v[j][0] * r * gg[0], v[j][1] * r * gg[1]); o.y = cvt_pk_bf16(v[j][2] * r * gg[2], v[j][3] * r * gg[3]);
            *(u32x2*)(y + (size_t)t * D + j * 256 + lane * 4) = o;
        }
    }
}

__device__ __forceinline__ float gelu_f(float v) {
    const float av = fabsf(v), dd = av * 0.2316418882f + 1.0f;
    const float tt = __builtin_amdgcn_rcpf(dd);
    float q = tt * 0.5307027145f + (-0.7265760135f); q = q * tt + 0.7107068705f; q = q * tt + (-0.142248368f); q = q * tt + 0.127414796f; q = q * tt;
    const float e = __builtin_amdgcn_exp2f((v * v) * (-0.72134752044f));
    const float m = v * (q * e);
    return v < 0.f ? m : v - m;
}
typedef float f32x16 __attribute__((ext_vector_type(16)));

__device__ __forceinline__ void phase_mixer(const Params& p, LAS3 char* lds, int wid) {
    int lane = lane_id(); asm volatile("" : "+v"(lane));
    const int n = lane & 31, kh = lane >> 5;
    const bf16_t* __restrict__ proj = p.proj;
    LAS3 float* stat = (LAS3 float*)(lds + 32768);
    const int nunits = (T / 128) * 16;
    for (int it = 0; it * (int)gridDim.x < nunits; ++it) {
        const int b = blockIdx.x;
        int u = it * gridDim.x + b;
        if (u >= nunits) break;
        int chunk, g;
        if ((gridDim.x & 15) == 0) { chunk = (b >> 4) + (gridDim.x >> 4) * it; g = ((b & 15) + 8 * (it & 1)) & 15; } else { chunk = u >> 4; g = u & 15; }
        const int t0 = chunk * 128;
        if (g < 8) {
            const int c = g * 128 + 2 * lane;
            const int r0 = t0 + 16 * wid;
            const bf16_t* base = proj + (size_t)r0 * DIN + c;
            const float w00 = p.conv_w[c], w01 = p.conv_w[c + 1], w10 = p.conv_w[DC + c], w11 = p.conv_w[DC + c + 1], w20 = p.conv_w[2 * DC + c], w21 = p.conv_w[2 * DC + c + 1];
            const float g0 = p.gn_conv[c], g1 = p.gn_conv[c + 1];
            const bool has_hist = ((r0 % SEQ) != 0);
            float z2a = 0.f, z2b = 0.f, z1a = 0.f, z1b = 0.f;
            if (has_hist) {
                const unsigned c2 = *(const unsigned*)(base - 2 * (ptrdiff_t)DIN + DC), h2 = *(const unsigned*)(base - 2 * (ptrdiff_t)DIN + 2 * DC);
                const unsigned c1 = *(const unsigned*)(base - (ptrdiff_t)DIN + DC), h1 = *(const unsigned*)(base - (ptrdiff_t)DIN + 2 * DC);
                z2a = bf16_lo(c2) * bf16_lo(h2); z2b = bf16_hi(c2) * bf16_hi(h2); z1a = bf16_lo(c1) * bf16_lo(h1); z1b = bf16_hi(c1) * bf16_hi(h1);
            }
#pragma unroll 1
            for (int hb = 0; hb < 16; hb += 8) {
                unsigned bg[8], cg[8], hg[8];
#pragma unroll
                for (int i = 0; i < 8; ++i) { bg[i] = *(const unsigned*)(base + (size_t)(hb + i) * DIN); cg[i] = *(const unsigned*)(base + (size_t)(hb + i) * DIN + DC); hg[i] = *(const unsigned*)(base + (size_t)(hb + i) * DIN + 2 * DC); }
#pragma unroll
                for (int i = 0; i < 8; ++i) {
                    const float z0a = bf16_lo(cg[i]) * bf16_lo(hg[i]), z0b = bf16_hi(cg[i]) * bf16_hi(hg[i]);
                    const float ya = bf16_lo(bg[i]) * (w00 * z2a + w10 * z1a + w20 * z0a);
                    const float yb = bf16_hi(bg[i]) * (w01 * z2b + w11 * z1b + w21 * z0b);
                    z2a = z1a; z2b = z1b; z1a = z0a; z1b = z0b;
                    const float ss = wave_sum(ya * ya + yb * yb);
                    const float rs = rsqrtf(ss * (1.0f / 128.0f) + EPS);
                    *(unsigned*)(p.y + (size_t)(r0 + hb + i) * D + c) = cvt_pk_bf16(ya * rs * g0, yb * rs * g1);
                }
            }
            __syncthreads(); __syncthreads(); __syncthreads();
        } else {
            const int hd = g - 8;
            {
                const int s0 = 16 * wid + 8 * kh;
                const bf16_t* vb = proj + (size_t)(t0 + s0) * DIN + 4096 + hd * 128 + 4 * n;
                const bf16_t* vb2 = p.proj2 + (size_t)(t0 + s0) * (DIN - 4096) + hd * 128 + 4 * n;
                u32x2 raw[8], raw2[8];
#pragma unroll
                for (int j = 0; j < 8; ++j) { raw[j] = *(const u32x2*)(vb + (size_t)j * DIN); raw2[j] = *(const u32x2*)(vb2 + (size_t)j * (DIN - 4096)); }
                const f32x4 lg = *(const f32x4*)(p.sgu_ln_g + hd * 128 + 4 * n), lb = *(const f32x4*)(p.sgu_ln_b + hd * 128 + 4 * n);
                float vn[8][4];
#pragma unroll
                for (int j = 0; j < 8; ++j) {
                    const float a0 = gelu_f(bf16_lo(raw[j].x) + bf16_lo(raw2[j].x)), a1 = gelu_f(bf16_hi(raw[j].x) + bf16_hi(raw2[j].x)), a2 = gelu_f(bf16_lo(raw[j].y) + bf16_lo(raw2[j].y)), a3 = gelu_f(bf16_hi(raw[j].y) + bf16_hi(raw2[j].y));
                    const float mu = half_sum32((a0 + a1) + (a2 + a3)) * (1.0f / 128.0f);
                    const float d0 = a0 - mu, d1 = a1 - mu, d2 = a2 - mu, d3 = a3 - mu;
                    const float rs = rsqrtf(half_sum32((d0 * d0 + d1 * d1) + (d2 * d2 + d3 * d3)) * (1.0f / 128.0f) + EPS);
                    vn[j][0] = d0 * rs * lg[0] + lb[0]; vn[j][1] = d1 * rs * lg[1] + lb[1]; vn[j][2] = d2 * rs * lg[2] + lb[2]; vn[j][3] = d3 * rs * lg[3] + lb[3];
                }
                __syncthreads();
#pragma unroll
                for (int c = 0; c < 4; ++c) {
                    u32x4 f; f.x = cvt_pk_bf16(vn[0][c], vn[1][c]); f.y = cvt_pk_bf16(vn[2][c], vn[3][c]); f.z = cvt_pk_bf16(vn[4][c], vn[5][c]); f.w = cvt_pk_bf16(vn[6][c], vn[7][c]);
                    *(LAS3 u32x4*)(lds + ((wid * 4 + c) * 64 + lane) * 16) = f;
                }
            }
            __syncthreads();
            {
                const int mt = wid >> 1, cp = (wid & 1) * 2;
                const int trow = 32 * mt + n;
                const float* Wr = p.sgu_w + (size_t)hd * 16384 + (size_t)trow * 128 + 8 * kh;
                f32x16 acc0, acc1;
#pragma unroll
                for (int r = 0; r < 16; ++r) { acc0[r] = 0.f; acc1[r] = 0.f; }
                for (int ks = 0; ks <= 2 * mt + 1; ++ks) {
                    const f32x4 wa = *(const f32x4*)(Wr + 16 * ks), wb = *(const f32x4*)(Wr + 16 * ks + 4);
                    const int sb = 16 * ks + 8 * kh;
                    float wv[8] = {wa[0], wa[1], wa[2], wa[3], wb[0], wb[1], wb[2], wb[3]};
#pragma unroll
                    for (int j = 0; j < 8; ++j) wv[j] = (sb + j <= trow) ? wv[j] : 0.f;
                    u32x4 af; af.x = cvt_pk_bf16(wv[0], wv[1]); af.y = cvt_pk_bf16(wv[2], wv[3]); af.z = cvt_pk_bf16(wv[4], wv[5]); af.w = cvt_pk_bf16(wv[6], wv[7]);
                    const u32x4 b0 = *(LAS3 const u32x4*)(lds + ((ks * 4 + cp) * 64 + lane) * 16);
                    const u32x4 b1 = *(LAS3 const u32x4*)(lds + ((ks * 4 + cp + 1) * 64 + lane) * 16);
                    acc0 = __builtin_amdgcn_mfma_f32_32x32x16_bf16(__builtin_bit_cast(bf16x8, af), __builtin_bit_cast(bf16x8, b0), acc0, 0, 0, 0);
                    acc1 = __builtin_amdgcn_mfma_f32_32x32x16_bf16(__builtin_bit_cast(bf16x8, af), __builtin_bit_cast(bf16x8, b1), acc1, 0, 0, 0);
                }
                const bf16_t* ub = proj + (size_t)t0 * DIN + 3072 + hd * 128 + 4 * n + cp;
                float ya[16], yb[16];
#pragma unroll
                for (int r = 0; r < 16; ++r) {
                    const int tt = 32 * mt + (r & 3) + 8 * (r >> 2) + 4 * kh;
                    const unsigned uu = *(const unsigned*)(ub + (size_t)tt * DIN);
                    const float bias = p.sgu_b[hd * 128 + tt];
                    ya[r] = gelu_f(bf16_lo(uu)) * (acc0[r] + bias);
                    yb[r] = gelu_f(bf16_hi(uu)) * (acc1[r] + bias);
                    const float ps = half_sum32(ya[r] * ya[r] + yb[r] * yb[r]);
                    if (n == 0) stat[tt * 2 + (wid & 1)] = ps;
                }
                __syncthreads();
                const float g0 = p.gn_sgu[hd * 128 + 4 * n + cp], g1 = p.gn_sgu[hd * 128 + 4 * n + cp + 1];
#pragma unroll
                for (int r = 0; r < 16; ++r) {
                    const int tt = 32 * mt + (r & 3) + 8 * (r >> 2) + 4 * kh;
                    const float rs = rsqrtf((stat[tt * 2] + stat[tt * 2 + 1]) * (1.0f / 128.0f) + EPS);
                    *(unsigned*)(p.y + (size_t)(t0 + tt) * D + DC + hd * 128 + 4 * n + cp) = cvt_pk_bf16(ya[r] * rs * g0, yb[r] * rs * g1);
                }
            }
        }
    }
}

__device__ __forceinline__ void phase_router(const Params& p, LAS3 char* lds, int wid) {
    LAS3 float* part = (LAS3 float*)lds;
    LAS3 float* ssqp = (LAS3 float*)(lds + 34816);
    LAS3 float* logit = (LAS3 float*)(lds + 36864);
    LAS3 float* rstd = (LAS3 float*)(lds + 41984);
    LAS3 int* lhist = (LAS3 int*)(lds + 42240);
    LAS3 int* gbase = (LAS3 int*)(lds + 42368);
    int lane = lane_id(); asm volatile("" : "+v"(lane));
    const int n = lane & 31, kh = lane >> 5, tid = wid * 64 + lane;
    for (int grp = blockIdx.x; grp < T / 32; grp += gridDim.x) {
        const int t0 = grp * 32;
        __syncthreads();
        if (tid < 32) lhist[tid] = 0;
        {
            const float* hrow = p.h + (size_t)(t0 + n) * D + wid * 256 + 4 * kh;
            const float* grow = p.ln_ffn_g + wid * 256 + 4 * kh;
            const float* wrow = p.w_router + (size_t)(wid * 256 + 4 * kh) * 32 + n;
            f32x16 acc;
#pragma unroll
            for (int r = 0; r < 16; ++r) acc[r] = 0.f;
            float ssq = 0.f;
#pragma unroll 1
            for (int jj = 0; jj < 32; jj += 8) {
                f32x4 hv[8], gv[8];
#pragma unroll
                for (int j = 0; j < 8; ++j) { hv[j] = *(const f32x4*)(hrow + 8 * (jj + j)); gv[j] = *(const f32x4*)(grow + 8 * (jj + j)); }
#pragma unroll
                for (int j = 0; j < 8; ++j)
#pragma unroll
                    for (int i = 0; i < 4; ++i) {
                        const float a = hv[j][i];
                        ssq += a * a;
                        const float bw = wrow[(size_t)(8 * (jj + j) + i) * 32];
                        acc = __builtin_amdgcn_mfma_f32_32x32x2f32(a * gv[j][i], bw, acc, 0, 0, 0);
                    }
            }
            ssq += xor32(ssq);
            if (kh == 0) ssqp[wid * 32 + n] = ssq;
#pragma unroll
            for (int r = 0; r < 16; ++r) part[(wid * 32 + ((r & 3) + 8 * (r >> 2) + 4 * kh)) * 33 + n] = acc[r];
        }
        __syncthreads();
        if (tid < 32) { float s = 0.f;
#pragma unroll
            for (int w = 0; w < 8; ++w) s += ssqp[w * 32 + tid];
            rstd[tid] = rsqrtf(s * (1.0f / D) + EPS); }
        __syncthreads();
#pragma unroll
        for (int i = 0; i < 2; ++i) {
            const int idx = tid + 512 * i, tk = idx >> 5, e = idx & 31;
            float s = 0.f;
#pragma unroll
            for (int w = 0; w < 8; ++w) s += part[(w * 32 + tk) * 33 + e];
            logit[tk * 33 + e] = s * rstd[tk] + p.b_router[e];
        }
        __syncthreads();
        int se[4] = {0, 0, 0, 0}, sl[4] = {0, 0, 0, 0}; float sx[4] = {0.f, 0.f, 0.f, 0.f}; float sden = 1.f;
        if (tid < 32) {
            float v0 = 0.f; sden = 0.f;
#pragma unroll
            for (int k = 0; k < 4; ++k) {
                int bi = 0; float bv = -3.0e38f;
                for (int i = 0; i < 32; ++i) { const float l = logit[tid * 33 + i]; if (l > bv) { bv = l; bi = i; } }
                logit[tid * 33 + bi] = -3.4e38f;
                if (k == 0) v0 = bv;
                sx[k] = __expf(bv - v0); sden += sx[k];
                se[k] = bi; sl[k] = atomicAdd((int*)&lhist[bi], 1);
            }
        }
        __syncthreads();
        if (tid < 32) { const int c = lhist[tid]; gbase[tid] = c ? atomicAdd(&p.cnt[tid], c) : 0; }
        __syncthreads();
        if (tid < 32) {
            const int t = t0 + tid;
            const float inv = 1.0f / sden;
#pragma unroll
            for (int k = 0; k < 4; ++k) {
                const int slot = gbase[se[k]] + sl[k];
                p.gates[t * 4 + k] = sx[k] * inv;
                p.list[se[k] * T + slot] = t * 4 + k;
                p.sel[t * 4 + k] = (se[k] << 16) | slot;
            }
        }
#pragma unroll 1
        for (int q = 0; q < 4; ++q) {
            const int tk = wid * 4 + q;
            const float r = rstd[tk];
            const float* hr = p.h + (size_t)(t0 + tk) * D;
#pragma unroll
            for (int j = 0; j < 8; ++j) {
                const f32x4 hv = *(const f32x4*)(hr + j * 256 + lane * 4), gg = *(const f32x4*)(p.ln_ffn_g + j * 256 + lane * 4);
                int o = __builtin_amdgcn_cvt_pk_fp8_f32(hv[0] * r * gg[0], hv[1] * r * gg[1], 0, false);
                o = __builtin_amdgcn_cvt_pk_fp8_f32(hv[2] * r * gg[2], hv[3] * r * gg[3], o, true);
                *(int*)((unsigned char*)p.xn2 + (size_t)(t0 + tk) * D + j * 256 + lane * 4) = o;
            }
        }
    }
}

__device__ __forceinline__ void phase_final(const Params& p, LAS3 char* lds, int wid) {
    LAS3 int* base = (LAS3 int*)(lds + LDS_MISC + 2048);
    int lane = lane_id(); asm volatile("" : "+v"(lane));
    if (wid == 0 && lane == 0) { int a = 0; for (int i = 0; i < NE; ++i) { base[i] = a; a += p.cnt[i]; } }
    __syncthreads();
    for (int t = blockIdx.x * 8 + wid; t < T; t += gridDim.x * 8) {
        float gk[4]; const unsigned char* op[4];
#pragma unroll
        for (int k = 0; k < 4; ++k) { const int s = p.sel[t * 4 + k]; gk[k] = p.gates[t * 4 + k]; op[k] = (const unsigned char*)p.outp + (size_t)(base[s >> 16] + (s & 0xffff)) * D; }
        f32x4 v[8]; float ss = 0.f;
#pragma unroll
        for (int j = 0; j < 8; ++j) {
            const int c = j * 256 + lane * 4;
            f32x4 a = *(const f32x4*)(p.h + (size_t)t * D + c);
#pragma unroll
            for (int k = 0; k < 4; ++k) { const int o = *(const int*)(op[k] + c);
                typedef float f32x2 __attribute__((ext_vector_type(2)));
                const f32x2 lo = __builtin_amdgcn_cvt_pk_f32_fp8(o, false), hi = __builtin_amdgcn_cvt_pk_f32_fp8(o, true);
                a[0] += gk[k] * lo.x; a[1] += gk[k] * lo.y; a[2] += gk[k] * hi.x; a[3] += gk[k] * hi.y; }
            v[j] = a; ss += a[0] * a[0] + a[1] * a[1] + a[2] * a[2] + a[3] * a[3];
        }
        ss = wave_sum(ss);
        const float r = rsqrtf(ss * (1.0f / D) + EPS);
#pragma unroll
        for (int j = 0; j < 8; ++j) { const int c = j * 256 + lane * 4; const f32x4 gg = *(const f32x4*)(p.ln_final_g + c);
            f32x4 o; o[0] = v[j][0] * r * gg[0]; o[1] = v[j][1] * r * gg[1]; o[2] = v[j][2] * r * gg[2]; o[3] = v[j][3] * r * gg[3];
            *(f32x4*)(p.out + (size_t)t * D + c) = o; }
    }
}

__device__ __forceinline__ void expert_span(const int* cnt, int e, int& ebase, int& ecnt) {
    const int l = lane_id();
    const int c = (l < NE) ? cnt[l] : 0;
    ebase = __builtin_amdgcn_readfirstlane((int)wave_sum((l < e) ? (float)c : 0.0f));
    ecnt = __builtin_amdgcn_readlane(c, e);
}
#ifndef MOE_PLIMIT
#define MOE_PLIMIT 96
#endif
__device__ __forceinline__ void moe_groups(const Params& p, LAS3 char* lds, int wid, int vb, int nb) {
    constexpr int G2 = NE * 16, GT = NE * 16 + NE * 8;
    GemmArgs gu{}; gu.A = p.xn2; gu.B = p.w_gate_up; gu.C = p.act; gu.bias = p.b_gate_up; gu.list = p.list; gu.done = p.done;
    GemmArgs gd{}; gd.A = p.act; gd.B = p.w_down; gd.C = p.outp; gd.bias = p.b_down; gd.done = p.done;
    unsigned char* slot0 = p.img_moe + (size_t)vb * 1048576;
    int gi = vb, k = 0, cpm = 1; bool curP = false, nxtP = false;
    while (gi < GT) {
        const bool up = gi < G2;
        const int e = up ? (gi >> 4) : ((gi - G2) >> 3), pn = up ? (gi & 15) : ((gi - G2) & 7);
        int ebase, ecnt; expert_span(p.cnt, e, ebase, ecnt);
        const int mt = (ecnt + 255) >> 8;
        unsigned char* img = slot0 + (size_t)(k & 1) * 524288;
        if (mt > 0 && !curP) {
            { const int t0 = wid * 64 + lane_id(); if (t0 == 0) __hip_atomic_fetch_add(p.np, 1, __ATOMIC_RELAXED, __HIP_MEMORY_SCOPE_AGENT); }
            if (up) gemm_tile<2>(gu, 0, pn, e, ebase, ecnt, lds, wid, img); else gemm_tile<3>(gd, 0, pn, e, ebase, ecnt, lds, wid, img);
            { const int t0 = wid * 64 + lane_id(); if (t0 == 0) { __hip_atomic_fetch_add(p.np, -1, __ATOMIC_RELAXED, __HIP_MEMORY_SCOPE_AGENT);
                  __builtin_amdgcn_fence(__ATOMIC_ACQUIRE, "agent"); asm volatile("s_waitcnt vmcnt(0)" ::: "memory"); } __syncthreads(); }
            curP = true; continue;
        }
        if (mt > 0 && cpm < mt) {
            const int gn = gi + nb;
            if (gn < GT && !nxtP) {
                const bool upn = gn < G2;
                const int en = upn ? (gn >> 4) : ((gn - G2) >> 3), pnn = upn ? (gn & 15) : ((gn - G2) & 7);
                int ebn, ecn; expert_span(p.cnt, en, ebn, ecn);
                LAS3 int* dec = (LAS3 int*)(lds + LDS_MISC + 64);
                { const int t0 = wid * 64 + lane_id();
                  if (t0 == 0) { int ok = (ecn > 0 && __hip_atomic_load(p.np, __ATOMIC_RELAXED, __HIP_MEMORY_SCOPE_AGENT) < MOE_PLIMIT) ? 1 : 0;
                      if (ok && !upn) ok = (__hip_atomic_load(p.done + en, __ATOMIC_RELAXED, __HIP_MEMORY_SCOPE_AGENT) >= 16 * ((ecn + 255) >> 8)) ? 1 : 0;
                      *dec = ok; } }
                __syncthreads();
                const bool go = __builtin_amdgcn_readfirstlane(*dec) != 0;
                __syncthreads();
                if (go) {
                    unsigned char* imgn = slot0 + (size_t)((k + 1) & 1) * 524288;
                    { const int t0 = wid * 64 + lane_id(); if (t0 == 0) __hip_atomic_fetch_add(p.np, 1, __ATOMIC_RELAXED, __HIP_MEMORY_SCOPE_AGENT); }
                    if (upn) gemm_tile<2>(gu, 0, pnn, en, ebn, ecn, lds, wid, imgn); else gemm_tile<3>(gd, 0, pnn, en, ebn, ecn, lds, wid, imgn);
                    { const int t0 = wid * 64 + lane_id(); if (t0 == 0) { __hip_atomic_fetch_add(p.np, -1, __ATOMIC_RELAXED, __HIP_MEMORY_SCOPE_AGENT);
                  __builtin_amdgcn_fence(__ATOMIC_ACQUIRE, "agent"); asm volatile("s_waitcnt vmcnt(0)" ::: "memory"); } __syncthreads(); }
                    nxtP = true; continue;
                }
            }
            if (up) gemm_tile_img<2>(gu, cpm, pn, e, ebase, ecnt, lds, wid, img); else gemm_tile_img<3>(gd, cpm, pn, e, ebase, ecnt, lds, wid, img);
            ++cpm; continue;
        }
        gi += nb; ++k; cpm = 1; curP = nxtP; nxtP = false;
    }
}

__global__ void __launch_bounds__(512, 2) k_mega(Params p) {
    extern __shared__ __attribute__((aligned(16))) char smem[];
    LAS3 char* lds = (LAS3 char*)smem;
    volatile LAS unsigned* xbw = (volatile LAS unsigned*)(lds + LDS_MISC);
    int wid = __builtin_amdgcn_readfirstlane((int)(threadIdx.x >> 6)); asm volatile("" : "+s"(wid));
    const int tid0 = wid * 64 + lane_id();
    if (tid0 == 0) { xbw[0] = 0u; xbw[1] = 0u; xbw[2] = 0u; xbw[3] = 0u; }
    __syncthreads();
    XcdBarrier bar = xcd_barrier_post(p.bar, xbw, tid0);
    const int nb = gridDim.x;
    const int vb = ((nb & 7) == 0) ? (int)(blockIdx.x & 7) * (nb >> 3) + (int)(blockIdx.x >> 3) : (int)blockIdx.x;

    if (blockIdx.x == 0 && tid0 < NE) p.cnt[tid0] = 0;
    phase_rmsnorm(p.x, p.ln_mix_g, p.xn, wid);
    for (int it = vb; it < 28 * 4; it += nb) {
        const int tile = it >> 2, kq = it & 3;
        if (tile < 20) convert_tile<false, DIN>(p.w_in + (size_t)kq * 512 * DIN, tile * 256, tile * 256 + 128, 8, p.img_in + (size_t)tile * 1048576 + (size_t)kq * 8 * 32768, lds, wid);
        else convert_tile<false, D>(p.w_out + (size_t)kq * 512 * D, (tile - 20) * 256, (tile - 20) * 256 + 128, 8, p.img_out + (size_t)(tile - 20) * 1048576 + (size_t)kq * 8 * 32768, lds, wid);
    }
    xcd_barrier(bar, wid * 64 + lane_id());
    { GemmArgs g{}; g.A = p.xn; g.C = p.proj; g.R = (const float*)p.proj2;
      for (int u = vb; u < 32 * 16 + 256; u += nb) {
          if (u < 32 * 16) gemm_tile_img<0>(g, u & 31, u >> 5, 0, 0, T, lds, wid, p.img_in + (size_t)(u >> 5) * 1048576);
          else { const int v = u - 32 * 16, pn = 16 + (v >> 6), pm = v & 31, kh = (v >> 5) & 1;
                 gemm_tile_img<0>(g, pm, pn, 0, 0, T, lds, wid, p.img_in + (size_t)pn * 1048576, kh); } } }
    xcd_barrier(bar, wid * 64 + lane_id());
    phase_mixer(p, lds, wid);
    xcd_barrier(bar, wid * 64 + lane_id());
    { GemmArgs g{}; g.A = p.y; g.C = p.h; g.R = p.x;
      for (int u = vb; u < 32 * 8; u += nb) gemm_tile_img<1>(g, u & 31, u >> 5, 0, 0, T, lds, wid, p.img_out + (size_t)(u >> 5) * 1048576); }
    xcd_barrier(bar, wid * 64 + lane_id());
    phase_router(p, lds, wid);
    xcd_barrier(bar, wid * 64 + lane_id());
    moe_groups(p, lds, wid, vb, nb);
    xcd_barrier(bar, wid * 64 + lane_id());
    phase_final(p, lds, wid);
}
}

extern "C" void kernel_launch(void* const* d_in, const int* in_sizes, int n_in, void* d_out, int out_size, void* d_ws, size_t ws_size,
                              hipStream_t stream) {
    Params p{};
    p.x = (const float*)d_in[0]; p.ln_mix_g = (const float*)d_in[1]; p.w_in = (const float*)d_in[2]; p.conv_w = (const float*)d_in[3];
    p.sgu_ln_g = (const float*)d_in[4]; p.sgu_ln_b = (const float*)d_in[5]; p.sgu_w = (const float*)d_in[6]; p.sgu_b = (const float*)d_in[7];
    p.gn_conv = (const float*)d_in[8]; p.gn_sgu = (const float*)d_in[9]; p.w_out = (const float*)d_in[10]; p.ln_ffn_g = (const float*)d_in[11];
    p.w_router = (const float*)d_in[12]; p.b_router = (const float*)d_in[13]; p.w_gate_up = (const float*)d_in[14]; p.b_gate_up = (const float*)d_in[15];
    p.w_down = (const float*)d_in[16]; p.b_down = (const float*)d_in[17]; p.ln_final_g = (const float*)d_in[18];
    p.out = (float*)d_out;

    char* ws = (char*)d_ws;
    size_t off = 0;
    auto take = [&](size_t bytes) { char* q = ws + off; off += (bytes + 255) & ~(size_t)255; return q; };
    p.bar = (unsigned*)take(XCD_BAR_WORDS * 4 + 512);
    p.done = (int*)(p.bar + XCD_BAR_WORDS); p.np = p.done + 64;
    p.cnt = (int*)take(256);
    p.list = (int*)take((size_t)NE * T * 4);
    p.sel = (int*)take((size_t)NPAIR * 4);
    p.gates = (float*)take((size_t)NPAIR * 4);
    p.xn = (bf16_t*)take((size_t)T * D * 2);
    p.proj = (bf16_t*)take((size_t)T * DIN * 2);
    p.proj2 = (bf16_t*)take((size_t)T * (DIN - 4096) * 2);
    p.y = (bf16_t*)take((size_t)T * D * 2);
    p.h = (float*)take((size_t)T * D * 4);
    p.xn2 = (bf16_t*)take((size_t)T * D * 2);
    p.act = (bf16_t*)take((size_t)ACT_ROWS * DFF * 2);
    p.outp = (bf16_t*)take((size_t)ACT_ROWS * D * 2);
    p.img_in = (unsigned char*)take((size_t)20 * 1048576);
    p.img_out = (unsigned char*)take((size_t)8 * 1048576);
    p.img_moe = (unsigned char*)take((size_t)1024 * 1048576);
    if (off > ws_size) { fprintf(stderr, "workspace too small: need %zu have %zu\n", off, ws_size); return; }

    static int grid = 0;
    if (!grid) {
        int dev = 0, cus = 0, per_cu = 0;
        (void)hipGetDevice(&dev);
        (void)hipDeviceGetAttribute(&cus, hipDeviceAttributeMultiprocessorCount, dev);
        (void)hipFuncSetAttribute((const void*)k_mega, hipFuncAttributeMaxDynamicSharedMemorySize, LDS_TOTAL);
        (void)hipOccupancyMaxActiveBlocksPerMultiprocessor(&per_cu, (const void*)k_mega, 512, LDS_TOTAL);
        if (per_cu < 1) { fprintf(stderr, "occupancy query says 0 blocks per CU\n"); per_cu = 1; }
        grid = cus * 1;
    }
    (void)hipMemsetAsync(p.bar, 0, XCD_BAR_WORDS * 4 + 512, stream);
    k_mega<<<grid, 512, LDS_TOTAL, stream>>>(p);
}
```

```cpp
#include <hip/hip_runtime.h>
#include <stdint.h>
#include <stdio.h>

namespace {
constexpr int T = 8192, D = 2048, DIN = 5120, DC = 1024, NE = 32, DFF = 2048, SEQ = 4096;
constexpr int NPAIR = T * 4, ACT_ROWS = NPAIR + 256;
constexpr float EPS = 1e-5f;

#define LAS3 __attribute__((address_space(3)))
typedef short bf16x8 __attribute__((ext_vector_type(8)));
typedef float f32x4 __attribute__((ext_vector_type(4)));
typedef unsigned u32x4 __attribute__((ext_vector_type(4)));
typedef unsigned u32x2 __attribute__((ext_vector_type(2)));
typedef unsigned short bf16_t;

constexpr int GBK = 64, GHTB = 128 * 64 * 2;
constexpr int GEMM_LDS = 8 * GHTB;

__device__ __forceinline__ unsigned cvt_pk_bf16(float lo, float hi) {
    unsigned r; asm("v_cvt_pk_bf16_f32 %0, %1, %2" : "=v"(r) : "v"(lo), "v"(hi)); return r;
}
__device__ __forceinline__ float bf16_lo(unsigned u) { return __uint_as_float(u << 16); }
__device__ __forceinline__ float bf16_hi(unsigned u) { return __uint_as_float(u & 0xffff0000u); }

__device__ __forceinline__ void dma16(const void* sbase, unsigned voff, unsigned lds_dst) {
    unsigned keep;
    asm volatile("s_mov_b32 %0, m0\n\ts_mov_b32 m0, %3\n\ts_nop 2\n\tglobal_load_lds_dwordx4 %1, %2\n\ts_mov_b32 m0, %0"
                 : "=&s"(keep) : "v"(voff), "s"(sbase), "s"(lds_dst) : "memory");
}
#define G_WAIT_V(n) asm volatile("s_waitcnt vmcnt(" #n ")" ::: "memory")
#define G_WAIT_L(n) asm volatile("s_waitcnt lgkmcnt(" #n ")" ::: "memory")
#define G_BAR do { asm volatile("" ::: "memory"); __builtin_amdgcn_s_barrier(); asm volatile("" ::: "memory"); } while (0)
#define G_SCHED __builtin_amdgcn_sched_barrier(0)

template <int LDB, int VAR = 0>
__device__ __forceinline__ void gemm_kloop(f32x4 (&acc)[2][2][4][2], const bf16_t* __restrict__ A, const unsigned (&aoff)[2][2],
                                           const float* __restrict__ B, unsigned boff, int nt, LAS3 char* lds, int tid, int wid, size_t astep = GBK, size_t bstep = (size_t)GBK * LDB) {
    const int lane = tid & 63, wr = wid >> 2, wc = wid & 3, fr = lane & 15, fq = lane >> 4;
    const int c0 = fq ^ (fr >> 1);
    const int a_rd0 = (wr * 64 + fr) * 128 + c0 * 16, a_rd1 = (wr * 64 + fr) * 128 + (c0 ^ 4) * 16;
    const int b_rd0 = (wc * 16 + fr) * 128 + ((c0 ^ (wc & 1)) * 16), b_rd1 = (wc * 16 + fr) * 128 + ((c0 ^ (wc & 1) ^ 4) * 16);
    const int k8 = wid, n4 = tid & 63, bhalf = n4 >> 5, nloc = (n4 & 31) * 4;
    const int sw0 = (((n4 & 3) * 2) & 7) ^ ((n4 >> 2) & 1), sw1 = (((n4 & 3) * 2 + 1) & 7) ^ ((n4 >> 2) & 1);
    const int b_wr0 = (4 + bhalf) * GHTB + nloc * 128 + ((k8 ^ sw0) << 4);
    const int b_wr1 = (4 + bhalf) * GHTB + (nloc + 2) * 128 + ((k8 ^ sw1) << 4);
    const unsigned boffb = boff * 4u;
    const unsigned lds_u = (unsigned)(unsigned long)lds;
    const unsigned bw_a0 = lds_u + (unsigned)b_wr0, bw_a1 = lds_u + (unsigned)b_wr1;
    const int a_dma0 = wid * 1024, a_dma1 = (8 + wid) * 1024;

#define SA_(b, h) (((b) * 2 + (h)) * GHTB)
#define SB_(b, h) ((4 + (b) * 2 + (h)) * GHTB)
#define STAGE_A(b, h, kt) do { const bf16_t* _g = A + (size_t)(kt) * astep; \
        dma16((const void*)_g, aoff[h][0], lds_u + SA_(b, h) + a_dma0); \
        dma16((const void*)_g, aoff[h][1], lds_u + SA_(b, h) + a_dma1); } while (0)
#define BLOAD2(R, kt, j0) asm volatile("s_nop 4\n\tglobal_load_dwordx4 %0, %2, %3\n\tglobal_load_dwordx4 %1, %2, %4" \
        : "=&v"(R[(j0) & 3]), "=&v"(R[((j0) & 3) + 1]) : "v"(boffb), "s"(B + (size_t)(kt) * bstep + (size_t)(j0) * LDB), "s"(B + (size_t)(kt) * bstep + (size_t)((j0) + 1) * LDB) : "memory")
#define BWAIT(R, n) asm volatile("s_waitcnt vmcnt(" #n ")" : "+v"(R[0]), "+v"(R[1]), "+v"(R[2]), "+v"(R[3]) :: "memory")
#define BWRITE_H(R, b, hi) do { _Pragma("unroll") for (int _i = 0; _i < 4; ++_i) { u32x2 _w; \
            _w.x = cvt_pk_bf16(R[0][_i], R[1][_i]); _w.y = cvt_pk_bf16(R[2][_i], R[3][_i]); \
            asm volatile("ds_write_b64 %0, %1 offset:%2" :: "v"((_i < 2) ? bw_a0 : bw_a1), "v"(_w), "n"((b) * 2 * GHTB + (_i & 1) * 128 + (hi) * 8) : "memory"); } } while (0)
#define LDA(dst, b, h) do { _Pragma("unroll") for (int _m = 0; _m < 4; ++_m) { \
        dst[_m][0] = *(LAS3 const bf16x8*)(lds + SA_(b, h) + a_rd0 + _m * 2048); \
        dst[_m][1] = *(LAS3 const bf16x8*)(lds + SA_(b, h) + a_rd1 + _m * 2048); } } while (0)
#define LDB_(dst, b, h) do { _Pragma("unroll") for (int _n = 0; _n < 2; ++_n) { \
        dst[_n][0] = *(LAS3 const bf16x8*)(lds + SB_(b, h) + b_rd0 + _n * 8192); \
        dst[_n][1] = *(LAS3 const bf16x8*)(lds + SB_(b, h) + b_rd1 + _n * 8192); } } while (0)
#define MMA(ai, bj, Af, Bf) do { __builtin_amdgcn_s_setprio(1); \
        _Pragma("unroll") for (int _m = 0; _m < 4; ++_m) _Pragma("unroll") for (int _n = 0; _n < 2; ++_n) _Pragma("unroll") for (int _k = 0; _k < 2; ++_k) \
            acc[ai][bj][_m][_n] = __builtin_amdgcn_mfma_f32_16x16x32_bf16(Bf[_n][_k], Af[_m][_k], acc[ai][bj][_m][_n], 0, 0, 0); \
        __builtin_amdgcn_s_setprio(0); } while (0)

    f32x4 blo[4], bhi[4];
    bf16x8 At[4][2], B0[2][2], B1[2][2];
#pragma unroll
    for (int ai = 0; ai < 2; ++ai)
#pragma unroll
        for (int bj = 0; bj < 2; ++bj)
#pragma unroll
            for (int m = 0; m < 4; ++m)
#pragma unroll
                for (int n = 0; n < 2; ++n) acc[ai][bj][m][n] = (f32x4){0.f, 0.f, 0.f, 0.f};

    __builtin_amdgcn_s_waitcnt(0);
    const int p1 = (1 < nt) ? 1 : 0;
    BLOAD2(blo, 0, 0); BLOAD2(blo, 0, 2); BLOAD2(bhi, 0, 4); BLOAD2(bhi, 0, 6); STAGE_A(0, 0, 0); STAGE_A(0, 1, 0);
    BWAIT(blo, 4); BWAIT(bhi, 4); BWRITE_H(blo, 0, 0); BWRITE_H(bhi, 0, 1);
    BLOAD2(blo, p1, 0); BLOAD2(blo, p1, 2); STAGE_A(1, 0, p1); BLOAD2(bhi, p1, 4);
    G_WAIT_V(2);
    G_WAIT_L(0);
    if (wr == 1) G_BAR;
    G_BAR;
    for (int t = 0; t < nt; t += 2) {
        const int t1 = (t + 1 < nt) ? t + 1 : nt - 1, t2 = (t + 2 < nt) ? t + 2 : nt - 1, t3 = (t + 3 < nt) ? t + 3 : nt - 1;
        LDB_(B0, 0, 0); G_SCHED; LDA(At, 0, 0); BLOAD2(bhi, t1, 6); STAGE_A(1, 1, t1);
        G_WAIT_L(8); G_BAR; G_WAIT_L(0); MMA(0, 0, At, B0); G_BAR; G_SCHED;
        LDB_(B1, 0, 1); BWAIT(blo, 8); BWRITE_H(blo, 1, 0); BLOAD2(blo, t2, 0);
        G_BAR; G_WAIT_L(0); MMA(0, 1, At, B1); G_BAR;
        LDA(At, 0, 1); BLOAD2(blo, t2, 2); STAGE_A(0, 0, t2);
        G_BAR; G_WAIT_L(0); MMA(1, 0, At, B0); G_BAR; G_SCHED;
        BWAIT(bhi, 8); BWRITE_H(bhi, 1, 1); BLOAD2(bhi, t2, 4);
        G_WAIT_V(8); G_WAIT_L(0); G_BAR; MMA(1, 1, At, B1); G_BAR;
        LDB_(B0, 1, 0); G_SCHED; LDA(At, 1, 0); BLOAD2(bhi, t2, 6); STAGE_A(0, 1, t2);
        G_WAIT_L(8); G_BAR; G_WAIT_L(0); MMA(0, 0, At, B0); G_BAR; G_SCHED;
        LDB_(B1, 1, 1); BWAIT(blo, 8); BWRITE_H(blo, 0, 0); BLOAD2(blo, t3, 0);
        G_BAR; G_WAIT_L(0); MMA(0, 1, At, B1); G_BAR;
        LDA(At, 1, 1); BLOAD2(blo, t3, 2); STAGE_A(1, 0, t3);
        G_BAR; G_WAIT_L(0); MMA(1, 0, At, B0); G_BAR; G_SCHED;
        BWAIT(bhi, 8); BWRITE_H(bhi, 0, 1); BLOAD2(bhi, t3, 4);
        G_WAIT_V(8); G_WAIT_L(0); G_BAR; MMA(1, 1, At, B1); G_BAR;
    }
    G_WAIT_V(0); G_WAIT_L(0);
    if (wr == 0) G_BAR;
    G_BAR;
#undef SA_
#undef SB_
#undef STAGE_A
#undef BLOAD2
#undef BWRITE_H
#undef BWAIT
#undef LDA
#undef LDB_
#undef MMA
}

typedef int v8i32 __attribute__((ext_vector_type(8)));
typedef short v2s16 __attribute__((ext_vector_type(2)));
typedef int i32x4 __attribute__((ext_vector_type(4)));
#ifndef F8_WSCALE
#define F8_WSCALE 0.00390625f
#endif
template <int LDB>
__device__ __forceinline__ void gemm_kloop_f8(f32x4 (&acc)[2][2][4][2], const unsigned char* __restrict__ A, const unsigned (&aoff)[2][2],
                                              const float* __restrict__ B, unsigned boff, int nt, LAS3 char* lds, int tid, int wid, int pam = 1, int pbm = 1) {
    const int lane = tid & 63, wr = wid >> 2, wc = wid & 3, fr = lane & 15, fq = lane >> 4;
    const int c0 = fq ^ (fr >> 1);
    const int a_rd0 = (wr * 64 + fr) * 128 + c0 * 16, a_rd1 = (wr * 64 + fr) * 128 + (c0 ^ 4) * 16;
    const int b_rd0 = (wc * 16 + fr) * 128 + ((c0 ^ (wc & 1)) * 16), b_rd1 = (wc * 16 + fr) * 128 + ((c0 ^ (wc & 1) ^ 4) * 16);
    const int k8 = wid, n4 = tid & 63, bhalf = n4 >> 5, nloc = (n4 & 31) * 4;
    const int sw0 = (((n4 & 3) * 2) & 7) ^ ((n4 >> 2) & 1), sw1 = (((n4 & 3) * 2 + 1) & 7) ^ ((n4 >> 2) & 1);
    const int b_wr0 = (4 + bhalf) * GHTB + nloc * 128 + ((k8 ^ sw0) << 4);
    const int b_wr1 = (4 + bhalf) * GHTB + (nloc + 2) * 128 + ((k8 ^ sw1) << 4);
    const unsigned boffb = boff * 4u;
    const unsigned lds_u = (unsigned)(unsigned long)lds;
    const unsigned bw_a0 = lds_u + (unsigned)b_wr0, bw_a1 = lds_u + (unsigned)b_wr1;
    const int a_dma0 = wid * 1024, a_dma1 = (8 + wid) * 1024;
    const size_t bstep = (size_t)128 * LDB * pbm, astepb = (size_t)128 * pam;

#define SA_(b, h) (((b) * 2 + (h)) * GHTB)
#define SB_(b, h) ((4 + (b) * 2 + (h)) * GHTB)
#define STAGE_A(b, h, kt) do { const unsigned char* _g = A + (size_t)(kt) * astepb; \
        dma16((const void*)_g, aoff[h][0], lds_u + SA_(b, h) + a_dma0); \
        dma16((const void*)_g, aoff[h][1], lds_u + SA_(b, h) + a_dma1); } while (0)
#define QLOAD(R, kt, q) do { \
        asm volatile("s_nop 4\n\tglobal_load_dwordx4 %0, %2, %3\n\tglobal_load_dwordx4 %1, %2, %4" : "=&v"(R[0]), "=&v"(R[1]) \
            : "v"(boffb), "s"(B + (size_t)(kt) * bstep + (size_t)(4 * (q)) * LDB), "s"(B + (size_t)(kt) * bstep + (size_t)(4 * (q) + 1) * LDB) : "memory"); \
        asm volatile("s_nop 4\n\tglobal_load_dwordx4 %0, %2, %3\n\tglobal_load_dwordx4 %1, %2, %4" : "=&v"(R[2]), "=&v"(R[3]) \
            : "v"(boffb), "s"(B + (size_t)(kt) * bstep + (size_t)(4 * (q) + 2) * LDB), "s"(B + (size_t)(kt) * bstep + (size_t)(4 * (q) + 3) * LDB) : "memory"); } while (0)
#define QWAIT4(R, n) QWAIT(R, n)
#define QWAIT(R, n) asm volatile("s_waitcnt vmcnt(" #n ")" : "+v"(R[0]), "+v"(R[1]), "+v"(R[2]), "+v"(R[3]) :: "memory")
#define QCVTW(R, b, q) do { _Pragma("unroll") for (int _i = 0; _i < 4; ++_i) { \
            cvd = __builtin_amdgcn_cvt_scalef32_pk_fp8_f32(cvd, R[0][_i], R[1][_i], F8_WSCALE, false); \
            cvd = __builtin_amdgcn_cvt_scalef32_pk_fp8_f32(cvd, R[2][_i], R[3][_i], F8_WSCALE, true); \
            asm volatile("ds_write_b32 %0, %1 offset:%2" :: "v"((_i < 2) ? bw_a0 : bw_a1), "v"(cvd), "n"((b) * 2 * GHTB + (_i & 1) * 128 + (q) * 4) : "memory"); } } while (0)
#define LDA1(dst, b, h, m) do { \
        dst.lo = *(LAS3 const i32x4*)(lds + SA_(b, h) + a_rd0 + (m) * 2048); \
        dst.hi = *(LAS3 const i32x4*)(lds + SA_(b, h) + a_rd1 + (m) * 2048); } while (0)
#define LDB4(dst, b) do { _Pragma("unroll") for (int _h = 0; _h < 2; ++_h) _Pragma("unroll") for (int _n = 0; _n < 2; ++_n) { \
        dst[_h * 2 + _n].lo = *(LAS3 const i32x4*)(lds + SB_(b, _h) + b_rd0 + _n * 8192); \
        dst[_h * 2 + _n].hi = *(LAS3 const i32x4*)(lds + SB_(b, _h) + b_rd1 + _n * 8192); } } while (0)
#define MF4(ai, m, slot) do { _Pragma("unroll") for (int _j = 0; _j < 4; ++_j) \
            acc[ai][_j >> 1][m][_j & 1] = __builtin_amdgcn_mfma_scale_f32_16x16x128_f8f6f4(Bx[_j], slot, acc[ai][_j >> 1][m][_j & 1], 0, 0, 0, 0x7f7f7f77, 1, 0x7f7f7f77); } while (0)
#define MMA16(ai, b, h) do { __builtin_amdgcn_s_setprio(1); MF4(ai, 0, A0); G_SCHED; LDA1(A0, b, h, 2); G_SCHED; MF4(ai, 1, A1); G_SCHED; LDA1(A1, b, h, 3); G_SCHED; \
        G_WAIT_L(2); MF4(ai, 2, A0); G_SCHED; G_WAIT_L(0); MF4(ai, 3, A1); __builtin_amdgcn_s_setprio(0); } while (0)

    f32x4 s0[4], s1[4];
    v2s16 cvd; asm("" : "=v"(cvd));
    v8i32 A0, A1, Bx[4];
#pragma unroll
    for (int ai = 0; ai < 2; ++ai)
#pragma unroll
        for (int bj = 0; bj < 2; ++bj)
#pragma unroll
            for (int m = 0; m < 4; ++m)
#pragma unroll
                for (int n = 0; n < 2; ++n) acc[ai][bj][m][n] = (f32x4){0.f, 0.f, 0.f, 0.f};

    const int p1 = (1 < nt) ? 1 : 0;
    QLOAD(acc[0][0][0], 0, 0); QLOAD(acc[0][0][2], 0, 1); QLOAD(acc[0][1][0], 0, 2); QLOAD(acc[0][1][2], 0, 3);
    STAGE_A(0, 0, 0); STAGE_A(0, 1, 0);
    QLOAD(s0, p1, 0); QLOAD(s1, p1, 1);
    __builtin_amdgcn_s_waitcnt(0);
    QWAIT4(acc[0][0][0], 0); QWAIT4(acc[0][0][2], 0); QWAIT4(acc[0][1][0], 0); QWAIT4(acc[0][1][2], 0); QWAIT(s0, 0); QWAIT(s1, 0);
    QCVTW(acc[0][0][0], 0, 0); QCVTW(acc[0][0][2], 0, 1); QCVTW(acc[0][1][0], 0, 2); QCVTW(acc[0][1][2], 0, 3);
#pragma unroll
    for (int bj = 0; bj < 2; ++bj)
#pragma unroll
        for (int m = 0; m < 4; ++m)
#pragma unroll
            for (int n = 0; n < 2; ++n) acc[0][bj][m][n] = (f32x4){0.f, 0.f, 0.f, 0.f};
    G_WAIT_L(0);
    if (wr == 1) G_BAR;
    G_BAR;
#define KTILE(b, tn1, tn2) do { \
          \
        LDB4(Bx, b); G_SCHED; LDA1(A0, b, 0, 0); LDA1(A1, b, 0, 1); \
        QWAIT(s0, 6); QCVTW(s0, (b) ^ 1, 0); QLOAD(s0, tn1, 2); QWAIT(s1, 6); QCVTW(s1, (b) ^ 1, 1); QLOAD(s1, tn1, 3); STAGE_A((b) ^ 1, 0, tn1); \
        G_WAIT_V(10); G_BAR; G_WAIT_L(0); MMA16(0, b, 0); G_BAR; G_SCHED; \
          \
        LDA1(A0, b, 1, 0); LDA1(A1, b, 1, 1); \
        QWAIT(s0, 6); QCVTW(s0, (b) ^ 1, 2); QLOAD(s0, tn2, 0); QWAIT(s1, 6); QCVTW(s1, (b) ^ 1, 3); QLOAD(s1, tn2, 1); STAGE_A((b) ^ 1, 1, tn1); \
        G_WAIT_V(10); G_WAIT_L(0); G_BAR; MMA16(1, b, 1); G_BAR; G_SCHED; } while (0)
    for (int t = 0; t < nt; t += 2) {
        const int t1 = (t + 1 < nt) ? t + 1 : nt - 1, t2 = (t + 2 < nt) ? t + 2 : nt - 1, t3 = (t + 3 < nt) ? t + 3 : nt - 1;
        KTILE(0, t1, t2);
        KTILE(1, t2, t3);
    }
    G_WAIT_V(0); G_WAIT_L(0);
    if (wr == 0) G_BAR;
    G_BAR;
#undef KTILE
#undef SA_
#undef SB_
#undef STAGE_A
#undef QLOAD
#undef QWAIT
#undef QCVTW
#undef LDA1
#undef MF4
#undef MMA16
#undef LDB4
#undef QWAIT4
}


__device__ __forceinline__ int lane_id() { int r; asm volatile("v_mbcnt_lo_u32_b32 %0, -1, 0\n\tv_mbcnt_hi_u32_b32 %0, -1, %0" : "=v"(r)); return r; }
#define SWZ_XOR(v, o) __int_as_float(__builtin_amdgcn_ds_swizzle(__float_as_int(v), ((o) << 10) | 0x1F))
__device__ __forceinline__ float half_sum32(float v) {
    v += SWZ_XOR(v, 16); v += SWZ_XOR(v, 8); v += SWZ_XOR(v, 4); v += SWZ_XOR(v, 2); v += SWZ_XOR(v, 1);
    return v;
}
__device__ __forceinline__ float xor32(float v) { const int l = lane_id(); return __int_as_float(__builtin_amdgcn_ds_bpermute((l ^ 32) << 2, __float_as_int(v))); }
__device__ __forceinline__ float wave_sum(float v) { v = half_sum32(v); return v + xor32(v); }
typedef int v8i32d __attribute__((ext_vector_type(8)));
typedef int i32x4d __attribute__((ext_vector_type(4)));
template <bool F8, bool BSW = false, int ROWB = 0, bool ACCUM = false>
__device__ __forceinline__ void gemm_kloop_dma(f32x4 (&acc)[2][2][4][2], const unsigned char* __restrict__ A, const unsigned (&aoff)[2][2],
                                               const unsigned char* __restrict__ img, int nt, LAS3 char* lds, int tid, int wid, int kbase = 0) {
    constexpr int KMASK = F8 ? 15 : 31;
#define KT_(kt) ((kbase + (kt)) & KMASK)
    const int lane = tid & 63, wr = wid >> 2, wc = wid & 3, fr = lane & 15, fq = lane >> 4;
    const int c0 = fq ^ (fr >> 1);
    const int a_rd0 = (wr * 64 + fr) * 128 + c0 * 16, a_rd1 = (wr * 64 + fr) * 128 + (c0 ^ 4) * 16;
    const int cb = BSW ? (c0 ^ (wc & 1)) : c0;
    const int b_rd0 = (wc * 16 + fr) * 128 + cb * 16, b_rd1 = (wc * 16 + fr) * 128 + (cb ^ 4) * 16;
    const unsigned lds_u = (unsigned)(unsigned long)lds;
    LAS3 const char* ap0 = lds + a_rd0; LAS3 const char* ap1 = lds + a_rd1; LAS3 const char* bp0 = lds + 4 * GHTB + b_rd0; LAS3 const char* bp1 = lds + 4 * GHTB + b_rd1;
    asm volatile("" : "+v"(ap0), "+v"(ap1), "+v"(bp0), "+v"(bp1));
    const int dma0 = wid * 1024, dma1 = (8 + wid) * 1024;
    const unsigned boffl = (unsigned)lane * 16u;

#define SA_(b, h) (((b) * 2 + (h)) * GHTB)
#define SB_(b, h) ((4 + (b) * 2 + (h)) * GHTB)
#define STG_A(b, h, kt) do { const unsigned char* _g = A + (size_t)KT_(kt) * 128; \
        dma16((const void*)(_g + (size_t)((h) * 128) * ROWB), ROWB ? aoff[0][0] : aoff[h][0], lds_u + SA_(b, h) + dma0); \
        dma16((const void*)(_g + (size_t)((h) * 128 + 64) * ROWB), ROWB ? aoff[0][0] : aoff[h][1], lds_u + SA_(b, h) + dma1); } while (0)
#define STG_B(b, h, kt) do { const unsigned char* _g = img + (size_t)KT_(kt) * 32768 + (h) * 16384; \
        dma16((const void*)(_g + dma0), boffl, lds_u + SB_(b, h) + dma0); \
        dma16((const void*)(_g + dma1), boffl, lds_u + SB_(b, h) + dma1); } while (0)
#define LDA_(dst, b, h) do { _Pragma("unroll") for (int _m = 0; _m < 4; ++_m) { \
        dst[_m].lo = *(LAS3 const i32x4d*)(ap0 + SA_(b, h) + _m * 2048); \
        dst[_m].hi = *(LAS3 const i32x4d*)(ap1 + SA_(b, h) + _m * 2048); } } while (0)
#define LDBF(dst, b, h) do { _Pragma("unroll") for (int _n = 0; _n < 2; ++_n) { \
        dst[_n].lo = *(LAS3 const i32x4d*)(bp0 + (SB_(b, h) - 4 * GHTB) + _n * 8192); \
        dst[_n].hi = *(LAS3 const i32x4d*)(bp1 + (SB_(b, h) - 4 * GHTB) + _n * 8192); } } while (0)
#define MMAD(ai, bj, Af, Bf) do { __builtin_amdgcn_s_setprio(1); \
        _Pragma("unroll") for (int _m = 0; _m < 4; ++_m) _Pragma("unroll") for (int _n = 0; _n < 2; ++_n) { \
            if (F8) acc[ai][bj][_m][_n] = __builtin_amdgcn_mfma_scale_f32_16x16x128_f8f6f4(Bf[_n], Af[_m], acc[ai][bj][_m][_n], 0, 0, 0, 0x7f7f7f77, 1, 0x7f7f7f77); \
            else { const i32x4d _bl = Bf[_n].lo, _bh = Bf[_n].hi, _al = Af[_m].lo, _ah = Af[_m].hi;     \
                   acc[ai][bj][_m][_n] = __builtin_amdgcn_mfma_f32_16x16x32_bf16(__builtin_bit_cast(bf16x8, _bl), __builtin_bit_cast(bf16x8, _al), acc[ai][bj][_m][_n], 0, 0, 0); \
                   acc[ai][bj][_m][_n] = __builtin_amdgcn_mfma_f32_16x16x32_bf16(__builtin_bit_cast(bf16x8, _bh), __builtin_bit_cast(bf16x8, _ah), acc[ai][bj][_m][_n], 0, 0, 0); } } \
        __builtin_amdgcn_s_setprio(0); } while (0)

    v8i32d At[4], B0[2], B1[2];
    if (!ACCUM)
#pragma unroll
    for (int ai = 0; ai < 2; ++ai)
#pragma unroll
        for (int bj = 0; bj < 2; ++bj)
#pragma unroll
            for (int m = 0; m < 4; ++m)
#pragma unroll
                for (int n = 0; n < 2; ++n) acc[ai][bj][m][n] = (f32x4){0.f, 0.f, 0.f, 0.f};
    STG_B(0, 0, 0); STG_A(0, 0, 0); STG_B(0, 1, 0); STG_A(0, 1, 0);
    __builtin_amdgcn_s_waitcnt(0);
    { int wr1 = wid >> 2; asm volatile("" : "+s"(wr1)); if (wr1 == 1) G_BAR; }
    G_BAR;
    { const int p1 = (1 < nt) ? 1 : 0; STG_B(1, 0, p1); STG_A(1, 0, p1); STG_B(1, 1, p1); }
    G_WAIT_V(6); G_BAR;
    for (int t = 0; t < nt; t += 2) {
        const int t1 = (t + 1 < nt) ? t + 1 : nt - 1, t2 = (t + 2 < nt) ? t + 2 : nt - 1, t3 = (t + 3 < nt) ? t + 3 : nt - 1;
        LDBF(B0, 0, 0); G_SCHED; LDA_(At, 0, 0); STG_A(1, 1, t1);
        G_WAIT_L(8); G_BAR; G_WAIT_L(0); MMAD(0, 0, At, B0); G_BAR; G_SCHED;
        LDBF(B1, 0, 1); STG_B(0, 0, t2);
        G_BAR; G_WAIT_L(0); MMAD(0, 1, At, B1); G_BAR;
        LDA_(At, 0, 1); STG_A(0, 0, t2);
        G_BAR; G_WAIT_L(0); MMAD(1, 0, At, B0); G_BAR; G_SCHED;
        STG_B(0, 1, t2);
        G_WAIT_V(6); G_BAR; MMAD(1, 1, At, B1); G_BAR;
        LDBF(B0, 1, 0); G_SCHED; LDA_(At, 1, 0); STG_A(0, 1, t2);
        G_WAIT_L(8); G_BAR; G_WAIT_L(0); MMAD(0, 0, At, B0); G_BAR; G_SCHED;
        LDBF(B1, 1, 1); STG_B(1, 0, t3);
        G_BAR; G_WAIT_L(0); MMAD(0, 1, At, B1); G_BAR;
        LDA_(At, 1, 1); STG_A(1, 0, t3);
        G_BAR; G_WAIT_L(0); MMAD(1, 0, At, B0); G_BAR; G_SCHED;
        STG_B(1, 1, t3);
        G_WAIT_V(6); G_BAR; MMAD(1, 1, At, B1); G_BAR;
    }
    G_WAIT_V(0); G_WAIT_L(0);
    { int wr0 = wid >> 2; asm volatile("" : "+s"(wr0)); if (wr0 == 0) G_BAR; }
    G_BAR;
#undef SA_
#undef SB_
#undef STG_A
#undef STG_B
#undef LDA_
#undef LDBF
#undef MMAD
#undef KT_
}

template <bool F8, int LDB>
__device__ __forceinline__ void convert_tile(const float* __restrict__ W, int col0, int col1, int nkt, unsigned char* __restrict__ img, LAS3 char* lds, int wid) {
    constexpr int RPT = F8 ? 16 : 8;
    int lane = lane_id(); asm volatile("" : "+v"(lane));
    const int n4 = lane, half = n4 >> 5, nloc = (n4 & 31) * 4;
    const float* src = W + (size_t)(wid * RPT) * LDB + ((n4 < 32) ? col0 + n4 * 4 : col1 + (n4 - 32) * 4);
    for (int kt = 0; kt < nkt; ++kt) {
        f32x4 r[RPT];
#pragma unroll
        for (int j = 0; j < RPT; ++j) r[j] = *(const f32x4*)(src + (size_t)(kt * (RPT * 8) + j) * LDB);
        LAS3 char* buf = lds + (kt & 1) * 32768;
#pragma unroll
        for (int i = 0; i < 4; ++i) {
            u32x4 w;
            if (F8) {
#pragma unroll
                for (int q = 0; q < 4; ++q) {
                    int d = __builtin_amdgcn_cvt_pk_fp8_f32(r[4 * q][i] * 256.0f, r[4 * q + 1][i] * 256.0f, 0, false);
                    d = __builtin_amdgcn_cvt_pk_fp8_f32(r[4 * q + 2][i] * 256.0f, r[4 * q + 3][i] * 256.0f, d, true);
                    w[q] = (unsigned)d;
                }
            } else {
                w.x = cvt_pk_bf16(r[0][i], r[1][i]); w.y = cvt_pk_bf16(r[2][i], r[3][i]); w.z = cvt_pk_bf16(r[4][i], r[5][i]); w.w = cvt_pk_bf16(r[6][i], r[7][i]);
            }
            const int row = nloc + i;
            *(LAS3 u32x4*)(buf + half * 16384 + row * 128 + ((wid ^ ((row >> 1) & 7)) << 4)) = w;
        }
        __syncthreads();
#pragma unroll
        for (int j = 0; j < 4; ++j) {
            const u32x4 v = *(LAS3 const u32x4*)(buf + wid * 4096 + j * 1024 + lane * 16);
            *(u32x4*)(img + (size_t)kt * 32768 + wid * 4096 + j * 1024 + lane * 16) = v;
        }
    }
    __syncthreads();
}

__device__ __forceinline__ float gelu_exact(float x) { return 0.5f * x * (1.0f + erff(x * 0.70710678118654752f)); }
__device__ __forceinline__ float bf2f(bf16_t v) { return __uint_as_float((unsigned)v << 16); }
__device__ __forceinline__ bf16_t f2bf(float v) { return (bf16_t)(cvt_pk_bf16(v, 0.f) & 0xffffu); }

struct GemmArgs {
    const bf16_t* A; const float* B; const float* bias; const float* R;
    void* C;
    const int* list; const int* cnt;
    int* done;
    int* pend;
};

constexpr int EST_BF16 = 528;
constexpr int EST_F8 = 144;
constexpr int LDS_BIAS = 256 * EST_BF16 + 3072;
__device__ __forceinline__ void epi_stage_bf16(const f32x4 (&v)[2][2], int r, int colw, LAS3 char* lds) {
#pragma unroll
    for (int bj = 0; bj < 2; ++bj)
#pragma unroll
        for (int n = 0; n < 2; ++n) { u32x2 o; o.x = cvt_pk_bf16(v[bj][n][0], v[bj][n][1]); o.y = cvt_pk_bf16(v[bj][n][2], v[bj][n][3]);
            *(LAS3 u32x2*)(lds + r * EST_BF16 + (bj * 128 + n * 64 + colw) * 2) = o; }
}
__device__ __forceinline__ void epi_flush_bf16(bf16_t* C, size_t ld, int grow0, int col0, int nvalid, LAS3 char* lds, int tid) {
    __syncthreads();
    const int chunk = tid & 31, r0 = tid >> 5;
#pragma unroll 4
    for (int it = 0; it < 16; ++it) { const int row = it * 16 + r0;
        if (row < nvalid) { const u32x4 q = *(LAS3 const u32x4*)(lds + row * EST_BF16 + chunk * 16); *(u32x4*)(C + (size_t)(grow0 + row) * ld + col0 + chunk * 8) = q; } }
    __syncthreads();
}
__device__ __forceinline__ void epi_flush_f8(unsigned char* C, size_t ld, int grow0, int col0, int nvalid, LAS3 char* lds, int tid) {
    __syncthreads();
    const int chunk = tid & 7, r0 = tid >> 3;
#pragma unroll
    for (int it = 0; it < 4; ++it) { const int row = it * 64 + r0;
        if (row < nvalid) { const u32x4 q = *(LAS3 const u32x4*)(lds + row * EST_F8 + chunk * 16);
            const unsigned off = (unsigned)(grow0 + row) * (unsigned)ld + (unsigned)(col0 + chunk * 16);
            asm volatile("s_nop 4\n\tglobal_store_dwordx4 %0, %1, %2 sc1\n\ts_nop 1" :: "v"(off), "v"(q), "s"(C) : "memory"); } }
    __syncthreads();
}

constexpr int EST_F8W = 272;
__device__ __forceinline__ void epi_flush_f8w(unsigned char* C, size_t ld, int grow0, int col0, int nvalid, LAS3 char* lds, int tid) {
    __syncthreads();
    const int chunk = tid & 15, r0 = tid >> 4;
#pragma unroll
    for (int it = 0; it < 8; ++it) { const int row = it * 32 + r0;
        if (row < nvalid) { const u32x4 q = *(LAS3 const u32x4*)(lds + row * EST_F8W + chunk * 16); *(u32x4*)(C + (size_t)(grow0 + row) * ld + col0 + chunk * 16) = q; } }
    __syncthreads();
}
template <int EPI, int VAR = 0>
__device__ __forceinline__ void gemm_tile(const GemmArgs& g, int pm, int pn, int e, int ebase, int ecnt, LAS3 char* lds, int wid, int pa = 1, int pb = 1) {
    constexpr int LDB = (EPI == 0) ? DIN : (EPI == 2) ? 2 * DFF : D;
    int tid = wid * 64 + lane_id(); asm volatile("" : "+v"(tid));
    const int lane = tid & 63;
    unsigned aoff[2][2];
#pragma unroll
    for (int h = 0; h < 2; ++h)
#pragma unroll
        for (int i = 0; i < 2; ++i) {
            const int rih = (i * 8 + wid) * 8 + (lane >> 3);
            const int chunk = (lane & 7) ^ ((rih >> 1) & 7);
            int r = pm * 256 + h * 128 + rih;
            unsigned grow;
            if (EPI == 2) { if (r >= ecnt) r = ecnt - 1; grow = (unsigned)(g.list[e * T + r] >> 2); }
            else if (EPI == 3) { grow = (unsigned)(ebase + r); }
            else grow = (unsigned)r;
            aoff[h][i] = (EPI >= 2) ? (grow * (unsigned)D + (unsigned)(chunk * 16)) : (grow * (unsigned)D + (unsigned)(chunk * 8)) * 2u;
        }
    const int k8 = wid, n4 = tid & 63;
    int col;
    if (EPI == 2) col = (n4 < 32) ? pn * 128 + n4 * 4 : DFF + pn * 128 + (n4 - 32) * 4;
    else col = pn * 256 + n4 * 4;
    const unsigned boff = (unsigned)(k8 * ((EPI >= 2) ? 16 : 8)) * (unsigned)LDB + (unsigned)col;
    const float* Bp = g.B;
    if (EPI == 2) Bp += (size_t)e * D * (2 * DFF);
    if (EPI == 3) Bp += (size_t)e * DFF * D;
    if (EPI >= 2 && tid < 256) {
        float bvv;
        if (EPI == 2) bvv = (tid < 128) ? g.bias[(size_t)e * (2 * DFF) + pn * 128 + tid] : g.bias[(size_t)e * (2 * DFF) + DFF + pn * 128 + (tid - 128)] + 1.0f;
        else bvv = g.bias[(size_t)e * D + pn * 256 + tid];
        *(LAS3 float*)(lds + LDS_BIAS + tid * 4) = bvv;
    }
    if (EPI == 3) {
        if (g.pend) {
            asm volatile("s_waitcnt vmcnt(0)" ::: "memory"); __syncthreads();
            if (tid == 0) __hip_atomic_fetch_add(g.pend, 1, __ATOMIC_RELAXED, __HIP_MEMORY_SCOPE_AGENT);
        }
        if (tid == 0) { const int need = 16 * ((ecnt + 255) >> 8); unsigned sp = 0;
            while (__hip_atomic_load(g.done + e, __ATOMIC_RELAXED, __HIP_MEMORY_SCOPE_AGENT) < need) { __builtin_amdgcn_s_sleep(8); if (++sp > (1u << 20)) break; }
            __builtin_amdgcn_fence(__ATOMIC_ACQUIRE, "agent"); asm volatile("s_waitcnt vmcnt(0)" ::: "memory"); }
        __syncthreads();
    }
    f32x4 acc[2][2][4][2];
    if (EPI >= 2) gemm_kloop_f8<LDB>(acc, (const unsigned char*)g.A, aoff, Bp, boff, D / 128, lds, tid, wid, pa, pb);
    else gemm_kloop<LDB, VAR>(acc, g.A, aoff, Bp, boff, D / GBK, lds, tid, wid, (size_t)GBK * pa, (size_t)GBK * LDB * pb);
    int tz = wid * 64 + lane_id(); asm volatile("" : "+v"(tz));
    if (EPI == 2 && g.pend && tz == 0) __hip_atomic_fetch_add(g.pend, 1, __ATOMIC_RELAXED, __HIP_MEMORY_SCOPE_AGENT);
    const int wid2 = tz >> 6, lane2 = tz & 63;
    const int row0 = (wid2 >> 2) * 64 + (lane2 & 15), colw = (wid2 & 3) * 16 + (lane2 >> 4) * 4;
    if (EPI == 0) {
#pragma unroll
        for (int ai = 0; ai < 2; ++ai)
#pragma unroll
            for (int m = 0; m < 4; ++m) {
                f32x4 v[2][2];
#pragma unroll
                for (int bj = 0; bj < 2; ++bj)
#pragma unroll
                    for (int n = 0; n < 2; ++n) v[bj][n] = acc[ai][bj][m][n];
                epi_stage_bf16(v, ai * 128 + row0 + m * 16, colw, lds);
            }
        epi_flush_bf16((bf16_t*)g.C, DIN, pm * 256, pn * 256, 256, lds, tz);
    } else if (EPI == 1) {
        float* C = (float*)g.C;
#pragma unroll
        for (int ai = 0; ai < 2; ++ai)
#pragma unroll
            for (int m = 0; m < 4; ++m) {
                const size_t ro = (size_t)(pm * 256 + ai * 128 + row0 + m * 16) * D + pn * 256 + colw;
#pragma unroll
                for (int bj = 0; bj < 2; ++bj)
#pragma unroll
                    for (int n = 0; n < 2; ++n) { const f32x4 xr = *(const f32x4*)(g.R + ro + bj * 128 + n * 64);
                        *(f32x4*)(C + ro + bj * 128 + n * 64) = acc[ai][bj][m][n] + xr; }
            }
    } else if (EPI == 2) {
        unsigned char* C = (unsigned char*)g.C;
        f32x4 bgate[2], bup1[2];
#pragma unroll
        for (int n = 0; n < 2; ++n) { bgate[n] = *(LAS3 const f32x4*)(lds + LDS_BIAS + (n * 64 + colw) * 4); bup1[n] = *(LAS3 const f32x4*)(lds + LDS_BIAS + (128 + n * 64 + colw) * 4); }
#pragma unroll
        for (int ai = 0; ai < 2; ++ai)
#pragma unroll
            for (int m = 0; m < 4; ++m) {
                const int r = pm * 256 + ai * 128 + row0 + m * 16;
                {
                    LAS3 char* rp = lds + (ai * 128 + row0 + m * 16) * EST_F8 + colw;
#pragma unroll
                    for (int n = 0; n < 2; ++n) {
                        float o[4];
#pragma unroll
                        for (int j = 0; j < 4; j += 2) {
                            typedef float f32x2 __attribute__((ext_vector_type(2)));
                            f32x2 gt = (f32x2){acc[ai][0][m][n][j], acc[ai][0][m][n][j + 1]} + (f32x2){bgate[n][j], bgate[n][j + 1]};
                            f32x2 up = (f32x2){acc[ai][1][m][n][j], acc[ai][1][m][n][j + 1]} + (f32x2){bup1[n][j], bup1[n][j + 1]};
                            gt.x = fminf(gt.x, 7.0f); gt.y = fminf(gt.y, 7.0f);
                            up.x = __builtin_amdgcn_fmed3f(up.x, -6.0f, 8.0f); up.y = __builtin_amdgcn_fmed3f(up.y, -6.0f, 8.0f);
                            const f32x2 xe = gt * (-2.45546696f);
                            f32x2 ex; ex.x = __builtin_amdgcn_exp2f(xe.x); ex.y = __builtin_amdgcn_exp2f(xe.y);
                            const f32x2 den = ex + 1.0f;
                            f32x2 rc; rc.x = __builtin_amdgcn_rcpf(den.x); rc.y = __builtin_amdgcn_rcpf(den.y);
                            const f32x2 res = (gt * rc) * up;
                            o[j] = res.x; o[j + 1] = res.y;
                        }
                        int w = __builtin_amdgcn_cvt_pk_fp8_f32(o[0], o[1], 0, false);
                        w = __builtin_amdgcn_cvt_pk_fp8_f32(o[2], o[3], w, true);
                        *(LAS3 int*)(rp + n * 64) = w;
                    }
                }
            }
        { const int nv = ecnt - pm * 256; epi_flush_f8(C, DFF, ebase + pm * 256, pn * 128, nv < 256 ? nv : 256, lds, tz); }
    } else {
        bf16_t* C = (bf16_t*)g.C;
        f32x4 bv[2][2];
#pragma unroll
        for (int bj = 0; bj < 2; ++bj)
#pragma unroll
            for (int n = 0; n < 2; ++n) bv[bj][n] = *(LAS3 const f32x4*)(lds + LDS_BIAS + (bj * 128 + n * 64 + colw) * 4);
#pragma unroll
        for (int ai = 0; ai < 2; ++ai)
#pragma unroll
            for (int m = 0; m < 4; ++m) {
                LAS3 char* rp = lds + (ai * 128 + row0 + m * 16) * EST_F8W + colw;
#pragma unroll
                for (int bj = 0; bj < 2; ++bj)
#pragma unroll
                    for (int n = 0; n < 2; ++n) { const f32x4 v = acc[ai][bj][m][n] + bv[bj][n];
                        int w = __builtin_amdgcn_cvt_pk_fp8_f32(v[0], v[1], 0, false); w = __builtin_amdgcn_cvt_pk_fp8_f32(v[2], v[3], w, true);
                        *(LAS3 int*)(rp + bj * 128 + n * 64) = w; }
            }
        { const int nv = ecnt - pm * 256; epi_flush_f8w((unsigned char*)g.C, D, ebase + pm * 256, pn * 256, nv < 256 ? nv : 256, lds, tz); }
    }
}


template <int EPI>
__device__ __forceinline__ void gemm_tile_img(const GemmArgs& g, int pm, int pn, int e, int ebase, int ecnt, LAS3 char* lds, int wid, const unsigned char* img, int kh = -1) {
    int tid = wid * 64 + lane_id(); asm volatile("" : "+v"(tid));
    const int lane = tid & 63;
    unsigned aoff[2][2];
#pragma unroll
    for (int h = 0; h < 2; ++h)
#pragma unroll
        for (int i = 0; i < 2; ++i) {
            const int rih = (i * 8 + wid) * 8 + (lane >> 3);
            const int chunk = (lane & 7) ^ ((rih >> 1) & 7);
            int r = pm * 256 + h * 128 + rih;
            unsigned grow;
            if (EPI == 2) { if (r >= ecnt) r = ecnt - 1; grow = (unsigned)(g.list[e * T + r] >> 2); }
            else if (EPI == 3) { grow = (unsigned)(ebase + r); }
            else grow = (unsigned)r;
            aoff[h][i] = (EPI >= 2) ? (grow * (unsigned)D + (unsigned)(chunk * 16)) : (grow * (unsigned)D + (unsigned)(chunk * 8)) * 2u;
        }
    f32x4 acc[2][2][4][2];
    gemm_kloop_dma<(EPI >= 2), false, (EPI == 2) ? 0 : (EPI == 3) ? DFF : 2 * D>(acc, (const unsigned char*)g.A, aoff, img, (EPI >= 2) ? D / 128 : (EPI == 0 && kh >= 0) ? D / 128 : D / 64, lds, tid, wid, (EPI == 0 && kh > 0) ? D / 128 : 0);
    int tz = wid * 64 + lane_id(); asm volatile("" : "+v"(tz));
    const int wid2 = tz >> 6, lane2 = tz & 63;
    const int row0 = (wid2 >> 2) * 64 + (lane2 & 15), colw = (wid2 & 3) * 16 + (lane2 >> 4) * 4;
    if (EPI == 0) {
#pragma unroll
        for (int ai = 0; ai < 2; ++ai)
#pragma unroll
            for (int m = 0; m < 4; ++m) {
                f32x4 v[2][2];
#pragma unroll
                for (int bj = 0; bj < 2; ++bj)
#pragma unroll
                    for (int n = 0; n < 2; ++n) v[bj][n] = acc[ai][bj][m][n];
                epi_stage_bf16(v, ai * 128 + row0 + m * 16, colw, lds);
            }
        if (kh > 0) epi_flush_bf16((bf16_t*)g.R, DIN - 4096, pm * 256, pn * 256 - 4096, 256, lds, tz);
        else epi_flush_bf16((bf16_t*)g.C, DIN, pm * 256, pn * 256, 256, lds, tz);
    } else if (EPI == 1) {
        float* C = (float*)g.C;
#pragma unroll
        for (int ai = 0; ai < 2; ++ai)
#pragma unroll
            for (int m = 0; m < 4; ++m) {
                const size_t ro = (size_t)(pm * 256 + ai * 128 + row0 + m * 16) * D + pn * 256 + colw;
#pragma unroll
                for (int bj = 0; bj < 2; ++bj)
#pragma unroll
                    for (int n = 0; n < 2; ++n) { const f32x4 xr = *(const f32x4*)(g.R + ro + bj * 128 + n * 64);
                        *(f32x4*)(C + ro + bj * 128 + n * 64) = acc[ai][bj][m][n] + xr; }
            }
    } else if (EPI == 2) {
        unsigned char* C = (unsigned char*)g.C;
        const float* bg = g.bias + (size_t)e * (2 * DFF) + pn * 128 + colw;
        f32x4 bgate[2], bup1[2];
#pragma unroll
        for (int n = 0; n < 2; ++n) { bgate[n] = *(const f32x4*)(bg + n * 64); bup1[n] = *(const f32x4*)(bg + DFF + n * 64) + 1.0f; }
#pragma unroll
        for (int ai = 0; ai < 2; ++ai)
#pragma unroll
            for (int m = 0; m < 4; ++m) {
                const int r = pm * 256 + ai * 128 + row0 + m * 16;
                {
                    LAS3 char* rp = lds + (ai * 128 + row0 + m * 16) * EST_F8 + colw;
#pragma unroll
                    for (int n = 0; n < 2; ++n) {
                        float o[4];
#pragma unroll
                        for (int j = 0; j < 4; j += 2) {
                            typedef float f32x2 __attribute__((ext_vector_type(2)));
                            f32x2 gt = (f32x2){acc[ai][0][m][n][j], acc[ai][0][m][n][j + 1]} + (f32x2){bgate[n][j], bgate[n][j + 1]};
                            f32x2 up = (f32x2){acc[ai][1][m][n][j], acc[ai][1][m][n][j + 1]} + (f32x2){bup1[n][j], bup1[n][j + 1]};
                            gt.x = fminf(gt.x, 7.0f); gt.y = fminf(gt.y, 7.0f);
                            up.x = __builtin_amdgcn_fmed3f(up.x, -6.0f, 8.0f); up.y = __builtin_amdgcn_fmed3f(up.y, -6.0f, 8.0f);
                            const f32x2 xe = gt * (-2.45546696f);
                            f32x2 ex; ex.x = __builtin_amdgcn_exp2f(xe.x); ex.y = __builtin_amdgcn_exp2f(xe.y);
                            const f32x2 den = ex + 1.0f;
                            f32x2 rc; rc.x = __builtin_amdgcn_rcpf(den.x); rc.y = __builtin_amdgcn_rcpf(den.y);
                            const f32x2 res = (gt * rc) * up;
                            o[j] = res.x; o[j + 1] = res.y;
                        }
                        int w = __builtin_amdgcn_cvt_pk_fp8_f32(o[0], o[1], 0, false);
                        w = __builtin_amdgcn_cvt_pk_fp8_f32(o[2], o[3], w, true);
                        *(LAS3 int*)(rp + n * 64) = w;
                    }
                }
            }
        { const int nv = ecnt - pm * 256; epi_flush_f8(C, DFF, ebase + pm * 256, pn * 128, nv < 256 ? nv : 256, lds, tz); }
    } else {
        bf16_t* C = (bf16_t*)g.C;
        const float* bd = g.bias + (size_t)e * D + pn * 256 + colw;
        f32x4 bv[2][2];
#pragma unroll
        for (int bj = 0; bj < 2; ++bj)
#pragma unroll
            for (int n = 0; n < 2; ++n) bv[bj][n] = *(const f32x4*)(bd + bj * 128 + n * 64);
#pragma unroll
        for (int ai = 0; ai < 2; ++ai)
#pragma unroll
            for (int m = 0; m < 4; ++m) {
                LAS3 char* rp = lds + (ai * 128 + row0 + m * 16) * EST_F8W + colw;
#pragma unroll
                for (int bj = 0; bj < 2; ++bj)
#pragma unroll
                    for (int n = 0; n < 2; ++n) { const f32x4 v = acc[ai][bj][m][n] + bv[bj][n];
                        int w = __builtin_amdgcn_cvt_pk_fp8_f32(v[0], v[1], 0, false); w = __builtin_amdgcn_cvt_pk_fp8_f32(v[2], v[3], w, true);
                        *(LAS3 int*)(rp + bj * 128 + n * 64) = w; }
            }
        { const int nv = ecnt - pm * 256; epi_flush_f8w((unsigned char*)g.C, D, ebase + pm * 256, pn * 256, nv < 256 ? nv : 256, lds, tz); }
    }
}

#define XB_TMO      128
#define XB_XCNT(j)  (256  + 64 * (j))
#define XB_XSUB(j)  (1280 + 64 * (j))
#define XB_XGEN(j)  (2304 + 64 * (j))
#define XB_TOP      3328
#define XB_TOPGEN   3392
#define XCD_BAR_WORDS 3456
#define XB_SPIN_CAP (1u << 18)
#define LAS __attribute__((address_space(3)))

__device__ __forceinline__ unsigned xb_ld(unsigned* p)              { return __hip_atomic_load(p, __ATOMIC_RELAXED, __HIP_MEMORY_SCOPE_AGENT); }
__device__ __forceinline__ unsigned xb_add(unsigned* p, unsigned v) { return __hip_atomic_fetch_add(p, v, __ATOMIC_RELAXED, __HIP_MEMORY_SCOPE_AGENT); }
__device__ __forceinline__ unsigned xb_xcc_id() { return (unsigned)__builtin_amdgcn_s_getreg((3 << 11) | 20) & 0xFu; }
#define XB_SPIN(cond, bar) do { unsigned _sp = 0; while (cond) { __builtin_amdgcn_s_sleep(1); \
    if ((++_sp & 255u) == 0u) { if (xb_ld(&(bar)[XB_TMO])) break; if (_sp > XB_SPIN_CAP) { atomicAdd(&(bar)[XB_TMO], 1u); break; } } } } while (0)

struct XcdBarrier {
    unsigned* bar; unsigned x;
    volatile LAS unsigned* st;
};
__device__ __forceinline__ XcdBarrier xcd_barrier_post(unsigned* bar, volatile LAS unsigned* st, int tid) {
    XcdBarrier b; b.bar = bar; b.x = xb_xcc_id(); b.st = st;
    if (tid == 0) (void)xb_add(&bar[XB_XCNT(b.x)], 1u);
    return b;
}
__device__ __forceinline__ void xcd_barrier_complete(unsigned* bar, unsigned x, unsigned& nloc, unsigned& nx) {
    const unsigned G = gridDim.x * gridDim.y * gridDim.z;
    unsigned sum, cnt, mine, sp = 0u;
    for (;;) {
        sum = 0u; cnt = 0u; mine = 0u;
#pragma unroll
        for (unsigned j = 0; j < 16; ++j) { const unsigned c = xb_ld(&bar[XB_XCNT(j)]); sum += c; cnt += (c > 0u) ? 1u : 0u; mine = (j == x) ? c : mine; }
        if (sum == G) break;
        __builtin_amdgcn_s_sleep(1);
        if ((++sp & 255u) == 0u) { if (xb_ld(&bar[XB_TMO])) break; if (sp > XB_SPIN_CAP) { atomicAdd(&bar[XB_TMO], 1u); break; } }
    }
    nloc = mine > 0u ? mine : 1u; nx = cnt > 0u ? cnt : 1u;
}
__device__ __forceinline__ void xcd_barrier(const XcdBarrier& b, int tid) {
    asm volatile("s_waitcnt vmcnt(0)" ::: "memory");
    __syncthreads();
    if (tid == 0) {
        unsigned* bar = b.bar;
        __builtin_amdgcn_s_waitcnt(0);
        unsigned nloc = b.st[0], nx = b.st[1];
        if (nloc == 0u) { xcd_barrier_complete(bar, b.x, nloc, nx); b.st[0] = nloc; b.st[1] = nx; }
        const unsigned old = xb_add(&bar[XB_XSUB(b.x)], 1u);
        const unsigned gen = old / nloc;
        if (old + 1u == (gen + 1u) * nloc) {
            __builtin_amdgcn_fence(__ATOMIC_RELEASE, "agent");
            asm volatile("s_waitcnt vmcnt(0)" ::: "memory");
            const unsigned og = xb_add(&bar[XB_TOP], 1u);
            const unsigned tg = og / nx;
            if (og + 1u == (tg + 1u) * nx) xb_add(&bar[XB_TOPGEN], 1u);
            else XB_SPIN(xb_ld(&bar[XB_TOPGEN]) == tg, bar);
            __builtin_amdgcn_fence(__ATOMIC_ACQUIRE, "agent");
            xb_add(&bar[XB_XGEN(b.x)], 1u);
            asm volatile("s_waitcnt vmcnt(0)" ::: "memory");
        } else {
            XB_SPIN(xb_ld(&bar[XB_XGEN(b.x)]) == gen, bar);
            __builtin_amdgcn_fence(__ATOMIC_ACQUIRE, "agent");
            asm volatile("s_waitcnt vmcnt(0)" ::: "memory");
        }
    }
    __syncthreads();
}

struct Params {
    const float *x, *ln_mix_g, *w_in, *conv_w, *sgu_ln_g, *sgu_ln_b, *sgu_w, *sgu_b, *gn_conv, *gn_sgu, *w_out, *ln_ffn_g, *w_router, *b_router,
                *w_gate_up, *b_gate_up, *w_down, *b_down, *ln_final_g;
    float* out;
    unsigned* bar; int* cnt; int* list; int* sel; float* gates; int* done;
    bf16_t *xn, *proj, *proj2, *y, *xn2, *act, *outp; float* h;
    unsigned char *img_in, *img_out;
};
constexpr int LDS_MISC = 256 * EST_BF16;
constexpr int LDS_TOTAL = LDS_MISC + 4096;

__device__ __forceinline__ void phase_rmsnorm(const float* __restrict__ x, const float* __restrict__ g, bf16_t* __restrict__ y, int wid) {
    int lane = lane_id(); asm volatile("" : "+v"(lane));
    for (int t = blockIdx.x * 8 + wid; t < T; t += gridDim.x * 8) {
        const float* xr = x + (size_t)t * D;
        f32x4 v[8]; float s = 0.f;
#pragma unroll
        for (int j = 0; j < 8; ++j) { v[j] = *(const f32x4*)(xr + j * 256 + lane * 4); s += v[j][0] * v[j][0] + v[j][1] * v[j][1] + v[j][2] * v[j][2] + v[j][3] * v[j][3]; }
        s = wave_sum(s);
        const float r = rsqrtf(s * (1.0f / D) + EPS);
#pragma unroll
        for (int j = 0; j < 8; ++j) {
            const f32x4 gg = *(const f32x4*)(g + j * 256 + lane * 4);
            u32x2 o; o.x = cvt_pk_bf16(v[j][0] * r * gg[0], v[j][1] * r * gg[1]); o.y = cvt_pk_bf16(v[j][2] * r * gg[2], v[j][3] * r * gg[3]);
            *(u32x2*)(y + (size_t)t * D + j * 256 + lane * 4) = o;
        }
    }
}

__device__ __forceinline__ float gelu_f(float v) {
    const float av = fabsf(v), dd = av * 0.2316418882f + 1.0f;
    const float tt = __builtin_amdgcn_rcpf(dd);
    float q = tt * 0.5307027145f + (-0.7265760135f); q = q * tt + 0.7107068705f; q = q * tt + (-0.142248368f); q = q * tt + 0.127414796f; q = q * tt;
    const float e = __builtin_amdgcn_exp2f((v * v) * (-0.72134752044f));
    const float m = v * (q * e);
    return v < 0.f ? m : v - m;
}
typedef float f32x16 __attribute__((ext_vector_type(16)));

__device__ __forceinline__ void phase_mixer(const Params& p, LAS3 char* lds, int wid) {
    int lane = lane_id(); asm volatile("" : "+v"(lane));
    const int n = lane & 31, kh = lane >> 5;
    const bf16_t* __restrict__ proj = p.proj;
    LAS3 float* stat = (LAS3 float*)(lds + 32768);
    const int nunits = (T / 128) * 16;
    for (int it = 0; it * (int)gridDim.x < nunits; ++it) {
        const int b = blockIdx.x;
        int u = it * gridDim.x + b;
        if (u >= nunits) break;
        int chunk, g;
        if ((gridDim.x & 15) == 0) { chunk = (b >> 4) + (gridDim.x >> 4) * it; g = ((b & 15) + 8 * (it & 1)) & 15; } else { chunk = u >> 4; g = u & 15; }
        const int t0 = chunk * 128;
        if (g < 8) {
            const int c = g * 128 + 2 * lane;
            const int r0 = t0 + 16 * wid;
            const bf16_t* base = proj + (size_t)r0 * DIN + c;
            const float w00 = p.conv_w[c], w01 = p.conv_w[c + 1], w10 = p.conv_w[DC + c], w11 = p.conv_w[DC + c + 1], w20 = p.conv_w[2 * DC + c], w21 = p.conv_w[2 * DC + c + 1];
            const float g0 = p.gn_conv[c], g1 = p.gn_conv[c + 1];
            const bool has_hist = ((r0 % SEQ) != 0);
            float z2a = 0.f, z2b = 0.f, z1a = 0.f, z1b = 0.f;
            if (has_hist) {
                const unsigned c2 = *(const unsigned*)(base - 2 * (ptrdiff_t)DIN + DC), h2 = *(const unsigned*)(base - 2 * (ptrdiff_t)DIN + 2 * DC);
                const unsigned c1 = *(const unsigned*)(base - (ptrdiff_t)DIN + DC), h1 = *(const unsigned*)(base - (ptrdiff_t)DIN + 2 * DC);
                z2a = bf16_lo(c2) * bf16_lo(h2); z2b = bf16_hi(c2) * bf16_hi(h2); z1a = bf16_lo(c1) * bf16_lo(h1); z1b = bf16_hi(c1) * bf16_hi(h1);
            }
#pragma unroll 1
            for (int hb = 0; hb < 16; hb += 8) {
                unsigned bg[8], cg[8], hg[8];
#pragma unroll
                for (int i = 0; i < 8; ++i) { bg[i] = *(const unsigned*)(base + (size_t)(hb + i) * DIN); cg[i] = *(const unsigned*)(base + (size_t)(hb + i) * DIN + DC); hg[i] = *(const unsigned*)(base + (size_t)(hb + i) * DIN + 2 * DC); }
#pragma unroll
                for (int i = 0; i < 8; ++i) {
                    const float z0a = bf16_lo(cg[i]) * bf16_lo(hg[i]), z0b = bf16_hi(cg[i]) * bf16_hi(hg[i]);
                    const float ya = bf16_lo(bg[i]) * (w00 * z2a + w10 * z1a + w20 * z0a);
                    const float yb = bf16_hi(bg[i]) * (w01 * z2b + w11 * z1b + w21 * z0b);
                    z2a = z1a; z2b = z1b; z1a = z0a; z1b = z0b;
                    const float ss = wave_sum(ya * ya + yb * yb);
                    const float rs = rsqrtf(ss * (1.0f / 128.0f) + EPS);
                    *(unsigned*)(p.y + (size_t)(r0 + hb + i) * D + c) = cvt_pk_bf16(ya * rs * g0, yb * rs * g1);
                }
            }
            __syncthreads(); __syncthreads(); __syncthreads();
        } else {
            const int hd = g - 8;
            {
                const int s0 = 16 * wid + 8 * kh;
                const bf16_t* vb = proj + (size_t)(t0 + s0) * DIN + 4096 + hd * 128 + 4 * n;
                const bf16_t* vb2 = p.proj2 + (size_t)(t0 + s0) * (DIN - 4096) + hd * 128 + 4 * n;
                u32x2 raw[8], raw2[8];
#pragma unroll
                for (int j = 0; j < 8; ++j) { raw[j] = *(const u32x2*)(vb + (size_t)j * DIN); raw2[j] = *(const u32x2*)(vb2 + (size_t)j * (DIN - 4096)); }
                const f32x4 lg = *(const f32x4*)(p.sgu_ln_g + hd * 128 + 4 * n), lb = *(const f32x4*)(p.sgu_ln_b + hd * 128 + 4 * n);
                float vn[8][4];
#pragma unroll
                for (int j = 0; j < 8; ++j) {
                    const float a0 = gelu_f(bf16_lo(raw[j].x) + bf16_lo(raw2[j].x)), a1 = gelu_f(bf16_hi(raw[j].x) + bf16_hi(raw2[j].x)), a2 = gelu_f(bf16_lo(raw[j].y) + bf16_lo(raw2[j].y)), a3 = gelu_f(bf16_hi(raw[j].y) + bf16_hi(raw2[j].y));
                    const float mu = half_sum32((a0 + a1) + (a2 + a3)) * (1.0f / 128.0f);
                    const float d0 = a0 - mu, d1 = a1 - mu, d2 = a2 - mu, d3 = a3 - mu;
                    const float rs = rsqrtf(half_sum32((d0 * d0 + d1 * d1) + (d2 * d2 + d3 * d3)) * (1.0f / 128.0f) + EPS);
                    vn[j][0] = d0 * rs * lg[0] + lb[0]; vn[j][1] = d1 * rs * lg[1] + lb[1]; vn[j][2] = d2 * rs * lg[2] + lb[2]; vn[j][3] = d3 * rs * lg[3] + lb[3];
                }
                __syncthreads();
#pragma unroll
                for (int c = 0; c < 4; ++c) {
                    u32x4 f; f.x = cvt_pk_bf16(vn[0][c], vn[1][c]); f.y = cvt_pk_bf16(vn[2][c], vn[3][c]); f.z = cvt_pk_bf16(vn[4][c], vn[5][c]); f.w = cvt_pk_bf16(vn[6][c], vn[7][c]);
                    *(LAS3 u32x4*)(lds + ((wid * 4 + c) * 64 + lane) * 16) = f;
                }
            }
            __syncthreads();
            {
                const int mt = wid >> 1, cp = (wid & 1) * 2;
                const int trow = 32 * mt + n;
                const float* Wr = p.sgu_w + (size_t)hd * 16384 + (size_t)trow * 128 + 8 * kh;
                f32x16 acc0, acc1;
#pragma unroll
                for (int r = 0; r < 16; ++r) { acc0[r] = 0.f; acc1[r] = 0.f; }
                for (int ks = 0; ks <= 2 * mt + 1; ++ks) {
                    const f32x4 wa = *(const f32x4*)(Wr + 16 * ks), wb = *(const f32x4*)(Wr + 16 * ks + 4);
                    const int sb = 16 * ks + 8 * kh;
                    float wv[8] = {wa[0], wa[1], wa[2], wa[3], wb[0], wb[1], wb[2], wb[3]};
#pragma unroll
                    for (int j = 0; j < 8; ++j) wv[j] = (sb + j <= trow) ? wv[j] : 0.f;
                    u32x4 af; af.x = cvt_pk_bf16(wv[0], wv[1]); af.y = cvt_pk_bf16(wv[2], wv[3]); af.z = cvt_pk_bf16(wv[4], wv[5]); af.w = cvt_pk_bf16(wv[6], wv[7]);
                    const u32x4 b0 = *(LAS3 const u32x4*)(lds + ((ks * 4 + cp) * 64 + lane) * 16);
                    const u32x4 b1 = *(LAS3 const u32x4*)(lds + ((ks * 4 + cp + 1) * 64 + lane) * 16);
                    acc0 = __builtin_amdgcn_mfma_f32_32x32x16_bf16(__builtin_bit_cast(bf16x8, af), __builtin_bit_cast(bf16x8, b0), acc0, 0, 0, 0);
                    acc1 = __builtin_amdgcn_mfma_f32_32x32x16_bf16(__builtin_bit_cast(bf16x8, af), __builtin_bit_cast(bf16x8, b1), acc1, 0, 0, 0);
                }
                const bf16_t* ub = proj + (size_t)t0 * DIN + 3072 + hd * 128 + 4 * n + cp;
                float ya[16], yb[16];
#pragma unroll
                for (int r = 0; r < 16; ++r) {
                    const int tt = 32 * mt + (r & 3) + 8 * (r >> 2) + 4 * kh;
                    const unsigned uu = *(const unsigned*)(ub + (size_t)tt * DIN);
                    const float bias = p.sgu_b[hd * 128 + tt];
                    ya[r] = gelu_f(bf16_lo(uu)) * (acc0[r] + bias);
                    yb[r] = gelu_f(bf16_hi(uu)) * (acc1[r] + bias);
                    const float ps = half_sum32(ya[r] * ya[r] + yb[r] * yb[r]);
                    if (n == 0) stat[tt * 2 + (wid & 1)] = ps;
                }
                __syncthreads();
                const float g0 = p.gn_sgu[hd * 128 + 4 * n + cp], g1 = p.gn_sgu[hd * 128 + 4 * n + cp + 1];
#pragma unroll
                for (int r = 0; r < 16; ++r) {
                    const int tt = 32 * mt + (r & 3) + 8 * (r >> 2) + 4 * kh;
                    const float rs = rsqrtf((stat[tt * 2] + stat[tt * 2 + 1]) * (1.0f / 128.0f) + EPS);
                    *(unsigned*)(p.y + (size_t)(t0 + tt) * D + DC + hd * 128 + 4 * n + cp) = cvt_pk_bf16(ya[r] * rs * g0, yb[r] * rs * g1);
                }
            }
        }
    }
}

__device__ __forceinline__ void phase_router(const Params& p, LAS3 char* lds, int wid) {
    LAS3 float* part = (LAS3 float*)lds;
    LAS3 float* ssqp = (LAS3 float*)(lds + 34816);
    LAS3 float* logit = (LAS3 float*)(lds + 36864);
    LAS3 float* rstd = (LAS3 float*)(lds + 41984);
    LAS3 int* lhist = (LAS3 int*)(lds + 42240);
    LAS3 int* gbase = (LAS3 int*)(lds + 42368);
    int lane = lane_id(); asm volatile("" : "+v"(lane));
    const int n = lane & 31, kh = lane >> 5, tid = wid * 64 + lane;
    for (int grp = blockIdx.x; grp < T / 32; grp += gridDim.x) {
        const int t0 = grp * 32;
        __syncthreads();
        if (tid < 32) lhist[tid] = 0;
        {
            const float* hrow = p.h + (size_t)(t0 + n) * D + wid * 256 + 4 * kh;
            const float* grow = p.ln_ffn_g + wid * 256 + 4 * kh;
            const float* wrow = p.w_router + (size_t)(wid * 256 + 4 * kh) * 32 + n;
            f32x16 acc;
#pragma unroll
            for (int r = 0; r < 16; ++r) acc[r] = 0.f;
            float ssq = 0.f;
#pragma unroll 1
            for (int jj = 0; jj < 32; jj += 8) {
                f32x4 hv[8], gv[8];
#pragma unroll
                for (int j = 0; j < 8; ++j) { hv[j] = *(const f32x4*)(hrow + 8 * (jj + j)); gv[j] = *(const f32x4*)(grow + 8 * (jj + j)); }
#pragma unroll
                for (int j = 0; j < 8; ++j)
#pragma unroll
                    for (int i = 0; i < 4; ++i) {
                        const float a = hv[j][i];
                        ssq += a * a;
                        const float bw = wrow[(size_t)(8 * (jj + j) + i) * 32];
                        acc = __builtin_amdgcn_mfma_f32_32x32x2f32(a * gv[j][i], bw, acc, 0, 0, 0);
                    }
            }
            ssq += xor32(ssq);
            if (kh == 0) ssqp[wid * 32 + n] = ssq;
#pragma unroll
            for (int r = 0; r < 16; ++r) part[(wid * 32 + ((r & 3) + 8 * (r >> 2) + 4 * kh)) * 33 + n] = acc[r];
        }
        __syncthreads();
        if (tid < 32) { float s = 0.f;
#pragma unroll
            for (int w = 0; w < 8; ++w) s += ssqp[w * 32 + tid];
            rstd[tid] = rsqrtf(s * (1.0f / D) + EPS); }
        __syncthreads();
#pragma unroll
        for (int i = 0; i < 2; ++i) {
            const int idx = tid + 512 * i, tk = idx >> 5, e = idx & 31;
            float s = 0.f;
#pragma unroll
            for (int w = 0; w < 8; ++w) s += part[(w * 32 + tk) * 33 + e];
            logit[tk * 33 + e] = s * rstd[tk] + p.b_router[e];
        }
        __syncthreads();
        int se[4] = {0, 0, 0, 0}, sl[4] = {0, 0, 0, 0}; float sx[4] = {0.f, 0.f, 0.f, 0.f}; float sden = 1.f;
        if (tid < 32) {
            float v0 = 0.f; sden = 0.f;
#pragma unroll
            for (int k = 0; k < 4; ++k) {
                int bi = 0; float bv = -3.0e38f;
                for (int i = 0; i < 32; ++i) { const float l = logit[tid * 33 + i]; if (l > bv) { bv = l; bi = i; } }
                logit[tid * 33 + bi] = -3.4e38f;
                if (k == 0) v0 = bv;
                sx[k] = __expf(bv - v0); sden += sx[k];
                se[k] = bi; sl[k] = atomicAdd((int*)&lhist[bi], 1);
            }
        }
        __syncthreads();
        if (tid < 32) { const int c = lhist[tid]; gbase[tid] = c ? atomicAdd(&p.cnt[tid], c) : 0; }
        __syncthreads();
        if (tid < 32) {
            const int t = t0 + tid;
            const float inv = 1.0f / sden;
#pragma unroll
            for (int k = 0; k < 4; ++k) {
                const int slot = gbase[se[k]] + sl[k];
                p.gates[t * 4 + k] = sx[k] * inv;
                p.list[se[k] * T + slot] = t * 4 + k;
                p.sel[t * 4 + k] = (se[k] << 16) | slot;
            }
        }
#pragma unroll 1
        for (int q = 0; q < 4; ++q) {
            const int tk = wid * 4 + q;
            const float r = rstd[tk];
            const float* hr = p.h + (size_t)(t0 + tk) * D;
#pragma unroll
            for (int j = 0; j < 8; ++j) {
                const f32x4 hv = *(const f32x4*)(hr + j * 256 + lane * 4), gg = *(const f32x4*)(p.ln_ffn_g + j * 256 + lane * 4);
                int o = __builtin_amdgcn_cvt_pk_fp8_f32(hv[0] * r * gg[0], hv[1] * r * gg[1], 0, false);
                o = __builtin_amdgcn_cvt_pk_fp8_f32(hv[2] * r * gg[2], hv[3] * r * gg[3], o, true);
                *(int*)((unsigned char*)p.xn2 + (size_t)(t0 + tk) * D + j * 256 + lane * 4) = o;
            }
        }
    }
}

__device__ __forceinline__ void phase_final(const Params& p, LAS3 char* lds, int wid) {
    LAS3 int* base = (LAS3 int*)(lds + LDS_MISC + 2048);
    int lane = lane_id(); asm volatile("" : "+v"(lane));
    if (wid == 0 && lane == 0) { int a = 0; for (int i = 0; i < NE; ++i) { base[i] = a; a += p.cnt[i]; } }
    __syncthreads();
    for (int t = blockIdx.x * 8 + wid; t < T; t += gridDim.x * 8) {
        float gk[4]; const unsigned char* op[4];
#pragma unroll
        for (int k = 0; k < 4; ++k) { const int s = p.sel[t * 4 + k]; gk[k] = p.gates[t * 4 + k]; op[k] = (const unsigned char*)p.outp + (size_t)(base[s >> 16] + (s & 0xffff)) * D; }
        f32x4 v[8]; float ss = 0.f;
#pragma unroll
        for (int j = 0; j < 8; ++j) {
            const int c = j * 256 + lane * 4;
            f32x4 a = *(const f32x4*)(p.h + (size_t)t * D + c);
#pragma unroll
            for (int k = 0; k < 4; ++k) { const int o = *(const int*)(op[k] + c);
                typedef float f32x2 __attribute__((ext_vector_type(2)));
                const f32x2 lo = __builtin_amdgcn_cvt_pk_f32_fp8(o, false), hi = __builtin_amdgcn_cvt_pk_f32_fp8(o, true);
                a[0] += gk[k] * lo.x; a[1] += gk[k] * lo.y; a[2] += gk[k] * hi.x; a[3] += gk[k] * hi.y; }
            v[j] = a; ss += a[0] * a[0] + a[1] * a[1] + a[2] * a[2] + a[3] * a[3];
        }
        ss = wave_sum(ss);
        const float r = rsqrtf(ss * (1.0f / D) + EPS);
#pragma unroll
        for (int j = 0; j < 8; ++j) { const int c = j * 256 + lane * 4; const f32x4 gg = *(const f32x4*)(p.ln_final_g + c);
            f32x4 o; o[0] = v[j][0] * r * gg[0]; o[1] = v[j][1] * r * gg[1]; o[2] = v[j][2] * r * gg[2]; o[3] = v[j][3] * r * gg[3];
            *(f32x4*)(p.out + (size_t)t * D + c) = o; }
    }
}

__global__ void __launch_bounds__(512, 2) k_mega(Params p) {
    extern __shared__ __attribute__((aligned(16))) char smem[];
    LAS3 char* lds = (LAS3 char*)smem;
    volatile LAS unsigned* xbw = (volatile LAS unsigned*)(lds + LDS_MISC);
    int wid = __builtin_amdgcn_readfirstlane((int)(threadIdx.x >> 6)); asm volatile("" : "+s"(wid));
    const int tid0 = wid * 64 + lane_id();
    if (tid0 == 0) { xbw[0] = 0u; xbw[1] = 0u; xbw[2] = 0u; xbw[3] = 0u; }
    __syncthreads();
    XcdBarrier bar = xcd_barrier_post(p.bar, xbw, tid0);
    const int nb = gridDim.x;
    const int vb = ((nb & 7) == 0) ? (int)(blockIdx.x & 7) * (nb >> 3) + (int)(blockIdx.x >> 3) : (int)blockIdx.x;

    if (blockIdx.x == 0 && tid0 < NE) p.cnt[tid0] = 0;
    phase_rmsnorm(p.x, p.ln_mix_g, p.xn, wid);
    for (int it = vb; it < 28 * 4; it += nb) {
        const int tile = it >> 2, kq = it & 3;
        if (tile < 20) convert_tile<false, DIN>(p.w_in + (size_t)kq * 512 * DIN, tile * 256, tile * 256 + 128, 8, p.img_in + (size_t)tile * 1048576 + (size_t)kq * 8 * 32768, lds, wid);
        else convert_tile<false, D>(p.w_out + (size_t)kq * 512 * D, (tile - 20) * 256, (tile - 20) * 256 + 128, 8, p.img_out + (size_t)(tile - 20) * 1048576 + (size_t)kq * 8 * 32768, lds, wid);
    }
    xcd_barrier(bar, wid * 64 + lane_id());
    { GemmArgs g{}; g.A = p.xn; g.C = p.proj; g.R = (const float*)p.proj2;
      for (int u = vb; u < 32 * 16 + 256; u += nb) {
          if (u < 32 * 16) gemm_tile_img<0>(g, u & 31, u >> 5, 0, 0, T, lds, wid, p.img_in + (size_t)(u >> 5) * 1048576);
          else { const int v = u - 32 * 16, pn = 16 + (v >> 6), pm = v & 31, kh = (v >> 5) & 1;
                 gemm_tile_img<0>(g, pm, pn, 0, 0, T, lds, wid, p.img_in + (size_t)pn * 1048576, kh); } } }
    xcd_barrier(bar, wid * 64 + lane_id());
    phase_mixer(p, lds, wid);
    xcd_barrier(bar, wid * 64 + lane_id());
    { GemmArgs g{}; g.A = p.y; g.C = p.h; g.R = p.x;
      for (int u = vb; u < 32 * 8; u += nb) gemm_tile_img<1>(g, u & 31, u >> 5, 0, 0, T, lds, wid, p.img_out + (size_t)(u >> 5) * 1048576); }
    xcd_barrier(bar, wid * 64 + lane_id());
    phase_router(p, lds, wid);
    xcd_barrier(bar, wid * 64 + lane_id());
    { GemmArgs gu{}; gu.A = p.xn2; gu.B = p.w_gate_up; gu.C = p.act; gu.bias = p.b_gate_up; gu.list = p.list; gu.done = p.done;
      GemmArgs gd{}; gd.A = p.act; gd.B = p.w_down; gd.C = p.outp; gd.bias = p.b_down; gd.done = p.done;
      int u = vb, e = 0, ebase = 0, tbase = 0;
      int ecnt = __builtin_amdgcn_readfirstlane(p.cnt[0]), mt = (ecnt + 255) >> 8;
      for (;;) {
          while (e < NE && u >= tbase + mt * 16) { tbase += mt * 16; ebase += ecnt; ++e; if (e < NE) { ecnt = __builtin_amdgcn_readfirstlane(p.cnt[e]); mt = (ecnt + 255) >> 8; } }
          if (e >= NE) break;
          const int ul = u - tbase;
          gemm_tile<2>(gu, ul % mt, ul / mt, e, ebase, ecnt, lds, wid);
          gu.pend = p.done + e;
          u += nb;
      }
      gd.pend = gu.pend;
      u -= tbase; e = 0; ebase = 0; tbase = 0;
      ecnt = __builtin_amdgcn_readfirstlane(p.cnt[0]); mt = (ecnt + 255) >> 8;
      for (;;) {
          while (e < NE && u >= tbase + mt * 8) { tbase += mt * 8; ebase += ecnt; ++e; if (e < NE) { ecnt = __builtin_amdgcn_readfirstlane(p.cnt[e]); mt = (ecnt + 255) >> 8; } }
          if (e >= NE) break;
          const int ul = u - tbase;
          gemm_tile<3>(gd, ul % mt, ul / mt, e, ebase, ecnt, lds, wid);
          gd.pend = nullptr;
          u += nb;
      }
      if (gd.pend) {
          asm volatile("s_waitcnt vmcnt(0)" ::: "memory"); __syncthreads();
          const int t0 = wid * 64 + lane_id(); if (t0 == 0) __hip_atomic_fetch_add(gd.pend, 1, __ATOMIC_RELAXED, __HIP_MEMORY_SCOPE_AGENT);
      } }
    xcd_barrier(bar, wid * 64 + lane_id());
    phase_final(p, lds, wid);
}
}

extern "C" void kernel_launch(void* const* d_in, const int* in_sizes, int n_in, void* d_out, int out_size, void* d_ws, size_t ws_size,
                              hipStream_t stream) {
    Params p{};
    p.x = (const float*)d_in[0]; p.ln_mix_g = (const float*)d_in[1]; p.w_in = (const float*)d_in[2]; p.conv_w = (const float*)d_in[3];
    p.sgu_ln_g = (const float*)d_in[4]; p.sgu_ln_b = (const float*)d_in[5]; p.sgu_w = (const float*)d_in[6]; p.sgu_b = (const float*)d_in[7];
    p.gn_conv = (const float*)d_in[8]; p.gn_sgu = (const float*)d_in[9]; p.w_out = (const float*)d_in[10]; p.ln_ffn_g = (const float*)d_in[11];
    p.w_router = (const float*)d_in[12]; p.b_router = (const float*)d_in[13]; p.w_gate_up = (const float*)d_in[14]; p.b_gate_up = (const float*)d_in[15];
    p.w_down = (const float*)d_in[16]; p.b_down = (const float*)d_in[17]; p.ln_final_g = (const float*)d_in[18];
    p.out = (float*)d_out;

    char* ws = (char*)d_ws;
    size_t off = 0;
    auto take = [&](size_t bytes) { char* q = ws + off; off += (bytes + 255) & ~(size_t)255; return q; };
    p.bar = (unsigned*)take(XCD_BAR_WORDS * 4 + 256);
    p.done = (int*)(p.bar + XCD_BAR_WORDS);
    p.cnt = (int*)take(256);
    p.list = (int*)take((size_t)NE * T * 4);
    p.sel = (int*)take((size_t)NPAIR * 4);
    p.gates = (float*)take((size_t)NPAIR * 4);
    p.xn = (bf16_t*)take((size_t)T * D * 2);
    p.proj = (bf16_t*)take((size_t)T * DIN * 2);
    p.proj2 = (bf16_t*)take((size_t)T * (DIN - 4096) * 2);
    p.y = (bf16_t*)take((size_t)T * D * 2);
    p.h = (float*)take((size_t)T * D * 4);
    p.xn2 = (bf16_t*)take((size_t)T * D * 2);
    p.act = (bf16_t*)take((size_t)ACT_ROWS * DFF * 2);
    p.outp = (bf16_t*)take((size_t)ACT_ROWS * D * 2);
    p.img_in = (unsigned char*)take((size_t)20 * 1048576);
    p.img_out = (unsigned char*)take((size_t)8 * 1048576);
    if (off > ws_size) { fprintf(stderr, "workspace too small: need %zu have %zu\n", off, ws_size); return; }

    static int grid = 0;
    if (!grid) {
        int dev = 0, cus = 0, per_cu = 0;
        (void)hipGetDevice(&dev);
        (void)hipDeviceGetAttribute(&cus, hipDeviceAttributeMultiprocessorCount, dev);
        (void)hipFuncSetAttribute((const void*)k_mega, hipFuncAttributeMaxDynamicSharedMemorySize, LDS_TOTAL);
        (void)hipOccupancyMaxActiveBlocksPerMultiprocessor(&per_cu, (const void*)k_mega, 512, LDS_TOTAL);
        if (per_cu < 1) { fprintf(stderr, "occupancy query says 0 blocks per CU\n"); per_cu = 1; }
        grid = cus * 1;
    }
    (void)hipMemsetAsync(p.bar, 0, XCD_BAR_WORDS * 4 + 256, stream);
    k_mega<<<grid, 512, LDS_TOTAL, stream>>>(p);
}
```

```cpp
#include <hip/hip_runtime.h>
#include <stdint.h>
#include <stdio.h>

namespace {
constexpr int T = 8192, D = 2048, DIN = 5120, DC = 1024, NE = 32, DFF = 2048, SEQ = 4096;
constexpr int NPAIR = T * 4, ACT_ROWS = NPAIR + 256;
constexpr float EPS = 1e-5f;

#define LAS3 __attribute__((address_space(3)))
typedef short bf16x8 __attribute__((ext_vector_type(8)));
typedef float f32x4 __attribute__((ext_vector_type(4)));
typedef unsigned u32x4 __attribute__((ext_vector_type(4)));
typedef unsigned u32x2 __attribute__((ext_vector_type(2)));
typedef unsigned short bf16_t;

constexpr int GBK = 64, GHTB = 128 * 64 * 2;
constexpr int GEMM_LDS = 8 * GHTB;

__device__ __forceinline__ unsigned cvt_pk_bf16(float lo, float hi) {
    unsigned r; asm("v_cvt_pk_bf16_f32 %0, %1, %2" : "=v"(r) : "v"(lo), "v"(hi)); return r;
}
__device__ __forceinline__ float bf16_lo(unsigned u) { return __uint_as_float(u << 16); }
__device__ __forceinline__ float bf16_hi(unsigned u) { return __uint_as_float(u & 0xffff0000u); }

__device__ __forceinline__ void dma16(const void* sbase, unsigned voff, unsigned lds_dst) {
    unsigned keep;
    asm volatile("s_mov_b32 %0, m0\n\ts_mov_b32 m0, %3\n\ts_nop 2\n\tglobal_load_lds_dwordx4 %1, %2\n\ts_mov_b32 m0, %0"
                 : "=&s"(keep) : "v"(voff), "s"(sbase), "s"(lds_dst) : "memory");
}
#define G_WAIT_V(n) asm volatile("s_waitcnt vmcnt(" #n ")" ::: "memory")
#define G_WAIT_L(n) asm volatile("s_waitcnt lgkmcnt(" #n ")" ::: "memory")
#define G_BAR do { asm volatile("" ::: "memory"); __builtin_amdgcn_s_barrier(); asm volatile("" ::: "memory"); } while (0)
#define G_SCHED __builtin_amdgcn_sched_barrier(0)

template <int LDB, int VAR = 0>
__device__ __forceinline__ void gemm_kloop(f32x4 (&acc)[2][2][4][2], const bf16_t* __restrict__ A, const unsigned (&aoff)[2][2],
                                           const float* __restrict__ B, unsigned boff, int nt, LAS3 char* lds, int tid, int wid, size_t astep = GBK, size_t bstep = (size_t)GBK * LDB) {
    const int lane = tid & 63, wr = wid >> 2, wc = wid & 3, fr = lane & 15, fq = lane >> 4;
    const int c0 = fq ^ (fr >> 1);
    const int a_rd0 = (wr * 64 + fr) * 128 + c0 * 16, a_rd1 = (wr * 64 + fr) * 128 + (c0 ^ 4) * 16;
    const int b_rd0 = (wc * 16 + fr) * 128 + ((c0 ^ (wc & 1)) * 16), b_rd1 = (wc * 16 + fr) * 128 + ((c0 ^ (wc & 1) ^ 4) * 16);
    const int k8 = wid, n4 = tid & 63, bhalf = n4 >> 5, nloc = (n4 & 31) * 4;
    const int sw0 = (((n4 & 3) * 2) & 7) ^ ((n4 >> 2) & 1), sw1 = (((n4 & 3) * 2 + 1) & 7) ^ ((n4 >> 2) & 1);
    const int b_wr0 = (4 + bhalf) * GHTB + nloc * 128 + ((k8 ^ sw0) << 4);
    const int b_wr1 = (4 + bhalf) * GHTB + (nloc + 2) * 128 + ((k8 ^ sw1) << 4);
    const unsigned boffb = boff * 4u;
    const unsigned lds_u = (unsigned)(unsigned long)lds;
    const unsigned bw_a0 = lds_u + (unsigned)b_wr0, bw_a1 = lds_u + (unsigned)b_wr1;
    const int a_dma0 = wid * 1024, a_dma1 = (8 + wid) * 1024;

#define SA_(b, h) (((b) * 2 + (h)) * GHTB)
#define SB_(b, h) ((4 + (b) * 2 + (h)) * GHTB)
#define STAGE_A(b, h, kt) do { const bf16_t* _g = A + (size_t)(kt) * astep; \
        dma16((const void*)_g, aoff[h][0], lds_u + SA_(b, h) + a_dma0); \
        dma16((const void*)_g, aoff[h][1], lds_u + SA_(b, h) + a_dma1); } while (0)
#define BLOAD2(R, kt, j0) asm volatile("s_nop 4\n\tglobal_load_dwordx4 %0, %2, %3\n\tglobal_load_dwordx4 %1, %2, %4" \
        : "=&v"(R[(j0) & 3]), "=&v"(R[((j0) & 3) + 1]) : "v"(boffb), "s"(B + (size_t)(kt) * bstep + (size_t)(j0) * LDB), "s"(B + (size_t)(kt) * bstep + (size_t)((j0) + 1) * LDB) : "memory")
#define BWAIT(R, n) asm volatile("s_waitcnt vmcnt(" #n ")" : "+v"(R[0]), "+v"(R[1]), "+v"(R[2]), "+v"(R[3]) :: "memory")
#define BWRITE_H(R, b, hi) do { _Pragma("unroll") for (int _i = 0; _i < 4; ++_i) { u32x2 _w; \
            _w.x = cvt_pk_bf16(R[0][_i], R[1][_i]); _w.y = cvt_pk_bf16(R[2][_i], R[3][_i]); \
            asm volatile("ds_write_b64 %0, %1 offset:%2" :: "v"((_i < 2) ? bw_a0 : bw_a1), "v"(_w), "n"((b) * 2 * GHTB + (_i & 1) * 128 + (hi) * 8) : "memory"); } } while (0)
#define LDA(dst, b, h) do { _Pragma("unroll") for (int _m = 0; _m < 4; ++_m) { \
        dst[_m][0] = *(LAS3 const bf16x8*)(lds + SA_(b, h) + a_rd0 + _m * 2048); \
        dst[_m][1] = *(LAS3 const bf16x8*)(lds + SA_(b, h) + a_rd1 + _m * 2048); } } while (0)
#define LDB_(dst, b, h) do { _Pragma("unroll") for (int _n = 0; _n < 2; ++_n) { \
        dst[_n][0] = *(LAS3 const bf16x8*)(lds + SB_(b, h) + b_rd0 + _n * 8192); \
        dst[_n][1] = *(LAS3 const bf16x8*)(lds + SB_(b, h) + b_rd1 + _n * 8192); } } while (0)
#define MMA(ai, bj, Af, Bf) do { __builtin_amdgcn_s_setprio(1); \
        _Pragma("unroll") for (int _m = 0; _m < 4; ++_m) _Pragma("unroll") for (int _n = 0; _n < 2; ++_n) _Pragma("unroll") for (int _k = 0; _k < 2; ++_k) \
            acc[ai][bj][_m][_n] = __builtin_amdgcn_mfma_f32_16x16x32_bf16(Bf[_n][_k], Af[_m][_k], acc[ai][bj][_m][_n], 0, 0, 0); \
        __builtin_amdgcn_s_setprio(0); } while (0)

    f32x4 blo[4], bhi[4];
    bf16x8 At[4][2], B0[2][2], B1[2][2];
#pragma unroll
    for (int ai = 0; ai < 2; ++ai)
#pragma unroll
        for (int bj = 0; bj < 2; ++bj)
#pragma unroll
            for (int m = 0; m < 4; ++m)
#pragma unroll
                for (int n = 0; n < 2; ++n) acc[ai][bj][m][n] = (f32x4){0.f, 0.f, 0.f, 0.f};

    __builtin_amdgcn_s_waitcnt(0);
    const int p1 = (1 < nt) ? 1 : 0;
    BLOAD2(blo, 0, 0); BLOAD2(blo, 0, 2); BLOAD2(bhi, 0, 4); BLOAD2(bhi, 0, 6); STAGE_A(0, 0, 0); STAGE_A(0, 1, 0);
    BWAIT(blo, 4); BWAIT(bhi, 4); BWRITE_H(blo, 0, 0); BWRITE_H(bhi, 0, 1);
    BLOAD2(blo, p1, 0); BLOAD2(blo, p1, 2); STAGE_A(1, 0, p1); BLOAD2(bhi, p1, 4);
    G_WAIT_V(2);
    G_WAIT_L(0);
    if (wr == 1) G_BAR;
    G_BAR;
    for (int t = 0; t < nt; t += 2) {
        const int t1 = (t + 1 < nt) ? t + 1 : nt - 1, t2 = (t + 2 < nt) ? t + 2 : nt - 1, t3 = (t + 3 < nt) ? t + 3 : nt - 1;
        LDB_(B0, 0, 0); G_SCHED; LDA(At, 0, 0); BLOAD2(bhi, t1, 6); STAGE_A(1, 1, t1);
        G_WAIT_L(8); G_BAR; G_WAIT_L(0); MMA(0, 0, At, B0); G_BAR; G_SCHED;
        LDB_(B1, 0, 1); BWAIT(blo, 8); BWRITE_H(blo, 1, 0); BLOAD2(blo, t2, 0);
        G_BAR; G_WAIT_L(0); MMA(0, 1, At, B1); G_BAR;
        LDA(At, 0, 1); BLOAD2(blo, t2, 2); STAGE_A(0, 0, t2);
        G_BAR; G_WAIT_L(0); MMA(1, 0, At, B0); G_BAR; G_SCHED;
        BWAIT(bhi, 8); BWRITE_H(bhi, 1, 1); BLOAD2(bhi, t2, 4);
        G_WAIT_V(8); G_WAIT_L(0); G_BAR; MMA(1, 1, At, B1); G_BAR;
        LDB_(B0, 1, 0); G_SCHED; LDA(At, 1, 0); BLOAD2(bhi, t2, 6); STAGE_A(0, 1, t2);
        G_WAIT_L(8); G_BAR; G_WAIT_L(0); MMA(0, 0, At, B0); G_BAR; G_SCHED;
        LDB_(B1, 1, 1); BWAIT(blo, 8); BWRITE_H(blo, 0, 0); BLOAD2(blo, t3, 0);
        G_BAR; G_WAIT_L(0); MMA(0, 1, At, B1); G_BAR;
        LDA(At, 1, 1); BLOAD2(blo, t3, 2); STAGE_A(1, 0, t3);
        G_BAR; G_WAIT_L(0); MMA(1, 0, At, B0); G_BAR; G_SCHED;
        BWAIT(bhi, 8); BWRITE_H(bhi, 0, 1); BLOAD2(bhi, t3, 4);
        G_WAIT_V(8); G_WAIT_L(0); G_BAR; MMA(1, 1, At, B1); G_BAR;
    }
    G_WAIT_V(0); G_WAIT_L(0);
    if (wr == 0) G_BAR;
    G_BAR;
#undef SA_
#undef SB_
#undef STAGE_A
#undef BLOAD2
#undef BWRITE_H
#undef BWAIT
#undef LDA
#undef LDB_
#undef MMA
}

typedef int v8i32 __attribute__((ext_vector_type(8)));
typedef short v2s16 __attribute__((ext_vector_type(2)));
typedef int i32x4 __attribute__((ext_vector_type(4)));
#ifndef F8_WSCALE
#define F8_WSCALE 0.00390625f
#endif
template <int LDB>
__device__ __forceinline__ void gemm_kloop_f8(f32x4 (&acc)[2][2][4][2], const unsigned char* __restrict__ A, const unsigned (&aoff)[2][2],
                                              const float* __restrict__ B, unsigned boff, int nt, LAS3 char* lds, int tid, int wid, int pam = 1, int pbm = 1) {
    const int lane = tid & 63, wr = wid >> 2, wc = wid & 3, fr = lane & 15, fq = lane >> 4;
    const int c0 = fq ^ (fr >> 1);
    const int a_rd0 = (wr * 64 + fr) * 128 + c0 * 16, a_rd1 = (wr * 64 + fr) * 128 + (c0 ^ 4) * 16;
    const int b_rd0 = (wc * 16 + fr) * 128 + ((c0 ^ (wc & 1)) * 16), b_rd1 = (wc * 16 + fr) * 128 + ((c0 ^ (wc & 1) ^ 4) * 16);
    const int k8 = wid, n4 = tid & 63, bhalf = n4 >> 5, nloc = (n4 & 31) * 4;
    const int sw0 = (((n4 & 3) * 2) & 7) ^ ((n4 >> 2) & 1), sw1 = (((n4 & 3) * 2 + 1) & 7) ^ ((n4 >> 2) & 1);
    const int b_wr0 = (4 + bhalf) * GHTB + nloc * 128 + ((k8 ^ sw0) << 4);
    const int b_wr1 = (4 + bhalf) * GHTB + (nloc + 2) * 128 + ((k8 ^ sw1) << 4);
    const unsigned boffb = boff * 4u;
    const unsigned lds_u = (unsigned)(unsigned long)lds;
    const unsigned bw_a0 = lds_u + (unsigned)b_wr0, bw_a1 = lds_u + (unsigned)b_wr1;
    const int a_dma0 = wid * 1024, a_dma1 = (8 + wid) * 1024;
    const size_t bstep = (size_t)128 * LDB * pbm, astepb = (size_t)128 * pam;

#define SA_(b, h) (((b) * 2 + (h)) * GHTB)
#define SB_(b, h) ((4 + (b) * 2 + (h)) * GHTB)
#define STAGE_A(b, h, kt) do { const unsigned char* _g = A + (size_t)(kt) * astepb; \
        dma16((const void*)_g, aoff[h][0], lds_u + SA_(b, h) + a_dma0); \
        dma16((const void*)_g, aoff[h][1], lds_u + SA_(b, h) + a_dma1); } while (0)
#define QLOAD(R, kt, q) do { \
        asm volatile("s_nop 4\n\tglobal_load_dwordx4 %0, %2, %3\n\tglobal_load_dwordx4 %1, %2, %4" : "=&v"(R[0]), "=&v"(R[1]) \
            : "v"(boffb), "s"(B + (size_t)(kt) * bstep + (size_t)(4 * (q)) * LDB), "s"(B + (size_t)(kt) * bstep + (size_t)(4 * (q) + 1) * LDB) : "memory"); \
        asm volatile("s_nop 4\n\tglobal_load_dwordx4 %0, %2, %3\n\tglobal_load_dwordx4 %1, %2, %4" : "=&v"(R[2]), "=&v"(R[3]) \
            : "v"(boffb), "s"(B + (size_t)(kt) * bstep + (size_t)(4 * (q) + 2) * LDB), "s"(B + (size_t)(kt) * bstep + (size_t)(4 * (q) + 3) * LDB) : "memory"); } while (0)
#define QWAIT4(R, n) QWAIT(R, n)
#define QWAIT(R, n) asm volatile("s_waitcnt vmcnt(" #n ")" : "+v"(R[0]), "+v"(R[1]), "+v"(R[2]), "+v"(R[3]) :: "memory")
#define QCVTW(R, b, q) do { _Pragma("unroll") for (int _i = 0; _i < 4; ++_i) { \
            cvd = __builtin_amdgcn_cvt_scalef32_pk_fp8_f32(cvd, R[0][_i], R[1][_i], F8_WSCALE, false); \
            cvd = __builtin_amdgcn_cvt_scalef32_pk_fp8_f32(cvd, R[2][_i], R[3][_i], F8_WSCALE, true); \
            asm volatile("ds_write_b32 %0, %1 offset:%2" :: "v"((_i < 2) ? bw_a0 : bw_a1), "v"(cvd), "n"((b) * 2 * GHTB + (_i & 1) * 128 + (q) * 4) : "memory"); } } while (0)
#define LDA1(dst, b, h, m) do { \
        dst.lo = *(LAS3 const i32x4*)(lds + SA_(b, h) + a_rd0 + (m) * 2048); \
        dst.hi = *(LAS3 const i32x4*)(lds + SA_(b, h) + a_rd1 + (m) * 2048); } while (0)
#define LDB4(dst, b) do { _Pragma("unroll") for (int _h = 0; _h < 2; ++_h) _Pragma("unroll") for (int _n = 0; _n < 2; ++_n) { \
        dst[_h * 2 + _n].lo = *(LAS3 const i32x4*)(lds + SB_(b, _h) + b_rd0 + _n * 8192); \
        dst[_h * 2 + _n].hi = *(LAS3 const i32x4*)(lds + SB_(b, _h) + b_rd1 + _n * 8192); } } while (0)
#define MF4(ai, m, slot) do { _Pragma("unroll") for (int _j = 0; _j < 4; ++_j) \
            acc[ai][_j >> 1][m][_j & 1] = __builtin_amdgcn_mfma_scale_f32_16x16x128_f8f6f4(Bx[_j], slot, acc[ai][_j >> 1][m][_j & 1], 0, 0, 0, 0x7f7f7f77, 1, 0x7f7f7f77); } while (0)
#define MMA16(ai, b, h) do { __builtin_amdgcn_s_setprio(1); MF4(ai, 0, A0); G_SCHED; LDA1(A0, b, h, 2); G_SCHED; MF4(ai, 1, A1); G_SCHED; LDA1(A1, b, h, 3); G_SCHED; \
        G_WAIT_L(2); MF4(ai, 2, A0); G_SCHED; G_WAIT_L(0); MF4(ai, 3, A1); __builtin_amdgcn_s_setprio(0); } while (0)

    f32x4 s0[4], s1[4];
    v2s16 cvd; asm("" : "=v"(cvd));
    v8i32 A0, A1, Bx[4];
#pragma unroll
    for (int ai = 0; ai < 2; ++ai)
#pragma unroll
        for (int bj = 0; bj < 2; ++bj)
#pragma unroll
            for (int m = 0; m < 4; ++m)
#pragma unroll
                for (int n = 0; n < 2; ++n) acc[ai][bj][m][n] = (f32x4){0.f, 0.f, 0.f, 0.f};

    const int p1 = (1 < nt) ? 1 : 0;
    QLOAD(acc[0][0][0], 0, 0); QLOAD(acc[0][0][2], 0, 1); QLOAD(acc[0][1][0], 0, 2); QLOAD(acc[0][1][2], 0, 3);
    STAGE_A(0, 0, 0); STAGE_A(0, 1, 0);
    QLOAD(s0, p1, 0); QLOAD(s1, p1, 1);
    __builtin_amdgcn_s_waitcnt(0);
    QWAIT4(acc[0][0][0], 0); QWAIT4(acc[0][0][2], 0); QWAIT4(acc[0][1][0], 0); QWAIT4(acc[0][1][2], 0); QWAIT(s0, 0); QWAIT(s1, 0);
    QCVTW(acc[0][0][0], 0, 0); QCVTW(acc[0][0][2], 0, 1); QCVTW(acc[0][1][0], 0, 2); QCVTW(acc[0][1][2], 0, 3);
#pragma unroll
    for (int bj = 0; bj < 2; ++bj)
#pragma unroll
        for (int m = 0; m < 4; ++m)
#pragma unroll
            for (int n = 0; n < 2; ++n) acc[0][bj][m][n] = (f32x4){0.f, 0.f, 0.f, 0.f};
    G_WAIT_L(0);
    if (wr == 1) G_BAR;
    G_BAR;
#define KTILE(b, tn1, tn2) do { \
          \
        LDB4(Bx, b); G_SCHED; LDA1(A0, b, 0, 0); LDA1(A1, b, 0, 1); \
        QWAIT(s0, 6); QCVTW(s0, (b) ^ 1, 0); QLOAD(s0, tn1, 2); QWAIT(s1, 6); QCVTW(s1, (b) ^ 1, 1); QLOAD(s1, tn1, 3); STAGE_A((b) ^ 1, 0, tn1); \
        G_WAIT_V(10); G_BAR; G_WAIT_L(0); MMA16(0, b, 0); G_BAR; G_SCHED; \
          \
        LDA1(A0, b, 1, 0); LDA1(A1, b, 1, 1); \
        QWAIT(s0, 6); QCVTW(s0, (b) ^ 1, 2); QLOAD(s0, tn2, 0); QWAIT(s1, 6); QCVTW(s1, (b) ^ 1, 3); QLOAD(s1, tn2, 1); STAGE_A((b) ^ 1, 1, tn1); \
        G_WAIT_V(10); G_WAIT_L(0); G_BAR; MMA16(1, b, 1); G_BAR; G_SCHED; } while (0)
    for (int t = 0; t < nt; t += 2) {
        const int t1 = (t + 1 < nt) ? t + 1 : nt - 1, t2 = (t + 2 < nt) ? t + 2 : nt - 1, t3 = (t + 3 < nt) ? t + 3 : nt - 1;
        KTILE(0, t1, t2);
        KTILE(1, t2, t3);
    }
    G_WAIT_V(0); G_WAIT_L(0);
    if (wr == 0) G_BAR;
    G_BAR;
#undef KTILE
#undef SA_
#undef SB_
#undef STAGE_A
#undef QLOAD
#undef QWAIT
#undef QCVTW
#undef LDA1
#undef MF4
#undef MMA16
#undef LDB4
#undef QWAIT4
}


__device__ __forceinline__ int lane_id() { int r; asm volatile("v_mbcnt_lo_u32_b32 %0, -1, 0\n\tv_mbcnt_hi_u32_b32 %0, -1, %0" : "=v"(r)); return r; }
#define SWZ_XOR(v, o) __int_as_float(__builtin_amdgcn_ds_swizzle(__float_as_int(v), ((o) << 10) | 0x1F))
__device__ __forceinline__ float half_sum32(float v) {
    v += SWZ_XOR(v, 16); v += SWZ_XOR(v, 8); v += SWZ_XOR(v, 4); v += SWZ_XOR(v, 2); v += SWZ_XOR(v, 1);
    return v;
}
__device__ __forceinline__ float xor32(float v) { const int l = lane_id(); return __int_as_float(__builtin_amdgcn_ds_bpermute((l ^ 32) << 2, __float_as_int(v))); }
__device__ __forceinline__ float wave_sum(float v) { v = half_sum32(v); return v + xor32(v); }
typedef int v8i32d __attribute__((ext_vector_type(8)));
typedef int i32x4d __attribute__((ext_vector_type(4)));
template <bool F8, bool BSW = false, int ROWB = 0, bool ACCUM = false>
__device__ __forceinline__ void gemm_kloop_dma(f32x4 (&acc)[2][2][4][2], const unsigned char* __restrict__ A, const unsigned (&aoff)[2][2],
                                               const unsigned char* __restrict__ img, int nt, LAS3 char* lds, int tid, int wid, int kbase = 0) {
    constexpr int KMASK = F8 ? 15 : 31;
#define KT_(kt) ((kbase + (kt)) & KMASK)
    const int lane = tid & 63, wr = wid >> 2, wc = wid & 3, fr = lane & 15, fq = lane >> 4;
    const int c0 = fq ^ (fr >> 1);
    const int a_rd0 = (wr * 64 + fr) * 128 + c0 * 16, a_rd1 = (wr * 64 + fr) * 128 + (c0 ^ 4) * 16;
    const int cb = BSW ? (c0 ^ (wc & 1)) : c0;
    const int b_rd0 = (wc * 16 + fr) * 128 + cb * 16, b_rd1 = (wc * 16 + fr) * 128 + (cb ^ 4) * 16;
    const unsigned lds_u = (unsigned)(unsigned long)lds;
    LAS3 const char* ap0 = lds + a_rd0; LAS3 const char* ap1 = lds + a_rd1; LAS3 const char* bp0 = lds + 4 * GHTB + b_rd0; LAS3 const char* bp1 = lds + 4 * GHTB + b_rd1;
    asm volatile("" : "+v"(ap0), "+v"(ap1), "+v"(bp0), "+v"(bp1));
    const int dma0 = wid * 1024, dma1 = (8 + wid) * 1024;
    const unsigned boffl = (unsigned)lane * 16u;

#define SA_(b, h) (((b) * 2 + (h)) * GHTB)
#define SB_(b, h) ((4 + (b) * 2 + (h)) * GHTB)
#define STG_A(b, h, kt) do { const unsigned char* _g = A + (size_t)KT_(kt) * 128; \
        dma16((const void*)(_g + (size_t)((h) * 128) * ROWB), ROWB ? aoff[0][0] : aoff[h][0], lds_u + SA_(b, h) + dma0); \
        dma16((const void*)(_g + (size_t)((h) * 128 + 64) * ROWB), ROWB ? aoff[0][0] : aoff[h][1], lds_u + SA_(b, h) + dma1); } while (0)
#define STG_B(b, h, kt) do { const unsigned char* _g = img + (size_t)KT_(kt) * 32768 + (h) * 16384; \
        dma16((const void*)(_g + dma0), boffl, lds_u + SB_(b, h) + dma0); \
        dma16((const void*)(_g + dma1), boffl, lds_u + SB_(b, h) + dma1); } while (0)
#define LDA_(dst, b, h) do { _Pragma("unroll") for (int _m = 0; _m < 4; ++_m) { \
        dst[_m].lo = *(LAS3 const i32x4d*)(ap0 + SA_(b, h) + _m * 2048); \
        dst[_m].hi = *(LAS3 const i32x4d*)(ap1 + SA_(b, h) + _m * 2048); } } while (0)
#define LDBF(dst, b, h) do { _Pragma("unroll") for (int _n = 0; _n < 2; ++_n) { \
        dst[_n].lo = *(LAS3 const i32x4d*)(bp0 + (SB_(b, h) - 4 * GHTB) + _n * 8192); \
        dst[_n].hi = *(LAS3 const i32x4d*)(bp1 + (SB_(b, h) - 4 * GHTB) + _n * 8192); } } while (0)
#define MMAD(ai, bj, Af, Bf) do { __builtin_amdgcn_s_setprio(1); \
        _Pragma("unroll") for (int _m = 0; _m < 4; ++_m) _Pragma("unroll") for (int _n = 0; _n < 2; ++_n) { \
            if (F8) acc[ai][bj][_m][_n] = __builtin_amdgcn_mfma_scale_f32_16x16x128_f8f6f4(Bf[_n], Af[_m], acc[ai][bj][_m][_n], 0, 0, 0, 0x7f7f7f77, 1, 0x7f7f7f77); \
            else { const i32x4d _bl = Bf[_n].lo, _bh = Bf[_n].hi, _al = Af[_m].lo, _ah = Af[_m].hi;     \
                   acc[ai][bj][_m][_n] = __builtin_amdgcn_mfma_f32_16x16x32_bf16(__builtin_bit_cast(bf16x8, _bl), __builtin_bit_cast(bf16x8, _al), acc[ai][bj][_m][_n], 0, 0, 0); \
                   acc[ai][bj][_m][_n] = __builtin_amdgcn_mfma_f32_16x16x32_bf16(__builtin_bit_cast(bf16x8, _bh), __builtin_bit_cast(bf16x8, _ah), acc[ai][bj][_m][_n], 0, 0, 0); } } \
        __builtin_amdgcn_s_setprio(0); } while (0)

    v8i32d At[4], B0[2], B1[2];
    if (!ACCUM)
#pragma unroll
    for (int ai = 0; ai < 2; ++ai)
#pragma unroll
        for (int bj = 0; bj < 2; ++bj)
#pragma unroll
            for (int m = 0; m < 4; ++m)
#pragma unroll
                for (int n = 0; n < 2; ++n) acc[ai][bj][m][n] = (f32x4){0.f, 0.f, 0.f, 0.f};
    STG_B(0, 0, 0); STG_A(0, 0, 0); STG_B(0, 1, 0); STG_A(0, 1, 0);
    __builtin_amdgcn_s_waitcnt(0);
    { int wr1 = wid >> 2; asm volatile("" : "+s"(wr1)); if (wr1 == 1) G_BAR; }
    G_BAR;
    { const int p1 = (1 < nt) ? 1 : 0; STG_B(1, 0, p1); STG_A(1, 0, p1); STG_B(1, 1, p1); }
    G_WAIT_V(6); G_BAR;
    for (int t = 0; t < nt; t += 2) {
        const int t1 = (t + 1 < nt) ? t + 1 : nt - 1, t2 = (t + 2 < nt) ? t + 2 : nt - 1, t3 = (t + 3 < nt) ? t + 3 : nt - 1;
        LDBF(B0, 0, 0); G_SCHED; LDA_(At, 0, 0); STG_A(1, 1, t1);
        G_WAIT_L(8); G_BAR; G_WAIT_L(0); MMAD(0, 0, At, B0); G_BAR; G_SCHED;
        LDBF(B1, 0, 1); STG_B(0, 0, t2);
        G_BAR; G_WAIT_L(0); MMAD(0, 1, At, B1); G_BAR;
        LDA_(At, 0, 1); STG_A(0, 0, t2);
        G_BAR; G_WAIT_L(0); MMAD(1, 0, At, B0); G_BAR; G_SCHED;
        STG_B(0, 1, t2);
        G_WAIT_V(6); G_BAR; MMAD(1, 1, At, B1); G_BAR;
        LDBF(B0, 1, 0); G_SCHED; LDA_(At, 1, 0); STG_A(0, 1, t2);
        G_WAIT_L(8); G_BAR; G_WAIT_L(0); MMAD(0, 0, At, B0); G_BAR; G_SCHED;
        LDBF(B1, 1, 1); STG_B(1, 0, t3);
        G_BAR; G_WAIT_L(0); MMAD(0, 1, At, B1); G_BAR;
        LDA_(At, 1, 1); STG_A(1, 0, t3);
        G_BAR; G_WAIT_L(0); MMAD(1, 0, At, B0); G_BAR; G_SCHED;
        STG_B(1, 1, t3);
        G_WAIT_V(6); G_BAR; MMAD(1, 1, At, B1); G_BAR;
    }
    G_WAIT_V(0); G_WAIT_L(0);
    { int wr0 = wid >> 2; asm volatile("" : "+s"(wr0)); if (wr0 == 0) G_BAR; }
    G_BAR;
#undef SA_
#undef SB_
#undef STG_A
#undef STG_B
#undef LDA_
#undef LDBF
#undef MMAD
#undef KT_
}

template <bool F8, int LDB>
__device__ __forceinline__ void convert_tile(const float* __restrict__ W, int col0, int col1, int nkt, unsigned char* __restrict__ img, LAS3 char* lds, int wid) {
    constexpr int RPT = F8 ? 16 : 8;
    int lane = lane_id(); asm volatile("" : "+v"(lane));
    const int n4 = lane, half = n4 >> 5, nloc = (n4 & 31) * 4;
    const float* src = W + (size_t)(wid * RPT) * LDB + ((n4 < 32) ? col0 + n4 * 4 : col1 + (n4 - 32) * 4);
    for (int kt = 0; kt < nkt; ++kt) {
        f32x4 r[RPT];
#pragma unroll
        for (int j = 0; j < RPT; ++j) r[j] = *(const f32x4*)(src + (size_t)(kt * (RPT * 8) + j) * LDB);
        LAS3 char* buf = lds + (kt & 1) * 32768;
#pragma unroll
        for (int i = 0; i < 4; ++i) {
            u32x4 w;
            if (F8) {
#pragma unroll
                for (int q = 0; q < 4; ++q) {
                    int d = __builtin_amdgcn_cvt_pk_fp8_f32(r[4 * q][i] * 256.0f, r[4 * q + 1][i] * 256.0f, 0, false);
                    d = __builtin_amdgcn_cvt_pk_fp8_f32(r[4 * q + 2][i] * 256.0f, r[4 * q + 3][i] * 256.0f, d, true);
                    w[q] = (unsigned)d;
                }
            } else {
                w.x = cvt_pk_bf16(r[0][i], r[1][i]); w.y = cvt_pk_bf16(r[2][i], r[3][i]); w.z = cvt_pk_bf16(r[4][i], r[5][i]); w.w = cvt_pk_bf16(r[6][i], r[7][i]);
            }
            const int row = nloc + i;
            *(LAS3 u32x4*)(buf + half * 16384 + row * 128 + ((wid ^ ((row >> 1) & 7)) << 4)) = w;
        }
        __syncthreads();
#pragma unroll
        for (int j = 0; j < 4; ++j) {
            const u32x4 v = *(LAS3 const u32x4*)(buf + wid * 4096 + j * 1024 + lane * 16);
            *(u32x4*)(img + (size_t)kt * 32768 + wid * 4096 + j * 1024 + lane * 16) = v;
        }
    }
    __syncthreads();
}

__device__ __forceinline__ float gelu_exact(float x) { return 0.5f * x * (1.0f + erff(x * 0.70710678118654752f)); }
__device__ __forceinline__ float bf2f(bf16_t v) { return __uint_as_float((unsigned)v << 16); }
__device__ __forceinline__ bf16_t f2bf(float v) { return (bf16_t)(cvt_pk_bf16(v, 0.f) & 0xffffu); }

struct GemmArgs {
    const bf16_t* A; const float* B; const float* bias; const float* R;
    void* C;
    const int* list; const int* cnt;
    int* done;
    int nowait;
    int* pend;
};

constexpr int EST_BF16 = 528;
constexpr int EST_F8 = 144;
constexpr int LDS_BIAS = 256 * EST_BF16 + 3072;
__device__ __forceinline__ void epi_stage_bf16(const f32x4 (&v)[2][2], int r, int colw, LAS3 char* lds) {
#pragma unroll
    for (int bj = 0; bj < 2; ++bj)
#pragma unroll
        for (int n = 0; n < 2; ++n) { u32x2 o; o.x = cvt_pk_bf16(v[bj][n][0], v[bj][n][1]); o.y = cvt_pk_bf16(v[bj][n][2], v[bj][n][3]);
            *(LAS3 u32x2*)(lds + r * EST_BF16 + (bj * 128 + n * 64 + colw) * 2) = o; }
}
__device__ __forceinline__ void epi_flush_bf16(bf16_t* C, size_t ld, int grow0, int col0, int nvalid, LAS3 char* lds, int tid) {
    __syncthreads();
    const int chunk = tid & 31, r0 = tid >> 5;
#pragma unroll 4
    for (int it = 0; it < 16; ++it) { const int row = it * 16 + r0;
        if (row < nvalid) { const u32x4 q = *(LAS3 const u32x4*)(lds + row * EST_BF16 + chunk * 16); *(u32x4*)(C + (size_t)(grow0 + row) * ld + col0 + chunk * 8) = q; } }
    __syncthreads();
}
__device__ __forceinline__ void epi_flush_f8(unsigned char* C, size_t ld, int grow0, int col0, int nvalid, LAS3 char* lds, int tid) {
    __syncthreads();
    const int chunk = tid & 7, r0 = tid >> 3;
#pragma unroll
    for (int it = 0; it < 4; ++it) { const int row = it * 64 + r0;
        if (row < nvalid) { const u32x4 q = *(LAS3 const u32x4*)(lds + row * EST_F8 + chunk * 16);
            const unsigned off = (unsigned)(grow0 + row) * (unsigned)ld + (unsigned)(col0 + chunk * 16);
            asm volatile("s_nop 4\n\tglobal_store_dwordx4 %0, %1, %2 sc1\n\ts_nop 1" :: "v"(off), "v"(q), "s"(C) : "memory"); } }
    __syncthreads();
}

constexpr int EST_F8W = 272;
__device__ __forceinline__ void epi_flush_f8w(unsigned char* C, size_t ld, int grow0, int col0, int nvalid, LAS3 char* lds, int tid) {
    __syncthreads();
    const int chunk = tid & 15, r0 = tid >> 4;
#pragma unroll
    for (int it = 0; it < 8; ++it) { const int row = it * 32 + r0;
        if (row < nvalid) { const u32x4 q = *(LAS3 const u32x4*)(lds + row * EST_F8W + chunk * 16); *(u32x4*)(C + (size_t)(grow0 + row) * ld + col0 + chunk * 16) = q; } }
    __syncthreads();
}
template <int EPI, int VAR = 0>
__device__ __forceinline__ void gemm_tile(const GemmArgs& g, int pm, int pn, int e, int ebase, int ecnt, LAS3 char* lds, int wid, int pa = 1, int pb = 1) {
    constexpr int LDB = (EPI == 0) ? DIN : (EPI == 2) ? 2 * DFF : D;
    int tid = wid * 64 + lane_id(); asm volatile("" : "+v"(tid));
    const int lane = tid & 63;
    unsigned aoff[2][2];
#pragma unroll
    for (int h = 0; h < 2; ++h)
#pragma unroll
        for (int i = 0; i < 2; ++i) {
            const int rih = (i * 8 + wid) * 8 + (lane >> 3);
            const int chunk = (lane & 7) ^ ((rih >> 1) & 7);
            int r = pm * 256 + h * 128 + rih;
            unsigned grow;
            if (EPI == 2) { if (r >= ecnt) r = ecnt - 1; grow = (unsigned)(g.list[e * T + r] >> 2); }
            else if (EPI == 3) { grow = (unsigned)(ebase + r); }
            else grow = (unsigned)r;
            aoff[h][i] = (EPI >= 2) ? (grow * (unsigned)D + (unsigned)(chunk * 16)) : (grow * (unsigned)D + (unsigned)(chunk * 8)) * 2u;
        }
    const int k8 = wid, n4 = tid & 63;
    int col;
    if (EPI == 2) col = (n4 < 32) ? pn * 128 + n4 * 4 : DFF + pn * 128 + (n4 - 32) * 4;
    else col = pn * 256 + n4 * 4;
    const unsigned boff = (unsigned)(k8 * ((EPI >= 2) ? 16 : 8)) * (unsigned)LDB + (unsigned)col;
    const float* Bp = g.B;
    if (EPI == 2) Bp += (size_t)e * D * (2 * DFF);
    if (EPI == 3) Bp += (size_t)e * DFF * D;
    if (EPI >= 2 && tid < 256) {
        float bvv;
        if (EPI == 2) bvv = (tid < 128) ? g.bias[(size_t)e * (2 * DFF) + pn * 128 + tid] : g.bias[(size_t)e * (2 * DFF) + DFF + pn * 128 + (tid - 128)] + 1.0f;
        else bvv = g.bias[(size_t)e * D + pn * 256 + tid];
        *(LAS3 float*)(lds + LDS_BIAS + tid * 4) = bvv;
    }
    if (EPI == 3) {
        if (g.pend) {
            asm volatile("s_waitcnt vmcnt(0)" ::: "memory"); __syncthreads();
            if (tid == 0) __hip_atomic_fetch_add(g.pend, 1, __ATOMIC_RELAXED, __HIP_MEMORY_SCOPE_AGENT);
        }
        if (!g.nowait) {
            if (tid == 0) { const int need = 16 * ((ecnt + 255) >> 8); unsigned sp = 0;
                while (__hip_atomic_load(g.done + e, __ATOMIC_RELAXED, __HIP_MEMORY_SCOPE_AGENT) < need) { __builtin_amdgcn_s_sleep(8); if (++sp > (1u << 20)) break; }
                __builtin_amdgcn_fence(__ATOMIC_ACQUIRE, "agent"); asm volatile("s_waitcnt vmcnt(0)" ::: "memory"); }
            __syncthreads();
        }
    }
    f32x4 acc[2][2][4][2];
    if (EPI >= 2) gemm_kloop_f8<LDB>(acc, (const unsigned char*)g.A, aoff, Bp, boff, D / 128, lds, tid, wid, pa, pb);
    else gemm_kloop<LDB, VAR>(acc, g.A, aoff, Bp, boff, D / GBK, lds, tid, wid, (size_t)GBK * pa, (size_t)GBK * LDB * pb);
    int tz = wid * 64 + lane_id(); asm volatile("" : "+v"(tz));
    if (EPI == 2 && g.pend && tz == 0) __hip_atomic_fetch_add(g.pend, 1, __ATOMIC_RELAXED, __HIP_MEMORY_SCOPE_AGENT);
    const int wid2 = tz >> 6, lane2 = tz & 63;
    const int row0 = (wid2 >> 2) * 64 + (lane2 & 15), colw = (wid2 & 3) * 16 + (lane2 >> 4) * 4;
    if (EPI == 0) {
#pragma unroll
        for (int ai = 0; ai < 2; ++ai)
#pragma unroll
            for (int m = 0; m < 4; ++m) {
                f32x4 v[2][2];
#pragma unroll
                for (int bj = 0; bj < 2; ++bj)
#pragma unroll
                    for (int n = 0; n < 2; ++n) v[bj][n] = acc[ai][bj][m][n];
                epi_stage_bf16(v, ai * 128 + row0 + m * 16, colw, lds);
            }
        epi_flush_bf16((bf16_t*)g.C, DIN, pm * 256, pn * 256, 256, lds, tz);
    } else if (EPI == 1) {
        float* C = (float*)g.C;
#pragma unroll
        for (int ai = 0; ai < 2; ++ai)
#pragma unroll
            for (int m = 0; m < 4; ++m) {
                const size_t ro = (size_t)(pm * 256 + ai * 128 + row0 + m * 16) * D + pn * 256 + colw;
#pragma unroll
                for (int bj = 0; bj < 2; ++bj)
#pragma unroll
                    for (int n = 0; n < 2; ++n) { const f32x4 xr = *(const f32x4*)(g.R + ro + bj * 128 + n * 64);
                        *(f32x4*)(C + ro + bj * 128 + n * 64) = acc[ai][bj][m][n] + xr; }
            }
    } else if (EPI == 2) {
        unsigned char* C = (unsigned char*)g.C;
        f32x4 bgate[2], bup1[2];
#pragma unroll
        for (int n = 0; n < 2; ++n) { bgate[n] = *(LAS3 const f32x4*)(lds + LDS_BIAS + (n * 64 + colw) * 4); bup1[n] = *(LAS3 const f32x4*)(lds + LDS_BIAS + (128 + n * 64 + colw) * 4); }
#pragma unroll
        for (int ai = 0; ai < 2; ++ai)
#pragma unroll
            for (int m = 0; m < 4; ++m) {
                const int r = pm * 256 + ai * 128 + row0 + m * 16;
                {
                    LAS3 char* rp = lds + (ai * 128 + row0 + m * 16) * EST_F8 + colw;
#pragma unroll
                    for (int n = 0; n < 2; ++n) {
                        float o[4];
#pragma unroll
                        for (int j = 0; j < 4; j += 2) {
                            typedef float f32x2 __attribute__((ext_vector_type(2)));
                            f32x2 gt = (f32x2){acc[ai][0][m][n][j], acc[ai][0][m][n][j + 1]} + (f32x2){bgate[n][j], bgate[n][j + 1]};
                            f32x2 up = (f32x2){acc[ai][1][m][n][j], acc[ai][1][m][n][j + 1]} + (f32x2){bup1[n][j], bup1[n][j + 1]};
                            gt.x = fminf(gt.x, 7.0f); gt.y = fminf(gt.y, 7.0f);
                            up.x = __builtin_amdgcn_fmed3f(up.x, -6.0f, 8.0f); up.y = __builtin_amdgcn_fmed3f(up.y, -6.0f, 8.0f);
                            const f32x2 xe = gt * (-2.45546696f);
                            f32x2 ex; ex.x = __builtin_amdgcn_exp2f(xe.x); ex.y = __builtin_amdgcn_exp2f(xe.y);
                            const f32x2 den = ex + 1.0f;
                            f32x2 rc; rc.x = __builtin_amdgcn_rcpf(den.x); rc.y = __builtin_amdgcn_rcpf(den.y);
                            const f32x2 res = (gt * rc) * up;
                            o[j] = res.x; o[j + 1] = res.y;
                        }
                        int w = __builtin_amdgcn_cvt_pk_fp8_f32(o[0], o[1], 0, false);
                        w = __builtin_amdgcn_cvt_pk_fp8_f32(o[2], o[3], w, true);
                        *(LAS3 int*)(rp + n * 64) = w;
                    }
                }
            }
        { const int nv = ecnt - pm * 256; epi_flush_f8(C, DFF, ebase + pm * 256, pn * 128, nv < 256 ? nv : 256, lds, tz); }
    } else {
        bf16_t* C = (bf16_t*)g.C;
        f32x4 bv[2][2];
#pragma unroll
        for (int bj = 0; bj < 2; ++bj)
#pragma unroll
            for (int n = 0; n < 2; ++n) bv[bj][n] = *(LAS3 const f32x4*)(lds + LDS_BIAS + (bj * 128 + n * 64 + colw) * 4);
#pragma unroll
        for (int ai = 0; ai < 2; ++ai)
#pragma unroll
            for (int m = 0; m < 4; ++m) {
                LAS3 char* rp = lds + (ai * 128 + row0 + m * 16) * EST_F8W + colw;
#pragma unroll
                for (int bj = 0; bj < 2; ++bj)
#pragma unroll
                    for (int n = 0; n < 2; ++n) { const f32x4 v = acc[ai][bj][m][n] + bv[bj][n];
                        int w = __builtin_amdgcn_cvt_pk_fp8_f32(v[0], v[1], 0, false); w = __builtin_amdgcn_cvt_pk_fp8_f32(v[2], v[3], w, true);
                        *(LAS3 int*)(rp + bj * 128 + n * 64) = w; }
            }
        { const int nv = ecnt - pm * 256; epi_flush_f8w((unsigned char*)g.C, D, ebase + pm * 256, pn * 256, nv < 256 ? nv : 256, lds, tz); }
    }
}


template <int EPI>
__device__ __forceinline__ void gemm_tile_img(const GemmArgs& g, int pm, int pn, int e, int ebase, int ecnt, LAS3 char* lds, int wid, const unsigned char* img, int kh = -1) {
    int tid = wid * 64 + lane_id(); asm volatile("" : "+v"(tid));
    const int lane = tid & 63;
    unsigned aoff[2][2];
#pragma unroll
    for (int h = 0; h < 2; ++h)
#pragma unroll
        for (int i = 0; i < 2; ++i) {
            const int rih = (i * 8 + wid) * 8 + (lane >> 3);
            const int chunk = (lane & 7) ^ ((rih >> 1) & 7);
            int r = pm * 256 + h * 128 + rih;
            unsigned grow;
            if (EPI == 2) { if (r >= ecnt) r = ecnt - 1; grow = (unsigned)(g.list[e * T + r] >> 2); }
            else if (EPI == 3) { grow = (unsigned)(ebase + r); }
            else grow = (unsigned)r;
            aoff[h][i] = (EPI >= 2) ? (grow * (unsigned)D + (unsigned)(chunk * 16)) : (grow * (unsigned)D + (unsigned)(chunk * 8)) * 2u;
        }
    f32x4 acc[2][2][4][2];
    gemm_kloop_dma<(EPI >= 2), false, (EPI == 2) ? 0 : (EPI == 3) ? DFF : 2 * D>(acc, (const unsigned char*)g.A, aoff, img, (EPI >= 2) ? D / 128 : (EPI == 0 && kh >= 0) ? D / 128 : D / 64, lds, tid, wid, (EPI == 0 && kh > 0) ? D / 128 : 0);
    int tz = wid * 64 + lane_id(); asm volatile("" : "+v"(tz));
    const int wid2 = tz >> 6, lane2 = tz & 63;
    const int row0 = (wid2 >> 2) * 64 + (lane2 & 15), colw = (wid2 & 3) * 16 + (lane2 >> 4) * 4;
    if (EPI == 0) {
#pragma unroll
        for (int ai = 0; ai < 2; ++ai)
#pragma unroll
            for (int m = 0; m < 4; ++m) {
                f32x4 v[2][2];
#pragma unroll
                for (int bj = 0; bj < 2; ++bj)
#pragma unroll
                    for (int n = 0; n < 2; ++n) v[bj][n] = acc[ai][bj][m][n];
                epi_stage_bf16(v, ai * 128 + row0 + m * 16, colw, lds);
            }
        if (kh > 0) epi_flush_bf16((bf16_t*)g.R, DIN - 4096, pm * 256, pn * 256 - 4096, 256, lds, tz);
        else epi_flush_bf16((bf16_t*)g.C, DIN, pm * 256, pn * 256, 256, lds, tz);
    } else if (EPI == 1) {
        float* C = (float*)g.C;
#pragma unroll
        for (int ai = 0; ai < 2; ++ai)
#pragma unroll
            for (int m = 0; m < 4; ++m) {
                const size_t ro = (size_t)(pm * 256 + ai * 128 + row0 + m * 16) * D + pn * 256 + colw;
#pragma unroll
                for (int bj = 0; bj < 2; ++bj)
#pragma unroll
                    for (int n = 0; n < 2; ++n) { const f32x4 xr = *(const f32x4*)(g.R + ro + bj * 128 + n * 64);
                        *(f32x4*)(C + ro + bj * 128 + n * 64) = acc[ai][bj][m][n] + xr; }
            }
    } else if (EPI == 2) {
        unsigned char* C = (unsigned char*)g.C;
        const float* bg = g.bias + (size_t)e * (2 * DFF) + pn * 128 + colw;
        f32x4 bgate[2], bup1[2];
#pragma unroll
        for (int n = 0; n < 2; ++n) { bgate[n] = *(const f32x4*)(bg + n * 64); bup1[n] = *(const f32x4*)(bg + DFF + n * 64) + 1.0f; }
#pragma unroll
        for (int ai = 0; ai < 2; ++ai)
#pragma unroll
            for (int m = 0; m < 4; ++m) {
                const int r = pm * 256 + ai * 128 + row0 + m * 16;
                {
                    LAS3 char* rp = lds + (ai * 128 + row0 + m * 16) * EST_F8 + colw;
#pragma unroll
                    for (int n = 0; n < 2; ++n) {
                        float o[4];
#pragma unroll
                        for (int j = 0; j < 4; j += 2) {
                            typedef float f32x2 __attribute__((ext_vector_type(2)));
                            f32x2 gt = (f32x2){acc[ai][0][m][n][j], acc[ai][0][m][n][j + 1]} + (f32x2){bgate[n][j], bgate[n][j + 1]};
                            f32x2 up = (f32x2){acc[ai][1][m][n][j], acc[ai][1][m][n][j + 1]} + (f32x2){bup1[n][j], bup1[n][j + 1]};
                            gt.x = fminf(gt.x, 7.0f); gt.y = fminf(gt.y, 7.0f);
                            up.x = __builtin_amdgcn_fmed3f(up.x, -6.0f, 8.0f); up.y = __builtin_amdgcn_fmed3f(up.y, -6.0f, 8.0f);
                            const f32x2 xe = gt * (-2.45546696f);
                            f32x2 ex; ex.x = __builtin_amdgcn_exp2f(xe.x); ex.y = __builtin_amdgcn_exp2f(xe.y);
                            const f32x2 den = ex + 1.0f;
                            f32x2 rc; rc.x = __builtin_amdgcn_rcpf(den.x); rc.y = __builtin_amdgcn_rcpf(den.y);
                            const f32x2 res = (gt * rc) * up;
                            o[j] = res.x; o[j + 1] = res.y;
                        }
                        int w = __builtin_amdgcn_cvt_pk_fp8_f32(o[0], o[1], 0, false);
                        w = __builtin_amdgcn_cvt_pk_fp8_f32(o[2], o[3], w, true);
                        *(LAS3 int*)(rp + n * 64) = w;
                    }
                }
            }
        { const int nv = ecnt - pm * 256; epi_flush_f8(C, DFF, ebase + pm * 256, pn * 128, nv < 256 ? nv : 256, lds, tz); }
    } else {
        bf16_t* C = (bf16_t*)g.C;
        const float* bd = g.bias + (size_t)e * D + pn * 256 + colw;
        f32x4 bv[2][2];
#pragma unroll
        for (int bj = 0; bj < 2; ++bj)
#pragma unroll
            for (int n = 0; n < 2; ++n) bv[bj][n] = *(const f32x4*)(bd + bj * 128 + n * 64);
#pragma unroll
        for (int ai = 0; ai < 2; ++ai)
#pragma unroll
            for (int m = 0; m < 4; ++m) {
                LAS3 char* rp = lds + (ai * 128 + row0 + m * 16) * EST_F8W + colw;
#pragma unroll
                for (int bj = 0; bj < 2; ++bj)
#pragma unroll
                    for (int n = 0; n < 2; ++n) { const f32x4 v = acc[ai][bj][m][n] + bv[bj][n];
                        int w = __builtin_amdgcn_cvt_pk_fp8_f32(v[0], v[1], 0, false); w = __builtin_amdgcn_cvt_pk_fp8_f32(v[2], v[3], w, true);
                        *(LAS3 int*)(rp + bj * 128 + n * 64) = w; }
            }
        { const int nv = ecnt - pm * 256; epi_flush_f8w((unsigned char*)g.C, D, ebase + pm * 256, pn * 256, nv < 256 ? nv : 256, lds, tz); }
    }
}

#define XB_TMO      128
#define XB_XCNT(j)  (256  + 64 * (j))
#define XB_XSUB(j)  (1280 + 64 * (j))
#define XB_XGEN(j)  (2304 + 64 * (j))
#define XB_TOP      3328
#define XB_TOPGEN   3392
#define XCD_BAR_WORDS 3456
#define XB_SPIN_CAP (1u << 18)
#define LAS __attribute__((address_space(3)))

__device__ __forceinline__ unsigned xb_ld(unsigned* p)              { return __hip_atomic_load(p, __ATOMIC_RELAXED, __HIP_MEMORY_SCOPE_AGENT); }
__device__ __forceinline__ unsigned xb_add(unsigned* p, unsigned v) { return __hip_atomic_fetch_add(p, v, __ATOMIC_RELAXED, __HIP_MEMORY_SCOPE_AGENT); }
__device__ __forceinline__ unsigned xb_xcc_id() { return (unsigned)__builtin_amdgcn_s_getreg((3 << 11) | 20) & 0xFu; }
#define XB_SPIN(cond, bar) do { unsigned _sp = 0; while (cond) { __builtin_amdgcn_s_sleep(1); \
    if ((++_sp & 255u) == 0u) { if (xb_ld(&(bar)[XB_TMO])) break; if (_sp > XB_SPIN_CAP) { atomicAdd(&(bar)[XB_TMO], 1u); break; } } } } while (0)

struct XcdBarrier {
    unsigned* bar; unsigned x;
    volatile LAS unsigned* st;
};
__device__ __forceinline__ XcdBarrier xcd_barrier_post(unsigned* bar, volatile LAS unsigned* st, int tid) {
    XcdBarrier b; b.bar = bar; b.x = xb_xcc_id(); b.st = st;
    if (tid == 0) (void)xb_add(&bar[XB_XCNT(b.x)], 1u);
    return b;
}
__device__ __forceinline__ void xcd_barrier_complete(unsigned* bar, unsigned x, unsigned& nloc, unsigned& nx) {
    const unsigned G = gridDim.x * gridDim.y * gridDim.z;
    unsigned sum, cnt, mine, sp = 0u;
    for (;;) {
        sum = 0u; cnt = 0u; mine = 0u;
#pragma unroll
        for (unsigned j = 0; j < 16; ++j) { const unsigned c = xb_ld(&bar[XB_XCNT(j)]); sum += c; cnt += (c > 0u) ? 1u : 0u; mine = (j == x) ? c : mine; }
        if (sum == G) break;
        __builtin_amdgcn_s_sleep(1);
        if ((++sp & 255u) == 0u) { if (xb_ld(&bar[XB_TMO])) break; if (sp > XB_SPIN_CAP) { atomicAdd(&bar[XB_TMO], 1u); break; } }
    }
    nloc = mine > 0u ? mine : 1u; nx = cnt > 0u ? cnt : 1u;
}
__device__ __forceinline__ void xcd_barrier(const XcdBarrier& b, int tid) {
    asm volatile("s_waitcnt vmcnt(0)" ::: "memory");
    __syncthreads();
    if (tid == 0) {
        unsigned* bar = b.bar;
        __builtin_amdgcn_s_waitcnt(0);
        unsigned nloc = b.st[0], nx = b.st[1];
        if (nloc == 0u) { xcd_barrier_complete(bar, b.x, nloc, nx); b.st[0] = nloc; b.st[1] = nx; }
        const unsigned old = xb_add(&bar[XB_XSUB(b.x)], 1u);
        const unsigned gen = old / nloc;
        if (old + 1u == (gen + 1u) * nloc) {
            __builtin_amdgcn_fence(__ATOMIC_RELEASE, "agent");
            asm volatile("s_waitcnt vmcnt(0)" ::: "memory");
            const unsigned og = xb_add(&bar[XB_TOP], 1u);
            const unsigned tg = og / nx;
            if (og + 1u == (tg + 1u) * nx) xb_add(&bar[XB_TOPGEN], 1u);
            else XB_SPIN(xb_ld(&bar[XB_TOPGEN]) == tg, bar);
            __builtin_amdgcn_fence(__ATOMIC_ACQUIRE, "agent");
            xb_add(&bar[XB_XGEN(b.x)], 1u);
            asm volatile("s_waitcnt vmcnt(0)" ::: "memory");
        } else {
            XB_SPIN(xb_ld(&bar[XB_XGEN(b.x)]) == gen, bar);
            __builtin_amdgcn_fence(__ATOMIC_ACQUIRE, "agent");
            asm volatile("s_waitcnt vmcnt(0)" ::: "memory");
        }
    }
    __syncthreads();
}

struct Params {
    const float *x, *ln_mix_g, *w_in, *conv_w, *sgu_ln_g, *sgu_ln_b, *sgu_w, *sgu_b, *gn_conv, *gn_sgu, *w_out, *ln_ffn_g, *w_router, *b_router,
                *w_gate_up, *b_gate_up, *w_down, *b_down, *ln_final_g;
    float* out;
    unsigned* bar; int* cnt; int* list; int* sel; float* gates; int* done;
    bf16_t *xn, *proj, *proj2, *y, *xn2, *act, *outp; float* h;
    unsigned char *img_in, *img_out;
};
constexpr int LDS_MISC = 256 * EST_BF16;
constexpr int LDS_TOTAL = LDS_MISC + 4096;

__device__ __forceinline__ void phase_rmsnorm(const float* __restrict__ x, const float* __restrict__ g, bf16_t* __restrict__ y, int wid) {
    int lane = lane_id(); asm volatile("" : "+v"(lane));
    for (int t = blockIdx.x * 8 + wid; t < T; t += gridDim.x * 8) {
        const float* xr = x + (size_t)t * D;
        f32x4 v[8]; float s = 0.f;
#pragma unroll
        for (int j = 0; j < 8; ++j) { v[j] = *(const f32x4*)(xr + j * 256 + lane * 4); s += v[j][0] * v[j][0] + v[j][1] * v[j][1] + v[j][2] * v[j][2] + v[j][3] * v[j][3]; }
        s = wave_sum(s);
        const float r = rsqrtf(s * (1.0f / D) + EPS);
#pragma unroll
        for (int j = 0; j < 8; ++j) {
            const f32x4 gg = *(const f32x4*)(g + j * 256 + lane * 4);
            u32x2 o; o.x = cvt_pk_bf16(v[j][0] * r * gg[0], v[j][1] * r * gg[1]); o.y = cvt_pk_bf16(v[j][2] * r * gg[2], v[j][3] * r * gg[3]);
            *(u32x2*)(y + (size_t)t * D + j * 256 + lane * 4) = o;
        }
    }
}

__device__ __forceinline__ float gelu_f(float v) {
    const float av = fabsf(v), dd = av * 0.2316418882f + 1.0f;
    const float tt = __builtin_amdgcn_rcpf(dd);
    float q = tt * 0.5307027145f + (-0.7265760135f); q = q * tt + 0.7107068705f; q = q * tt + (-0.142248368f); q = q * tt + 0.127414796f; q = q * tt;
    const float e = __builtin_amdgcn_exp2f((v * v) * (-0.72134752044f));
    const float m = v * (q * e);
    return v < 0.f ? m : v - m;
}
typedef float f32x16 __attribute__((ext_vector_type(16)));

__device__ __forceinline__ void phase_mixer(const Params& p, LAS3 char* lds, int wid) {
    int lane = lane_id(); asm volatile("" : "+v"(lane));
    const int n = lane & 31, kh = lane >> 5;
    const bf16_t* __restrict__ proj = p.proj;
    LAS3 float* stat = (LAS3 float*)(lds + 32768);
    const int nunits = (T / 128) * 16;
    for (int it = 0; it * (int)gridDim.x < nunits; ++it) {
        const int b = blockIdx.x;
        int u = it * gridDim.x + b;
        if (u >= nunits) break;
        int chunk, g;
        if ((gridDim.x & 15) == 0) { chunk = (b >> 4) + (gridDim.x >> 4) * it; g = ((b & 15) + 8 * (it & 1)) & 15; } else { chunk = u >> 4; g = u & 15; }
        const int t0 = chunk * 128;
        if (g < 8) {
            const int c = g * 128 + 2 * lane;
            const int r0 = t0 + 16 * wid;
            const bf16_t* base = proj + (size_t)r0 * DIN + c;
            const float w00 = p.conv_w[c], w01 = p.conv_w[c + 1], w10 = p.conv_w[DC + c], w11 = p.conv_w[DC + c + 1], w20 = p.conv_w[2 * DC + c], w21 = p.conv_w[2 * DC + c + 1];
            const float g0 = p.gn_conv[c], g1 = p.gn_conv[c + 1];
            const bool has_hist = ((r0 % SEQ) != 0);
            float z2a = 0.f, z2b = 0.f, z1a = 0.f, z1b = 0.f;
            if (has_hist) {
                const unsigned c2 = *(const unsigned*)(base - 2 * (ptrdiff_t)DIN + DC), h2 = *(const unsigned*)(base - 2 * (ptrdiff_t)DIN + 2 * DC);
                const unsigned c1 = *(const unsigned*)(base - (ptrdiff_t)DIN + DC), h1 = *(const unsigned*)(base - (ptrdiff_t)DIN + 2 * DC);
                z2a = bf16_lo(c2) * bf16_lo(h2); z2b = bf16_hi(c2) * bf16_hi(h2); z1a = bf16_lo(c1) * bf16_lo(h1); z1b = bf16_hi(c1) * bf16_hi(h1);
            }
#pragma unroll 1
            for (int hb = 0; hb < 16; hb += 8) {
                unsigned bg[8], cg[8], hg[8];
#pragma unroll
                for (int i = 0; i < 8; ++i) { bg[i] = *(const unsigned*)(base + (size_t)(hb + i) * DIN); cg[i] = *(const unsigned*)(base + (size_t)(hb + i) * DIN + DC); hg[i] = *(const unsigned*)(base + (size_t)(hb + i) * DIN + 2 * DC); }
#pragma unroll
                for (int i = 0; i < 8; ++i) {
                    const float z0a = bf16_lo(cg[i]) * bf16_lo(hg[i]), z0b = bf16_hi(cg[i]) * bf16_hi(hg[i]);
                    const float ya = bf16_lo(bg[i]) * (w00 * z2a + w10 * z1a + w20 * z0a);
                    const float yb = bf16_hi(bg[i]) * (w01 * z2b + w11 * z1b + w21 * z0b);
                    z2a = z1a; z2b = z1b; z1a = z0a; z1b = z0b;
                    const float ss = wave_sum(ya * ya + yb * yb);
                    const float rs = rsqrtf(ss * (1.0f / 128.0f) + EPS);
                    *(unsigned*)(p.y + (size_t)(r0 + hb + i) * D + c) = cvt_pk_bf16(ya * rs * g0, yb * rs * g1);
                }
            }
            __syncthreads(); __syncthreads(); __syncthreads();
        } else {
            const int hd = g - 8;
            {
                const int s0 = 16 * wid + 8 * kh;
                const bf16_t* vb = proj + (size_t)(t0 + s0) * DIN + 4096 + hd * 128 + 4 * n;
                const bf16_t* vb2 = p.proj2 + (size_t)(t0 + s0) * (DIN - 4096) + hd * 128 + 4 * n;
                u32x2 raw[8], raw2[8];
#pragma unroll
                for (int j = 0; j < 8; ++j) { raw[j] = *(const u32x2*)(vb + (size_t)j * DIN); raw2[j] = *(const u32x2*)(vb2 + (size_t)j * (DIN - 4096)); }
                const f32x4 lg = *(const f32x4*)(p.sgu_ln_g + hd * 128 + 4 * n), lb = *(const f32x4*)(p.sgu_ln_b + hd * 128 + 4 * n);
                float vn[8][4];
#pragma unroll
                for (int j = 0; j < 8; ++j) {
                    const float a0 = gelu_f(bf16_lo(raw[j].x) + bf16_lo(raw2[j].x)), a1 = gelu_f(bf16_hi(raw[j].x) + bf16_hi(raw2[j].x)), a2 = gelu_f(bf16_lo(raw[j].y) + bf16_lo(raw2[j].y)), a3 = gelu_f(bf16_hi(raw[j].y) + bf16_hi(raw2[j].y));
                    const float mu = half_sum32((a0 + a1) + (a2 + a3)) * (1.0f / 128.0f);
                    const float d0 = a0 - mu, d1 = a1 - mu, d2 = a2 - mu, d3 = a3 - mu;
                    const float rs = rsqrtf(half_sum32((d0 * d0 + d1 * d1) + (d2 * d2 + d3 * d3)) * (1.0f / 128.0f) + EPS);
                    vn[j][0] = d0 * rs * lg[0] + lb[0]; vn[j][1] = d1 * rs * lg[1] + lb[1]; vn[j][2] = d2 * rs * lg[2] + lb[2]; vn[j][3] = d3 * rs * lg[3] + lb[3];
                }
                __syncthreads();
#pragma unroll
                for (int c = 0; c < 4; ++c) {
                    u32x4 f; f.x = cvt_pk_bf16(vn[0][c], vn[1][c]); f.y = cvt_pk_bf16(vn[2][c], vn[3][c]); f.z = cvt_pk_bf16(vn[4][c], vn[5][c]); f.w = cvt_pk_bf16(vn[6][c], vn[7][c]);
                    *(LAS3 u32x4*)(lds + ((wid * 4 + c) * 64 + lane) * 16) = f;
                }
            }
            __syncthreads();
            {
                const int mt = wid >> 1, cp = (wid & 1) * 2;
                const int trow = 32 * mt + n;
                const float* Wr = p.sgu_w + (size_t)hd * 16384 + (size_t)trow * 128 + 8 * kh;
                f32x16 acc0, acc1;
#pragma unroll
                for (int r = 0; r < 16; ++r) { acc0[r] = 0.f; acc1[r] = 0.f; }
                for (int ks = 0; ks <= 2 * mt + 1; ++ks) {
                    const f32x4 wa = *(const f32x4*)(Wr + 16 * ks), wb = *(const f32x4*)(Wr + 16 * ks + 4);
                    const int sb = 16 * ks + 8 * kh;
                    float wv[8] = {wa[0], wa[1], wa[2], wa[3], wb[0], wb[1], wb[2], wb[3]};
#pragma unroll
                    for (int j = 0; j < 8; ++j) wv[j] = (sb + j <= trow) ? wv[j] : 0.f;
                    u32x4 af; af.x = cvt_pk_bf16(wv[0], wv[1]); af.y = cvt_pk_bf16(wv[2], wv[3]); af.z = cvt_pk_bf16(wv[4], wv[5]); af.w = cvt_pk_bf16(wv[6], wv[7]);
                    const u32x4 b0 = *(LAS3 const u32x4*)(lds + ((ks * 4 + cp) * 64 + lane) * 16);
                    const u32x4 b1 = *(LAS3 const u32x4*)(lds + ((ks * 4 + cp + 1) * 64 + lane) * 16);
                    acc0 = __builtin_amdgcn_mfma_f32_32x32x16_bf16(__builtin_bit_cast(bf16x8, af), __builtin_bit_cast(bf16x8, b0), acc0, 0, 0, 0);
                    acc1 = __builtin_amdgcn_mfma_f32_32x32x16_bf16(__builtin_bit_cast(bf16x8, af), __builtin_bit_cast(bf16x8, b1), acc1, 0, 0, 0);
                }
                const bf16_t* ub = proj + (size_t)t0 * DIN + 3072 + hd * 128 + 4 * n + cp;
                float ya[16], yb[16];
#pragma unroll
                for (int r = 0; r < 16; ++r) {
                    const int tt = 32 * mt + (r & 3) + 8 * (r >> 2) + 4 * kh;
                    const unsigned uu = *(const unsigned*)(ub + (size_t)tt * DIN);
                    const float bias = p.sgu_b[hd * 128 + tt];
                    ya[r] = gelu_f(bf16_lo(uu)) * (acc0[r] + bias);
                    yb[r] = gelu_f(bf16_hi(uu)) * (acc1[r] + bias);
                    const float ps = half_sum32(ya[r] * ya[r] + yb[r] * yb[r]);
                    if (n == 0) stat[tt * 2 + (wid & 1)] = ps;
                }
                __syncthreads();
                const float g0 = p.gn_sgu[hd * 128 + 4 * n + cp], g1 = p.gn_sgu[hd * 128 + 4 * n + cp + 1];
#pragma unroll
                for (int r = 0; r < 16; ++r) {
                    const int tt = 32 * mt + (r & 3) + 8 * (r >> 2) + 4 * kh;
                    const float rs = rsqrtf((stat[tt * 2] + stat[tt * 2 + 1]) * (1.0f / 128.0f) + EPS);
                    *(unsigned*)(p.y + (size_t)(t0 + tt) * D + DC + hd * 128 + 4 * n + cp) = cvt_pk_bf16(ya[r] * rs * g0, yb[r] * rs * g1);
                }
            }
        }
    }
}

__device__ __forceinline__ void phase_router(const Params& p, LAS3 char* lds, int wid) {
    LAS3 float* part = (LAS3 float*)lds;
    LAS3 float* ssqp = (LAS3 float*)(lds + 34816);
    LAS3 float* logit = (LAS3 float*)(lds + 36864);
    LAS3 float* rstd = (LAS3 float*)(lds + 41984);
    LAS3 int* lhist = (LAS3 int*)(lds + 42240);
    LAS3 int* gbase = (LAS3 int*)(lds + 42368);
    int lane = lane_id(); asm volatile("" : "+v"(lane));
    const int n = lane & 31, kh = lane >> 5, tid = wid * 64 + lane;
    for (int grp = blockIdx.x; grp < T / 32; grp += gridDim.x) {
        const int t0 = grp * 32;
        __syncthreads();
        if (tid < 32) lhist[tid] = 0;
        {
            const float* hrow = p.h + (size_t)(t0 + n) * D + wid * 256 + 4 * kh;
            const float* grow = p.ln_ffn_g + wid * 256 + 4 * kh;
            const float* wrow = p.w_router + (size_t)(wid * 256 + 4 * kh) * 32 + n;
            f32x16 acc;
#pragma unroll
            for (int r = 0; r < 16; ++r) acc[r] = 0.f;
            float ssq = 0.f;
#pragma unroll 1
            for (int jj = 0; jj < 32; jj += 8) {
                f32x4 hv[8], gv[8];
#pragma unroll
                for (int j = 0; j < 8; ++j) { hv[j] = *(const f32x4*)(hrow + 8 * (jj + j)); gv[j] = *(const f32x4*)(grow + 8 * (jj + j)); }
#pragma unroll
                for (int j = 0; j < 8; ++j)
#pragma unroll
                    for (int i = 0; i < 4; ++i) {
                        const float a = hv[j][i];
                        ssq += a * a;
                        const float bw = wrow[(size_t)(8 * (jj + j) + i) * 32];
                        acc = __builtin_amdgcn_mfma_f32_32x32x2f32(a * gv[j][i], bw, acc, 0, 0, 0);
                    }
            }
            ssq += xor32(ssq);
            if (kh == 0) ssqp[wid * 32 + n] = ssq;
#pragma unroll
            for (int r = 0; r < 16; ++r) part[(wid * 32 + ((r & 3) + 8 * (r >> 2) + 4 * kh)) * 33 + n] = acc[r];
        }
        __syncthreads();
        if (tid < 32) { float s = 0.f;
#pragma unroll
            for (int w = 0; w < 8; ++w) s += ssqp[w * 32 + tid];
            rstd[tid] = rsqrtf(s * (1.0f / D) + EPS); }
        __syncthreads();
#pragma unroll
        for (int i = 0; i < 2; ++i) {
            const int idx = tid + 512 * i, tk = idx >> 5, e = idx & 31;
            float s = 0.f;
#pragma unroll
            for (int w = 0; w < 8; ++w) s += part[(w * 32 + tk) * 33 + e];
            logit[tk * 33 + e] = s * rstd[tk] + p.b_router[e];
        }
        __syncthreads();
        int se[4] = {0, 0, 0, 0}, sl[4] = {0, 0, 0, 0}; float sx[4] = {0.f, 0.f, 0.f, 0.f}; float sden = 1.f;
        if (tid < 32) {
            float v0 = 0.f; sden = 0.f;
#pragma unroll
            for (int k = 0; k < 4; ++k) {
                int bi = 0; float bv = -3.0e38f;
                for (int i = 0; i < 32; ++i) { const float l = logit[tid * 33 + i]; if (l > bv) { bv = l; bi = i; } }
                logit[tid * 33 + bi] = -3.4e38f;
                if (k == 0) v0 = bv;
                sx[k] = __expf(bv - v0); sden += sx[k];
                se[k] = bi; sl[k] = atomicAdd((int*)&lhist[bi], 1);
            }
        }
        __syncthreads();
        if (tid < 32) { const int c = lhist[tid]; gbase[tid] = c ? atomicAdd(&p.cnt[tid], c) : 0; }
        __syncthreads();
        if (tid < 32) {
            const int t = t0 + tid;
            const float inv = 1.0f / sden;
#pragma unroll
            for (int k = 0; k < 4; ++k) {
                const int slot = gbase[se[k]] + sl[k];
                p.gates[t * 4 + k] = sx[k] * inv;
                p.list[se[k] * T + slot] = t * 4 + k;
                p.sel[t * 4 + k] = (se[k] << 16) | slot;
            }
        }
#pragma unroll 1
        for (int q = 0; q < 4; ++q) {
            const int tk = wid * 4 + q;
            const float r = rstd[tk];
            const float* hr = p.h + (size_t)(t0 + tk) * D;
#pragma unroll
            for (int j = 0; j < 8; ++j) {
                const f32x4 hv = *(const f32x4*)(hr + j * 256 + lane * 4), gg = *(const f32x4*)(p.ln_ffn_g + j * 256 + lane * 4);
                int o = __builtin_amdgcn_cvt_pk_fp8_f32(hv[0] * r * gg[0], hv[1] * r * gg[1], 0, false);
                o = __builtin_amdgcn_cvt_pk_fp8_f32(hv[2] * r * gg[2], hv[3] * r * gg[3], o, true);
                *(int*)((unsigned char*)p.xn2 + (size_t)(t0 + tk) * D + j * 256 + lane * 4) = o;
            }
        }
    }
}

__device__ __forceinline__ void phase_final(const Params& p, LAS3 char* lds, int wid) {
    LAS3 int* base = (LAS3 int*)(lds + LDS_MISC + 2048);
    int lane = lane_id(); asm volatile("" : "+v"(lane));
    if (wid == 0 && lane == 0) { int a = 0; for (int i = 0; i < NE; ++i) { base[i] = a; a += p.cnt[i]; } }
    __syncthreads();
    for (int t = blockIdx.x * 8 + wid; t < T; t += gridDim.x * 8) {
        float gk[4]; const unsigned char* op[4];
#pragma unroll
        for (int k = 0; k < 4; ++k) { const int s = p.sel[t * 4 + k]; gk[k] = p.gates[t * 4 + k]; op[k] = (const unsigned char*)p.outp + (size_t)(base[s >> 16] + (s & 0xffff)) * D; }
        f32x4 v[8]; float ss = 0.f;
#pragma unroll
        for (int j = 0; j < 8; ++j) {
            const int c = j * 256 + lane * 4;
            f32x4 a = *(const f32x4*)(p.h + (size_t)t * D + c);
#pragma unroll
            for (int k = 0; k < 4; ++k) { const int o = *(const int*)(op[k] + c);
                typedef float f32x2 __attribute__((ext_vector_type(2)));
                const f32x2 lo = __builtin_amdgcn_cvt_pk_f32_fp8(o, false), hi = __builtin_amdgcn_cvt_pk_f32_fp8(o, true);
                a[0] += gk[k] * lo.x; a[1] += gk[k] * lo.y; a[2] += gk[k] * hi.x; a[3] += gk[k] * hi.y; }
            v[j] = a; ss += a[0] * a[0] + a[1] * a[1] + a[2] * a[2] + a[3] * a[3];
        }
        ss = wave_sum(ss);
        const float r = rsqrtf(ss * (1.0f / D) + EPS);
#pragma unroll
        for (int j = 0; j < 8; ++j) { const int c = j * 256 + lane * 4; const f32x4 gg = *(const f32x4*)(p.ln_final_g + c);
            f32x4 o; o[0] = v[j][0] * r * gg[0]; o[1] = v[j][1] * r * gg[1]; o[2] = v[j][2] * r * gg[2]; o[3] = v[j][3] * r * gg[3];
            *(f32x4*)(p.out + (size_t)t * D + c) = o; }
    }
}

__global__ void __launch_bounds__(512, 2) k_mega(Params p) {
    extern __shared__ __attribute__((aligned(16))) char smem[];
    LAS3 char* lds = (LAS3 char*)smem;
    volatile LAS unsigned* xbw = (volatile LAS unsigned*)(lds + LDS_MISC);
    int wid = __builtin_amdgcn_readfirstlane((int)(threadIdx.x >> 6)); asm volatile("" : "+s"(wid));
    const int tid0 = wid * 64 + lane_id();
    if (tid0 == 0) { xbw[0] = 0u; xbw[1] = 0u; xbw[2] = 0u; xbw[3] = 0u; }
    __syncthreads();
    XcdBarrier bar = xcd_barrier_post(p.bar, xbw, tid0);
    const int nb = gridDim.x;
    const int vb = ((nb & 7) == 0) ? (int)(blockIdx.x & 7) * (nb >> 3) + (int)(blockIdx.x >> 3) : (int)blockIdx.x;

    if (blockIdx.x == 0 && tid0 < NE) p.cnt[tid0] = 0;
    phase_rmsnorm(p.x, p.ln_mix_g, p.xn, wid);
    for (int it = vb; it < 28 * 4; it += nb) {
        const int tile = it >> 2, kq = it & 3;
        if (tile < 20) convert_tile<false, DIN>(p.w_in + (size_t)kq * 512 * DIN, tile * 256, tile * 256 + 128, 8, p.img_in + (size_t)tile * 1048576 + (size_t)kq * 8 * 32768, lds, wid);
        else convert_tile<false, D>(p.w_out + (size_t)kq * 512 * D, (tile - 20) * 256, (tile - 20) * 256 + 128, 8, p.img_out + (size_t)(tile - 20) * 1048576 + (size_t)kq * 8 * 32768, lds, wid);
    }
    xcd_barrier(bar, wid * 64 + lane_id());
    { GemmArgs g{}; g.A = p.xn; g.C = p.proj; g.R = (const float*)p.proj2;
      for (int u = vb; u < 32 * 16 + 256; u += nb) {
          if (u < 32 * 16) gemm_tile_img<0>(g, u & 31, u >> 5, 0, 0, T, lds, wid, p.img_in + (size_t)(u >> 5) * 1048576);
          else { const int v = u - 32 * 16, pn = 16 + (v >> 6), pm = v & 31, kh = (v >> 5) & 1;
                 gemm_tile_img<0>(g, pm, pn, 0, 0, T, lds, wid, p.img_in + (size_t)pn * 1048576, kh); } } }
    xcd_barrier(bar, wid * 64 + lane_id());
    phase_mixer(p, lds, wid);
    xcd_barrier(bar, wid * 64 + lane_id());
    { GemmArgs g{}; g.A = p.y; g.C = p.h; g.R = p.x;
      for (int u = vb; u < 32 * 8; u += nb) gemm_tile_img<1>(g, u & 31, u >> 5, 0, 0, T, lds, wid, p.img_out + (size_t)(u >> 5) * 1048576); }
    xcd_barrier(bar, wid * 64 + lane_id());
    phase_router(p, lds, wid);
    xcd_barrier(bar, wid * 64 + lane_id());
    { GemmArgs gu{}; gu.A = p.xn2; gu.B = p.w_gate_up; gu.C = p.act; gu.bias = p.b_gate_up; gu.list = p.list; gu.done = p.done;
      GemmArgs gd{}; gd.A = p.act; gd.B = p.w_down; gd.C = p.outp; gd.bias = p.b_down; gd.done = p.done;
      int u = vb, e = 0, ebase = 0, tbase = 0;
      int ecnt = __builtin_amdgcn_readfirstlane(p.cnt[0]), mt = (ecnt + 255) >> 8;
      for (;;) {
          while (e < NE && u >= tbase + mt * 16) { tbase += mt * 16; ebase += ecnt; ++e; if (e < NE) { ecnt = __builtin_amdgcn_readfirstlane(p.cnt[e]); mt = (ecnt + 255) >> 8; } }
          if (e >= NE) break;
          const int ul = u - tbase;
          gemm_tile<2>(gu, ul % mt, ul / mt, e, ebase, ecnt, lds, wid);
          gu.pend = p.done + e;
          u += nb;
      }
      gd.pend = gu.pend;
      u -= tbase; e = 0; ebase = 0; tbase = 0;
      ecnt = __builtin_amdgcn_readfirstlane(p.cnt[0]); mt = (ecnt + 255) >> 8;
      for (;;) {
          while (e < NE && u >= tbase + mt * 8) { tbase += mt * 8; ebase += ecnt; ++e; if (e < NE) { ecnt = __builtin_amdgcn_readfirstlane(p.cnt[e]); mt = (ecnt + 255) >> 8; } }
          if (e >= NE) break;
          const int ul = u - tbase;
          if (!gd.nowait && !gd.pend) {
              LAS3 int* dec = (LAS3 int*)(lds + LDS_MISC + 64);
              if (wid == 0) { const int l = lane_id();
                  const int dn = (l < NE) ? __hip_atomic_load(p.done + l, __ATOMIC_RELAXED, __HIP_MEMORY_SCOPE_AGENT) : 0;
                  const int nd = (l < NE) ? 16 * ((p.cnt[l] + 255) >> 8) : 0;
                  const float sd = wave_sum((float)dn), sn = wave_sum((float)nd);
                  if (l == 0) { const int ok = (sd >= sn) ? 1 : 0; *dec = ok;
                      if (ok) { __builtin_amdgcn_fence(__ATOMIC_ACQUIRE, "agent"); asm volatile("s_waitcnt vmcnt(0)" ::: "memory"); } } }
              __syncthreads();
              gd.nowait = __builtin_amdgcn_readfirstlane(*dec);
              __syncthreads();
          }
          gemm_tile<3>(gd, ul % mt, ul / mt, e, ebase, ecnt, lds, wid);
          gd.pend = nullptr;
          u += nb;
      }
      if (gd.pend) {
          asm volatile("s_waitcnt vmcnt(0)" ::: "memory"); __syncthreads();
          const int t0 = wid * 64 + lane_id(); if (t0 == 0) __hip_atomic_fetch_add(gd.pend, 1, __ATOMIC_RELAXED, __HIP_MEMORY_SCOPE_AGENT);
      } }
    xcd_barrier(bar, wid * 64 + lane_id());
    phase_final(p, lds, wid);
}
}

extern "C" void kernel_launch(void* const* d_in, const int* in_sizes, int n_in, void* d_out, int out_size, void* d_ws, size_t ws_size,
                              hipStream_t stream) {
    Params p{};
    p.x = (const float*)d_in[0]; p.ln_mix_g = (const float*)d_in[1]; p.w_in = (const float*)d_in[2]; p.conv_w = (const float*)d_in[3];
    p.sgu_ln_g = (const float*)d_in[4]; p.sgu_ln_b = (const float*)d_in[5]; p.sgu_w = (const float*)d_in[6]; p.sgu_b = (const float*)d_in[7];
    p.gn_conv = (const float*)d_in[8]; p.gn_sgu = (const float*)d_in[9]; p.w_out = (const float*)d_in[10]; p.ln_ffn_g = (const float*)d_in[11];
    p.w_router = (const float*)d_in[12]; p.b_router = (const float*)d_in[13]; p.w_gate_up = (const float*)d_in[14]; p.b_gate_up = (const float*)d_in[15];
    p.w_down = (const float*)d_in[16]; p.b_down = (const float*)d_in[17]; p.ln_final_g = (const float*)d_in[18];
    p.out = (float*)d_out;

    char* ws = (char*)d_ws;
    size_t off = 0;
    auto take = [&](size_t bytes) { char* q = ws + off; off += (bytes + 255) & ~(size_t)255; return q; };
    p.bar = (unsigned*)take(XCD_BAR_WORDS * 4 + 256);
    p.done = (int*)(p.bar + XCD_BAR_WORDS);
    p.cnt = (int*)take(256);
    p.list = (int*)take((size_t)NE * T * 4);
    p.sel = (int*)take((size_t)NPAIR * 4);
    p.gates = (float*)take((size_t)NPAIR * 4);
    p.xn = (bf16_t*)take((size_t)T * D * 2);
    p.proj = (bf16_t*)take((size_t)T * DIN * 2);
    p.proj2 = (bf16_t*)take((size_t)T * (DIN - 4096) * 2);
    p.y = (bf16_t*)take((size_t)T * D * 2);
    p.h = (float*)take((size_t)T * D * 4);
    p.xn2 = (bf16_t*)take((size_t)T * D * 2);
    p.act = (bf16_t*)take((size_t)ACT_ROWS * DFF * 2);
    p.outp = (bf16_t*)take((size_t)ACT_ROWS * D * 2);
    p.img_in = (unsigned char*)take((size_t)20 * 1048576);
    p.img_out = (unsigned char*)take((size_t)8 * 1048576);
    if (off > ws_size) { fprintf(stderr, "workspace too small: need %zu have %zu\n", off, ws_size); return; }

    static int grid = 0;
    if (!grid) {
        int dev = 0, cus = 0, per_cu = 0;
        (void)hipGetDevice(&dev);
        (void)hipDeviceGetAttribute(&cus, hipDeviceAttributeMultiprocessorCount, dev);
        (void)hipFuncSetAttribute((const void*)k_mega, hipFuncAttributeMaxDynamicSharedMemorySize, LDS_TOTAL);
        (void)hipOccupancyMaxActiveBlocksPerMultiprocessor(&per_cu, (const void*)k_mega, 512, LDS_TOTAL);
        if (per_cu < 1) { fprintf(stderr, "occupancy query says 0 blocks per CU\n"); per_cu = 1; }
        grid = cus * 1;
    }
    (void)hipMemsetAsync(p.bar, 0, XCD_BAR_WORDS * 4 + 256, stream);
    k_mega<<<grid, 512, LDS_TOTAL, stream>>>(p);
}
```

```cpp
#include <hip/hip_runtime.h>
#include <stdint.h>
#include <stdio.h>

namespace {
constexpr int T = 8192, D = 2048, DIN = 5120, DC = 1024, NE = 32, DFF = 2048, SEQ = 4096;
constexpr int NPAIR = T * 4, ACT_ROWS = NPAIR + 256;
constexpr float EPS = 1e-5f;

#define LAS3 __attribute__((address_space(3)))
typedef short bf16x8 __attribute__((ext_vector_type(8)));
typedef float f32x4 __attribute__((ext_vector_type(4)));
typedef unsigned u32x4 __attribute__((ext_vector_type(4)));
typedef unsigned u32x2 __attribute__((ext_vector_type(2)));
typedef unsigned short bf16_t;

constexpr int GBK = 64, GHTB = 128 * 64 * 2;
constexpr int GEMM_LDS = 8 * GHTB;

__device__ __forceinline__ unsigned cvt_pk_bf16(float lo, float hi) {
    unsigned r; asm("v_cvt_pk_bf16_f32 %0, %1, %2" : "=v"(r) : "v"(lo), "v"(hi)); return r;
}
__device__ __forceinline__ float bf16_lo(unsigned u) { return __uint_as_float(u << 16); }
__device__ __forceinline__ float bf16_hi(unsigned u) { return __uint_as_float(u & 0xffff0000u); }

__device__ __forceinline__ void dma16(const void* sbase, unsigned voff, unsigned lds_dst) {
    unsigned keep;
    asm volatile("s_mov_b32 %0, m0\n\ts_mov_b32 m0, %3\n\ts_nop 2\n\tglobal_load_lds_dwordx4 %1, %2\n\ts_mov_b32 m0, %0"
                 : "=&s"(keep) : "v"(voff), "s"(sbase), "s"(lds_dst) : "memory");
}
#define G_WAIT_V(n) asm volatile("s_waitcnt vmcnt(" #n ")" ::: "memory")
#define G_WAIT_L(n) asm volatile("s_waitcnt lgkmcnt(" #n ")" ::: "memory")
#define G_BAR do { asm volatile("" ::: "memory"); __builtin_amdgcn_s_barrier(); asm volatile("" ::: "memory"); } while (0)
#define G_SCHED __builtin_amdgcn_sched_barrier(0)

template <int LDB, int VAR = 0>
__device__ __forceinline__ void gemm_kloop(f32x4 (&acc)[2][2][4][2], const bf16_t* __restrict__ A, const unsigned (&aoff)[2][2],
                                           const float* __restrict__ B, unsigned boff, int nt, LAS3 char* lds, int tid, int wid, size_t astep = GBK, size_t bstep = (size_t)GBK * LDB) {
    const int lane = tid & 63, wr = wid >> 2, wc = wid & 3, fr = lane & 15, fq = lane >> 4;
    const int c0 = fq ^ (fr >> 1);
    const int a_rd0 = (wr * 64 + fr) * 128 + c0 * 16, a_rd1 = (wr * 64 + fr) * 128 + (c0 ^ 4) * 16;
    const int b_rd0 = (wc * 16 + fr) * 128 + ((c0 ^ (wc & 1)) * 16), b_rd1 = (wc * 16 + fr) * 128 + ((c0 ^ (wc & 1) ^ 4) * 16);
    const int k8 = wid, n4 = tid & 63, bhalf = n4 >> 5, nloc = (n4 & 31) * 4;
    const int sw0 = (((n4 & 3) * 2) & 7) ^ ((n4 >> 2) & 1), sw1 = (((n4 & 3) * 2 + 1) & 7) ^ ((n4 >> 2) & 1);
    const int b_wr0 = (4 + bhalf) * GHTB + nloc * 128 + ((k8 ^ sw0) << 4);
    const int b_wr1 = (4 + bhalf) * GHTB + (nloc + 2) * 128 + ((k8 ^ sw1) << 4);
    const unsigned boffb = boff * 4u;
    const unsigned lds_u = (unsigned)(unsigned long)lds;
    const unsigned bw_a0 = lds_u + (unsigned)b_wr0, bw_a1 = lds_u + (unsigned)b_wr1;
    const int a_dma0 = wid * 1024, a_dma1 = (8 + wid) * 1024;

#define SA_(b, h) (((b) * 2 + (h)) * GHTB)
#define SB_(b, h) ((4 + (b) * 2 + (h)) * GHTB)
#define STAGE_A(b, h, kt) do { const bf16_t* _g = A + (size_t)(kt) * astep; \
        dma16((const void*)_g, aoff[h][0], lds_u + SA_(b, h) + a_dma0); \
        dma16((const void*)_g, aoff[h][1], lds_u + SA_(b, h) + a_dma1); } while (0)
#define BLOAD2(R, kt, j0) asm volatile("s_nop 4\n\tglobal_load_dwordx4 %0, %2, %3\n\tglobal_load_dwordx4 %1, %2, %4" \
        : "=&v"(R[(j0) & 3]), "=&v"(R[((j0) & 3) + 1]) : "v"(boffb), "s"(B + (size_t)(kt) * bstep + (size_t)(j0) * LDB), "s"(B + (size_t)(kt) * bstep + (size_t)((j0) + 1) * LDB) : "memory")
#define BWAIT(R, n) asm volatile("s_waitcnt vmcnt(" #n ")" : "+v"(R[0]), "+v"(R[1]), "+v"(R[2]), "+v"(R[3]) :: "memory")
#define BWRITE_H(R, b, hi) do { _Pragma("unroll") for (int _i = 0; _i < 4; ++_i) { u32x2 _w; \
            _w.x = cvt_pk_bf16(R[0][_i], R[1][_i]); _w.y = cvt_pk_bf16(R[2][_i], R[3][_i]); \
            asm volatile("ds_write_b64 %0, %1 offset:%2" :: "v"((_i < 2) ? bw_a0 : bw_a1), "v"(_w), "n"((b) * 2 * GHTB + (_i & 1) * 128 + (hi) * 8) : "memory"); } } while (0)
#define LDA(dst, b, h) do { _Pragma("unroll") for (int _m = 0; _m < 4; ++_m) { \
        dst[_m][0] = *(LAS3 const bf16x8*)(lds + SA_(b, h) + a_rd0 + _m * 2048); \
        dst[_m][1] = *(LAS3 const bf16x8*)(lds + SA_(b, h) + a_rd1 + _m * 2048); } } while (0)
#define LDB_(dst, b, h) do { _Pragma("unroll") for (int _n = 0; _n < 2; ++_n) { \
        dst[_n][0] = *(LAS3 const bf16x8*)(lds + SB_(b, h) + b_rd0 + _n * 8192); \
        dst[_n][1] = *(LAS3 const bf16x8*)(lds + SB_(b, h) + b_rd1 + _n * 8192); } } while (0)
#define MMA(ai, bj, Af, Bf) do { __builtin_amdgcn_s_setprio(1); \
        _Pragma("unroll") for (int _m = 0; _m < 4; ++_m) _Pragma("unroll") for (int _n = 0; _n < 2; ++_n) _Pragma("unroll") for (int _k = 0; _k < 2; ++_k) \
            acc[ai][bj][_m][_n] = __builtin_amdgcn_mfma_f32_16x16x32_bf16(Bf[_n][_k], Af[_m][_k], acc[ai][bj][_m][_n], 0, 0, 0); \
        __builtin_amdgcn_s_setprio(0); } while (0)

    f32x4 blo[4], bhi[4];
    bf16x8 At[4][2], B0[2][2], B1[2][2];
#pragma unroll
    for (int ai = 0; ai < 2; ++ai)
#pragma unroll
        for (int bj = 0; bj < 2; ++bj)
#pragma unroll
            for (int m = 0; m < 4; ++m)
#pragma unroll
                for (int n = 0; n < 2; ++n) acc[ai][bj][m][n] = (f32x4){0.f, 0.f, 0.f, 0.f};

    __builtin_amdgcn_s_waitcnt(0);
    const int p1 = (1 < nt) ? 1 : 0;
    BLOAD2(blo, 0, 0); BLOAD2(blo, 0, 2); BLOAD2(bhi, 0, 4); BLOAD2(bhi, 0, 6); STAGE_A(0, 0, 0); STAGE_A(0, 1, 0);
    BWAIT(blo, 4); BWAIT(bhi, 4); BWRITE_H(blo, 0, 0); BWRITE_H(bhi, 0, 1);
    BLOAD2(blo, p1, 0); BLOAD2(blo, p1, 2); STAGE_A(1, 0, p1); BLOAD2(bhi, p1, 4);
    G_WAIT_V(2);
    G_WAIT_L(0);
    { int wr1 = wid >> 2; asm volatile("" : "+s"(wr1)); if (wr1 == 1) G_BAR; }
    G_BAR;
    for (int t = 0; t < nt; t += 2) {
        const int t1 = (t + 1 < nt) ? t + 1 : nt - 1, t2 = (t + 2 < nt) ? t + 2 : nt - 1, t3 = (t + 3 < nt) ? t + 3 : nt - 1;
        LDB_(B0, 0, 0); G_SCHED; LDA(At, 0, 0); BLOAD2(bhi, t1, 6); STAGE_A(1, 1, t1);
        G_WAIT_L(8); G_BAR; G_WAIT_L(0); MMA(0, 0, At, B0); G_BAR; G_SCHED;
        LDB_(B1, 0, 1); BWAIT(blo, 8); BWRITE_H(blo, 1, 0); BLOAD2(blo, t2, 0);
        G_BAR; G_WAIT_L(0); MMA(0, 1, At, B1); G_BAR;
        LDA(At, 0, 1); BLOAD2(blo, t2, 2); STAGE_A(0, 0, t2);
        G_BAR; G_WAIT_L(0); MMA(1, 0, At, B0); G_BAR; G_SCHED;
        BWAIT(bhi, 8); BWRITE_H(bhi, 1, 1); BLOAD2(bhi, t2, 4);
        G_WAIT_V(8); G_WAIT_L(0); G_BAR; MMA(1, 1, At, B1); G_BAR;
        LDB_(B0, 1, 0); G_SCHED; LDA(At, 1, 0); BLOAD2(bhi, t2, 6); STAGE_A(0, 1, t2);
        G_WAIT_L(8); G_BAR; G_WAIT_L(0); MMA(0, 0, At, B0); G_BAR; G_SCHED;
        LDB_(B1, 1, 1); BWAIT(blo, 8); BWRITE_H(blo, 0, 0); BLOAD2(blo, t3, 0);
        G_BAR; G_WAIT_L(0); MMA(0, 1, At, B1); G_BAR;
        LDA(At, 1, 1); BLOAD2(blo, t3, 2); STAGE_A(1, 0, t3);
        G_BAR; G_WAIT_L(0); MMA(1, 0, At, B0); G_BAR; G_SCHED;
        BWAIT(bhi, 8); BWRITE_H(bhi, 0, 1); BLOAD2(bhi, t3, 4);
        G_WAIT_V(8); G_WAIT_L(0); G_BAR; MMA(1, 1, At, B1); G_BAR;
    }
    G_WAIT_V(0); G_WAIT_L(0);
    { int wr0 = wid >> 2; asm volatile("" : "+s"(wr0)); if (wr0 == 0) G_BAR; }
    G_BAR;
#undef SA_
#undef SB_
#undef STAGE_A
#undef BLOAD2
#undef BWRITE_H
#undef BWAIT
#undef LDA
#undef LDB_
#undef MMA
}

typedef int v8i32 __attribute__((ext_vector_type(8)));
typedef short v2s16 __attribute__((ext_vector_type(2)));
typedef int i32x4 __attribute__((ext_vector_type(4)));
#ifndef F8_WSCALE
#define F8_WSCALE 0.00390625f
#endif
template <int LDB, int ROWB = 0, int ASTEP = 128>
__device__ __forceinline__ void gemm_kloop_f8(f32x4 (&acc)[2][2][4][2], const unsigned char* __restrict__ A, const unsigned (&aoff)[2][2],
                                              const float* __restrict__ B, unsigned boff, int nt, LAS3 char* lds, int tid, int wid, unsigned char* __restrict__ img, int pam = 1, int pbm = 1) {
    const int lane = tid & 63, wr = wid >> 2, wc = wid & 3, fr = lane & 15, fq = lane >> 4;
    const int c0 = fq ^ (fr >> 1);
    const int a_rd0 = (wr * 64 + fr) * 128 + c0 * 16, a_rd1 = (wr * 64 + fr) * 128 + (c0 ^ 4) * 16;
    const int b_rd0 = (wc * 16 + fr) * 128 + ((c0 ^ (wc & 1)) * 16), b_rd1 = (wc * 16 + fr) * 128 + ((c0 ^ (wc & 1) ^ 4) * 16);
    const int k8 = wid, n4 = tid & 63, bhalf = n4 >> 5, nloc = (n4 & 31) * 4;
    const int sw0 = (((n4 & 3) * 2) & 7) ^ ((n4 >> 2) & 1), sw1 = (((n4 & 3) * 2 + 1) & 7) ^ ((n4 >> 2) & 1);
    const int b_wr0 = (4 + bhalf) * GHTB + nloc * 128 + ((k8 ^ sw0) << 4);
    const int b_wr1 = (4 + bhalf) * GHTB + (nloc + 2) * 128 + ((k8 ^ sw1) << 4);
    const unsigned boffb = boff * 4u;
    const unsigned lds_u = (unsigned)(unsigned long)lds;
    const unsigned bw_a0 = lds_u + (unsigned)b_wr0, bw_a1 = lds_u + (unsigned)b_wr1;
    const int a_dma0 = wid * 1024, a_dma1 = (8 + wid) * 1024;
    const size_t bstep = (size_t)128 * LDB * pbm, astepb = (size_t)ASTEP * pam;
    const unsigned cp_lds = lds_u + 4 * GHTB + (unsigned)wid * 4096u + (unsigned)lane * 16u;
    const unsigned char* cp_g = (const unsigned char*)((uintptr_t)img - (uintptr_t)(lds_u + 4 * GHTB));
    u32x4 cp0, cp1;
#define CPRD(b, h) asm volatile("ds_read_b128 %0, %2 offset:%3\n\tds_read_b128 %1, %2 offset:%4" : "=&v"(cp0), "=&v"(cp1) : "v"(cp_lds), "n"((b) * 2 * GHTB + (h) * 2048), "n"((b) * 2 * GHTB + (h) * 2048 + 1024) : "memory")
#define CPST(tc, h) asm volatile("s_nop 4\n\tglobal_store_dwordx4 %2, %0, %3 sc1\n\tglobal_store_dwordx4 %2, %1, %3 offset:1024 sc1\n\ts_nop 1" :: "v"(cp0), "v"(cp1), "v"(cp_lds), "s"(cp_g + (size_t)(tc) * 32768 + (h) * 2048) : "memory")

#define SA_(b, h) (((b) * 2 + (h)) * GHTB)
#define SB_(b, h) ((4 + (b) * 2 + (h)) * GHTB)
#define STAGE_A(b, h, kt) do { const unsigned char* _g = A + (size_t)(kt) * astepb; \
        dma16((const void*)(_g + (size_t)((h) * 128) * ROWB), ROWB ? aoff[0][0] : aoff[h][0], lds_u + SA_(b, h) + a_dma0); \
        dma16((const void*)(_g + (size_t)((h) * 128 + 64) * ROWB), ROWB ? aoff[0][0] : aoff[h][1], lds_u + SA_(b, h) + a_dma1); } while (0)
#define QLOAD(R, kt, q) do { \
        asm volatile("s_nop 4\n\tglobal_load_dwordx4 %0, %2, %3 nt\n\tglobal_load_dwordx4 %1, %2, %4 nt" : "=&v"(R[0]), "=&v"(R[1]) \
            : "v"(boffb), "s"(B + (size_t)(kt) * bstep + (size_t)(4 * (q)) * LDB), "s"(B + (size_t)(kt) * bstep + (size_t)(4 * (q) + 1) * LDB) : "memory"); \
        asm volatile("s_nop 4\n\tglobal_load_dwordx4 %0, %2, %3 nt\n\tglobal_load_dwordx4 %1, %2, %4 nt" : "=&v"(R[2]), "=&v"(R[3]) \
            : "v"(boffb), "s"(B + (size_t)(kt) * bstep + (size_t)(4 * (q) + 2) * LDB), "s"(B + (size_t)(kt) * bstep + (size_t)(4 * (q) + 3) * LDB) : "memory"); } while (0)
#define QWAIT4(R, n) QWAIT(R, n)
#define QWAIT(R, n) asm volatile("s_waitcnt vmcnt(" #n ")" : "+v"(R[0]), "+v"(R[1]), "+v"(R[2]), "+v"(R[3]) :: "memory")
#define QCVTW(R, b, q) do { _Pragma("unroll") for (int _i = 0; _i < 4; ++_i) { \
            cvd = __builtin_amdgcn_cvt_scalef32_pk_fp8_f32(cvd, R[0][_i], R[1][_i], F8_WSCALE, false); \
            cvd = __builtin_amdgcn_cvt_scalef32_pk_fp8_f32(cvd, R[2][_i], R[3][_i], F8_WSCALE, true); \
            asm volatile("ds_write_b32 %0, %1 offset:%2" :: "v"((_i < 2) ? bw_a0 : bw_a1), "v"(cvd), "n"((b) * 2 * GHTB + (_i & 1) * 128 + (q) * 4) : "memory"); } } while (0)
#define LDA1(dst, b, h, m) do { \
        dst.lo = *(LAS3 const i32x4*)(lds + SA_(b, h) + a_rd0 + (m) * 2048); \
        dst.hi = *(LAS3 const i32x4*)(lds + SA_(b, h) + a_rd1 + (m) * 2048); } while (0)
#define LDB4(dst, b) do { _Pragma("unroll") for (int _h = 0; _h < 2; ++_h) _Pragma("unroll") for (int _n = 0; _n < 2; ++_n) { \
        dst[_h * 2 + _n].lo = *(LAS3 const i32x4*)(lds + SB_(b, _h) + b_rd0 + _n * 8192); \
        dst[_h * 2 + _n].hi = *(LAS3 const i32x4*)(lds + SB_(b, _h) + b_rd1 + _n * 8192); } } while (0)
#define MF4(ai, m, slot) do { _Pragma("unroll") for (int _j = 0; _j < 4; ++_j) \
            acc[ai][_j >> 1][m][_j & 1] = __builtin_amdgcn_mfma_scale_f32_16x16x128_f8f6f4(Bx[_j], slot, acc[ai][_j >> 1][m][_j & 1], 0, 0, 0, 0x7f7f7f77, 1, 0x7f7f7f77); } while (0)
#define MMA16(ai, b, h) do { __builtin_amdgcn_s_setprio(1); MF4(ai, 0, A0); G_SCHED; LDA1(A0, b, h, 2); G_SCHED; MF4(ai, 1, A1); G_SCHED; LDA1(A1, b, h, 3); G_SCHED; \
        G_WAIT_L(2); MF4(ai, 2, A0); G_SCHED; G_WAIT_L(0); MF4(ai, 3, A1); __builtin_amdgcn_s_setprio(0); } while (0)
#define MMA16C(ai, b, h, tc) do { __builtin_amdgcn_s_setprio(1); MF4(ai, 0, A0); G_SCHED; LDA1(A0, b, h, 2); CPRD(b, 0); G_SCHED; MF4(ai, 1, A1); G_SCHED; LDA1(A1, b, h, 3); G_SCHED; \
        G_WAIT_L(2); MF4(ai, 2, A0); G_SCHED; CPST(tc, 0); CPRD(b, 1); G_WAIT_L(2); MF4(ai, 3, A1); G_SCHED; G_WAIT_L(0); CPST(tc, 1); __builtin_amdgcn_s_setprio(0); } while (0)

    f32x4 s0[4], s1[4];
    v2s16 cvd; asm("" : "=v"(cvd));
    v8i32 A0, A1, Bx[4];
#pragma unroll
    for (int ai = 0; ai < 2; ++ai)
#pragma unroll
        for (int bj = 0; bj < 2; ++bj)
#pragma unroll
            for (int m = 0; m < 4; ++m)
#pragma unroll
                for (int n = 0; n < 2; ++n) acc[ai][bj][m][n] = (f32x4){0.f, 0.f, 0.f, 0.f};

    const int p1 = (1 < nt) ? 1 : 0;
    QLOAD(acc[0][0][0], 0, 0); QLOAD(acc[0][0][2], 0, 1); QLOAD(acc[0][1][0], 0, 2); QLOAD(acc[0][1][2], 0, 3);
    STAGE_A(0, 0, 0); STAGE_A(0, 1, 0);
    QLOAD(s0, p1, 0); QLOAD(s1, p1, 1);
    __builtin_amdgcn_s_waitcnt(0);
    QWAIT4(acc[0][0][0], 0); QWAIT4(acc[0][0][2], 0); QWAIT4(acc[0][1][0], 0); QWAIT4(acc[0][1][2], 0); QWAIT(s0, 0); QWAIT(s1, 0);
    QCVTW(acc[0][0][0], 0, 0); QCVTW(acc[0][0][2], 0, 1); QCVTW(acc[0][1][0], 0, 2); QCVTW(acc[0][1][2], 0, 3);
#pragma unroll
    for (int bj = 0; bj < 2; ++bj)
#pragma unroll
        for (int m = 0; m < 4; ++m)
#pragma unroll
            for (int n = 0; n < 2; ++n) acc[0][bj][m][n] = (f32x4){0.f, 0.f, 0.f, 0.f};
    G_WAIT_L(0);
    { int wr1 = wid >> 2; asm volatile("" : "+s"(wr1)); if (wr1 == 1) G_BAR; }
    G_BAR;
#define KTILE(b, tc, tn1, tn2) do { \
          \
        LDB4(Bx, b); G_SCHED; LDA1(A0, b, 0, 0); LDA1(A1, b, 0, 1); \
        QWAIT(s0, 6); QCVTW(s0, (b) ^ 1, 0); QLOAD(s0, tn1, 2); QWAIT(s1, 6); QCVTW(s1, (b) ^ 1, 1); QLOAD(s1, tn1, 3); STAGE_A((b) ^ 1, 0, tn1); \
        G_WAIT_V(10); G_BAR; G_WAIT_L(0); MMA16C(0, b, 0, tc); G_BAR; G_SCHED; \
          \
        LDA1(A0, b, 1, 0); LDA1(A1, b, 1, 1); \
        QWAIT(s0, 10); QCVTW(s0, (b) ^ 1, 2); QLOAD(s0, tn2, 0); QWAIT(s1, 10); QCVTW(s1, (b) ^ 1, 3); QLOAD(s1, tn2, 1); STAGE_A((b) ^ 1, 1, tn1); \
        G_WAIT_V(14); G_WAIT_L(0); G_BAR; MMA16(1, b, 1); G_BAR; G_SCHED; } while (0)
    for (int t = 0; t < nt; t += 2) {
        const int t1 = (t + 1 < nt) ? t + 1 : nt - 1, t2 = (t + 2 < nt) ? t + 2 : nt - 1, t3 = (t + 3 < nt) ? t + 3 : nt - 1;
        KTILE(0, t, t1, t2);
        KTILE(1, t1, t2, t3);
    }
    G_WAIT_V(0); G_WAIT_L(0);
    { int wr0 = wid >> 2; asm volatile("" : "+s"(wr0)); if (wr0 == 0) G_BAR; }
    G_BAR;
#undef KTILE
#undef SA_
#undef SB_
#undef STAGE_A
#undef QLOAD
#undef QWAIT
#undef QCVTW
#undef LDA1
#undef MF4
#undef MMA16
#undef MMA16C
#undef LDB4
#undef QWAIT4
#undef CPRD
#undef CPST
}


__device__ __forceinline__ int lane_id() { int r; asm volatile("v_mbcnt_lo_u32_b32 %0, -1, 0\n\tv_mbcnt_hi_u32_b32 %0, -1, %0" : "=v"(r)); return r; }
#define SWZ_XOR(v, o) __int_as_float(__builtin_amdgcn_ds_swizzle(__float_as_int(v), ((o) << 10) | 0x1F))
__device__ __forceinline__ float half_sum32(float v) {
    v += SWZ_XOR(v, 16); v += SWZ_XOR(v, 8); v += SWZ_XOR(v, 4); v += SWZ_XOR(v, 2); v += SWZ_XOR(v, 1);
    return v;
}
__device__ __forceinline__ float xor32(float v) { const int l = lane_id(); return __int_as_float(__builtin_amdgcn_ds_bpermute((l ^ 32) << 2, __float_as_int(v))); }
__device__ __forceinline__ float wave_sum(float v) { v = half_sum32(v); return v + xor32(v); }
typedef int v8i32d __attribute__((ext_vector_type(8)));
typedef int i32x4d __attribute__((ext_vector_type(4)));
template <bool F8, bool BSW = false, int ROWB = 0, bool ACCUM = false, int ASTEP = 128>
__device__ __forceinline__ void gemm_kloop_dma(f32x4 (&acc)[2][2][4][2], const unsigned char* __restrict__ A, const unsigned (&aoff)[2][2],
                                               const unsigned char* __restrict__ img, int nt, LAS3 char* lds, int tid, int wid, int kbase = 0) {
    constexpr int KMASK = F8 ? 15 : 31;
#define KT_(kt) ((kbase + (kt)) & KMASK)
    const int lane = tid & 63, wr = wid >> 2, wc = wid & 3, fr = lane & 15, fq = lane >> 4;
    const int c0 = fq ^ (fr >> 1);
    const int a_rd0 = (wr * 64 + fr) * 128 + c0 * 16, a_rd1 = (wr * 64 + fr) * 128 + (c0 ^ 4) * 16;
    const int cb = BSW ? (c0 ^ (wc & 1)) : c0;
    const int b_rd0 = (wc * 16 + fr) * 128 + cb * 16, b_rd1 = (wc * 16 + fr) * 128 + (cb ^ 4) * 16;
    const unsigned lds_u = (unsigned)(unsigned long)lds;
    LAS3 const char* ap0 = lds + a_rd0; LAS3 const char* ap1 = lds + a_rd1; LAS3 const char* bp0 = lds + 4 * GHTB + b_rd0; LAS3 const char* bp1 = lds + 4 * GHTB + b_rd1;
    asm volatile("" : "+v"(ap0), "+v"(ap1), "+v"(bp0), "+v"(bp1));
    const int dma0 = wid * 1024, dma1 = (8 + wid) * 1024;
    const unsigned boffl = (unsigned)lane * 16u;

#define SA_(b, h) (((b) * 2 + (h)) * GHTB)
#define SB_(b, h) ((4 + (b) * 2 + (h)) * GHTB)
#define STG_A(b, h, kt) do { const unsigned char* _g = A + (size_t)KT_(kt) * ASTEP; \
        dma16((const void*)(_g + (size_t)((h) * 128) * ROWB), ROWB ? aoff[0][0] : aoff[h][0], lds_u + SA_(b, h) + dma0); \
        dma16((const void*)(_g + (size_t)((h) * 128 + 64) * ROWB), ROWB ? aoff[0][0] : aoff[h][1], lds_u + SA_(b, h) + dma1); } while (0)
#define STG_B(b, h, kt) do { const unsigned char* _g = img + (size_t)KT_(kt) * 32768 + (h) * 16384; \
        dma16((const void*)(_g + dma0), boffl, lds_u + SB_(b, h) + dma0); \
        dma16((const void*)(_g + dma1), boffl, lds_u + SB_(b, h) + dma1); } while (0)
#define LDA_(dst, b, h) do { _Pragma("unroll") for (int _m = 0; _m < 4; ++_m) { \
        dst[_m].lo = *(LAS3 const i32x4d*)(ap0 + SA_(b, h) + _m * 2048); \
        dst[_m].hi = *(LAS3 const i32x4d*)(ap1 + SA_(b, h) + _m * 2048); } } while (0)
#define LDBF(dst, b, h) do { _Pragma("unroll") for (int _n = 0; _n < 2; ++_n) { \
        dst[_n].lo = *(LAS3 const i32x4d*)(bp0 + (SB_(b, h) - 4 * GHTB) + _n * 8192); \
        dst[_n].hi = *(LAS3 const i32x4d*)(bp1 + (SB_(b, h) - 4 * GHTB) + _n * 8192); } } while (0)
#define MMAD(ai, bj, Af, Bf) do { __builtin_amdgcn_s_setprio(1); \
        _Pragma("unroll") for (int _m = 0; _m < 4; ++_m) _Pragma("unroll") for (int _n = 0; _n < 2; ++_n) { \
            if (F8) acc[ai][bj][_m][_n] = __builtin_amdgcn_mfma_scale_f32_16x16x128_f8f6f4(Bf[_n], Af[_m], acc[ai][bj][_m][_n], 0, 0, 0, 0x7f7f7f77, 1, 0x7f7f7f77); \
            else { const i32x4d _bl = Bf[_n].lo, _bh = Bf[_n].hi, _al = Af[_m].lo, _ah = Af[_m].hi;     \
                   acc[ai][bj][_m][_n] = __builtin_amdgcn_mfma_f32_16x16x32_bf16(__builtin_bit_cast(bf16x8, _bl), __builtin_bit_cast(bf16x8, _al), acc[ai][bj][_m][_n], 0, 0, 0); \
                   acc[ai][bj][_m][_n] = __builtin_amdgcn_mfma_f32_16x16x32_bf16(__builtin_bit_cast(bf16x8, _bh), __builtin_bit_cast(bf16x8, _ah), acc[ai][bj][_m][_n], 0, 0, 0); } } \
        __builtin_amdgcn_s_setprio(0); } while (0)

    v8i32d At[4], B0[2], B1[2];
    if (!ACCUM)
#pragma unroll
    for (int ai = 0; ai < 2; ++ai)
#pragma unroll
        for (int bj = 0; bj < 2; ++bj)
#pragma unroll
            for (int m = 0; m < 4; ++m)
#pragma unroll
                for (int n = 0; n < 2; ++n) acc[ai][bj][m][n] = (f32x4){0.f, 0.f, 0.f, 0.f};
    STG_B(0, 0, 0); STG_A(0, 0, 0); STG_B(0, 1, 0); STG_A(0, 1, 0);
    __builtin_amdgcn_s_waitcnt(0);
    { int wr1 = wid >> 2; asm volatile("" : "+s"(wr1)); if (wr1 == 1) G_BAR; }
    G_BAR;
    { const int p1 = (1 < nt) ? 1 : 0; STG_B(1, 0, p1); STG_A(1, 0, p1); STG_B(1, 1, p1); }
    G_WAIT_V(6); G_BAR;
    for (int t = 0; t < nt; t += 2) {
        const int t1 = (t + 1 < nt) ? t + 1 : nt - 1, t2 = (t + 2 < nt) ? t + 2 : nt - 1, t3 = (t + 3 < nt) ? t + 3 : nt - 1;
        LDBF(B0, 0, 0); G_SCHED; LDA_(At, 0, 0); STG_A(1, 1, t1);
        G_WAIT_L(8); G_BAR; G_WAIT_L(0); MMAD(0, 0, At, B0); G_BAR; G_SCHED;
        LDBF(B1, 0, 1); STG_B(0, 0, t2);
        G_BAR; G_WAIT_L(0); MMAD(0, 1, At, B1); G_BAR;
        LDA_(At, 0, 1); STG_A(0, 0, t2);
        G_BAR; G_WAIT_L(0); MMAD(1, 0, At, B0); G_BAR; G_SCHED;
        STG_B(0, 1, t2);
        G_WAIT_V(6); G_BAR; MMAD(1, 1, At, B1); G_BAR;
        LDBF(B0, 1, 0); G_SCHED; LDA_(At, 1, 0); STG_A(0, 1, t2);
        G_WAIT_L(8); G_BAR; G_WAIT_L(0); MMAD(0, 0, At, B0); G_BAR; G_SCHED;
        LDBF(B1, 1, 1); STG_B(1, 0, t3);
        G_BAR; G_WAIT_L(0); MMAD(0, 1, At, B1); G_BAR;
        LDA_(At, 1, 1); STG_A(1, 0, t3);
        G_BAR; G_WAIT_L(0); MMAD(1, 0, At, B0); G_BAR; G_SCHED;
        STG_B(1, 1, t3);
        G_WAIT_V(6); G_BAR; MMAD(1, 1, At, B1); G_BAR;
    }
    G_WAIT_V(0); G_WAIT_L(0);
    { int wr0 = wid >> 2; asm volatile("" : "+s"(wr0)); if (wr0 == 0) G_BAR; }
    G_BAR;
#undef SA_
#undef SB_
#undef STG_A
#undef STG_B
#undef LDA_
#undef LDBF
#undef MMAD
#undef KT_
}

template <bool F8, int LDB>
__device__ __forceinline__ void convert_tile(const float* __restrict__ W, int col0, int col1, int nkt, unsigned char* __restrict__ img, LAS3 char* lds, int wid) {
    constexpr int RPT = F8 ? 16 : 8;
    int lane = lane_id(); asm volatile("" : "+v"(lane));
    const int n4 = lane, half = n4 >> 5, nloc = (n4 & 31) * 4;
    const float* src = W + (size_t)(wid * RPT) * LDB + ((n4 < 32) ? col0 + n4 * 4 : col1 + (n4 - 32) * 4);
    for (int kt = 0; kt < nkt; ++kt) {
        f32x4 r[RPT];
#pragma unroll
        for (int j = 0; j < RPT; ++j) r[j] = *(const f32x4*)(src + (size_t)(kt * (RPT * 8) + j) * LDB);
        LAS3 char* buf = lds + (kt & 1) * 32768;
#pragma unroll
        for (int i = 0; i < 4; ++i) {
            u32x4 w;
            if (F8) {
#pragma unroll
                for (int q = 0; q < 4; ++q) {
                    int d = __builtin_amdgcn_cvt_pk_fp8_f32(r[4 * q][i] * 256.0f, r[4 * q + 1][i] * 256.0f, 0, false);
                    d = __builtin_amdgcn_cvt_pk_fp8_f32(r[4 * q + 2][i] * 256.0f, r[4 * q + 3][i] * 256.0f, d, true);
                    w[q] = (unsigned)d;
                }
            } else {
                w.x = cvt_pk_bf16(r[0][i], r[1][i]); w.y = cvt_pk_bf16(r[2][i], r[3][i]); w.z = cvt_pk_bf16(r[4][i], r[5][i]); w.w = cvt_pk_bf16(r[6][i], r[7][i]);
            }
            const int row = nloc + i;
            *(LAS3 u32x4*)(buf + half * 16384 + row * 128 + ((wid ^ ((row >> 1) & 7)) << 4)) = w;
        }
        __syncthreads();
#pragma unroll
        for (int j = 0; j < 4; ++j) {
            const u32x4 v = *(LAS3 const u32x4*)(buf + wid * 4096 + j * 1024 + lane * 16);
            *(u32x4*)(img + (size_t)kt * 32768 + wid * 4096 + j * 1024 + lane * 16) = v;
        }
    }
    __syncthreads();
}

__device__ __forceinline__ float gelu_exact(float x) { return 0.5f * x * (1.0f + erff(x * 0.70710678118654752f)); }
__device__ __forceinline__ float bf2f(bf16_t v) { return __uint_as_float((unsigned)v << 16); }
__device__ __forceinline__ bf16_t f2bf(float v) { return (bf16_t)(cvt_pk_bf16(v, 0.f) & 0xffffu); }

struct GemmArgs {
    const bf16_t* A; const float* B; const float* bias; const float* R;
    void* C;
    const int* list; const int* cnt;
    int abase;
};

struct TileSync {
    int* flag;
    unsigned* qctr;
    unsigned qtag;
    LAS3 unsigned* qslot;
    int* dep; int depn;
    int* pend;
};

constexpr int EST_BF16 = 528;
constexpr int EST_F8 = 144;
constexpr int LDS_BIAS = 256 * EST_BF16 + 3072;
__device__ __forceinline__ void epi_stage_bf16(const f32x4 (&v)[2][2], int r, int colw, LAS3 char* lds) {
#pragma unroll
    for (int bj = 0; bj < 2; ++bj)
#pragma unroll
        for (int n = 0; n < 2; ++n) { u32x2 o; o.x = cvt_pk_bf16(v[bj][n][0], v[bj][n][1]); o.y = cvt_pk_bf16(v[bj][n][2], v[bj][n][3]);
            *(LAS3 u32x2*)(lds + r * EST_BF16 + (bj * 128 + n * 64 + colw) * 2) = o; }
}
__device__ __forceinline__ void epi_flush_bf16(bf16_t* C, size_t ld, int grow0, int col0, int nvalid, LAS3 char* lds, int tid) {
    __syncthreads();
    const int chunk = tid & 31, r0 = tid >> 5;
#pragma unroll 4
    for (int it = 0; it < 16; ++it) { const int row = it * 16 + r0;
        if (row < nvalid) { const u32x4 q = *(LAS3 const u32x4*)(lds + row * EST_BF16 + chunk * 16); *(u32x4*)(C + ((unsigned)(grow0 + row) * (unsigned)ld + (unsigned)(col0 + chunk * 8))) = q; } }
    __syncthreads();
}
__device__ __forceinline__ void epi_flush_f8(unsigned char* C, size_t ld, int grow0, int col0, int nvalid, LAS3 char* lds, int tid) {
    __syncthreads();
    const int chunk = tid & 7, r0 = tid >> 3;
#pragma unroll
    for (int it = 0; it < 4; ++it) { const int row = it * 64 + r0;
        if (row < nvalid) { const u32x4 q = *(LAS3 const u32x4*)(lds + row * EST_F8 + chunk * 16);
            const unsigned off = ((((unsigned)grow0 >> 8) * (unsigned)(ld >> 7) + ((unsigned)col0 >> 7)) * 256u + (unsigned)row) * 128u + (unsigned)(chunk * 16);
            asm volatile("s_nop 4\n\tglobal_store_dwordx4 %0, %1, %2 sc1\n\ts_nop 1" :: "v"(off), "v"(q), "s"(C) : "memory"); } }
    __syncthreads();
}

constexpr int EST_F8W = 272;
__device__ __forceinline__ void epi_flush_f8w(unsigned char* C, size_t ld, int grow0, int col0, int nvalid, LAS3 char* lds, int tid) {
    __syncthreads();
    const int chunk = tid & 15, r0 = tid >> 4;
#pragma unroll
    for (int it = 0; it < 8; ++it) { const int row = it * 32 + r0;
        if (row < nvalid) { const u32x4 q = *(LAS3 const u32x4*)(lds + row * EST_F8W + chunk * 16);
            const unsigned off = (unsigned)(grow0 + row) * (unsigned)ld + (unsigned)(col0 + chunk * 16);
            asm volatile("s_nop 4\n\tglobal_store_dwordx4 %0, %1, %2 nt\n\ts_nop 1" :: "v"(off), "v"(q), "s"(C) : "memory"); } }
    __syncthreads();
}
template <int EPI, int VAR = 0>
__device__ __forceinline__ void gemm_tile(const GemmArgs& g, int pm, int pn, int e, int ebase, int ecnt, LAS3 char* lds, int wid, unsigned char* img, const TileSync& sy) {
    constexpr int LDB = (EPI == 0) ? DIN : (EPI == 2) ? 2 * DFF : D;
    int tid = wid * 64 + lane_id(); asm volatile("" : "+v"(tid));
    const int lane = tid & 63;
    unsigned aoff[2][2];
#pragma unroll
    for (int h = 0; h < 2; ++h)
#pragma unroll
        for (int i = 0; i < 2; ++i) {
            const int rih = (i * 8 + wid) * 8 + (lane >> 3);
            const int chunk = (lane & 7) ^ ((rih >> 1) & 7);
            int r = pm * 256 + h * 128 + rih;
            unsigned grow;
            if (EPI == 2) { if (r >= ecnt) r = ecnt - 1; grow = (unsigned)(g.list[e * T + r] >> 2); }
            else if (EPI == 3) { grow = (unsigned)(((g.abase >> 8) + pm) * (16 * 256) + h * 128 + rih); }
            else grow = (unsigned)r;
            aoff[h][i] = (EPI == 3) ? (grow * 128u + (unsigned)(chunk * 16)) : (EPI >= 2) ? (grow * (unsigned)D + (unsigned)(chunk * 16)) : (grow * (unsigned)D + (unsigned)(chunk * 8)) * 2u;
        }
    const int k8 = wid, n4 = tid & 63;
    int col;
    if (EPI == 2) col = (n4 < 32) ? pn * 128 + n4 * 4 : DFF + pn * 128 + (n4 - 32) * 4;
    else col = pn * 256 + n4 * 4;
    const unsigned boff = (unsigned)(k8 * ((EPI >= 2) ? 16 : 8)) * (unsigned)LDB + (unsigned)col;
    const float* Bp = g.B;
    if (EPI == 2) Bp += (size_t)e * D * (2 * DFF);
    if (EPI == 3) Bp += (size_t)e * DFF * D;
    if (EPI >= 2 && tid < 256) {
        float bvv;
        if (EPI == 2) bvv = (tid < 128) ? g.bias[(size_t)e * (2 * DFF) + pn * 128 + tid] : g.bias[(size_t)e * (2 * DFF) + DFF + pn * 128 + (tid - 128)] + 1.0f;
        else bvv = g.bias[(size_t)e * D + pn * 256 + tid];
        *(LAS3 float*)(lds + LDS_BIAS + tid * 4) = bvv;
    }
    if (EPI >= 2) {
        if (tid == 0) {
            if (sy.dep) { unsigned sp = 0; while (__hip_atomic_load(sy.dep, __ATOMIC_RELAXED, __HIP_MEMORY_SCOPE_AGENT) < sy.depn) { __builtin_amdgcn_s_sleep(8); if (++sp > (1u << 20)) break; }
                __builtin_amdgcn_fence(__ATOMIC_ACQUIRE, "agent"); asm volatile("s_waitcnt vmcnt(0)" ::: "memory"); } }
        if (sy.dep) __syncthreads();
    }
    f32x4 acc[2][2][4][2];
    if (EPI >= 2) gemm_kloop_f8<LDB, (EPI == 3) ? 128 : 0, (EPI == 3) ? 32768 : 128>(acc, (const unsigned char*)g.A, aoff, Bp, boff, D / 128, lds, tid, wid, img);
    else gemm_kloop<LDB, VAR>(acc, g.A, aoff, Bp, boff, D / GBK, lds, tid, wid);
    int tz = wid * 64 + lane_id(); asm volatile("" : "+v"(tz));
    if (EPI >= 2 && sy.pend && tz == 0) __hip_atomic_fetch_add(sy.pend, 1, __ATOMIC_RELAXED, __HIP_MEMORY_SCOPE_AGENT);
    unsigned nx = 0;
    if (EPI >= 2 && tz == 0) nx = __hip_atomic_fetch_add(sy.qctr, 1u, __ATOMIC_RELAXED, __HIP_MEMORY_SCOPE_AGENT);
    if (EPI >= 2 && tz == 0) __hip_atomic_store(sy.flag, 1, __ATOMIC_RELAXED, __HIP_MEMORY_SCOPE_AGENT);
    const int wid2 = tz >> 6, lane2 = tz & 63;
    const int row0 = (wid2 >> 2) * 64 + (lane2 & 15), colw = (wid2 & 3) * 16 + (lane2 >> 4) * 4;
    if (EPI == 0) {
#pragma unroll
        for (int ai = 0; ai < 2; ++ai)
#pragma unroll
            for (int m = 0; m < 4; ++m) {
                f32x4 v[2][2];
#pragma unroll
                for (int bj = 0; bj < 2; ++bj)
#pragma unroll
                    for (int n = 0; n < 2; ++n) v[bj][n] = acc[ai][bj][m][n];
                epi_stage_bf16(v, ai * 128 + row0 + m * 16, colw, lds);
            }
        epi_flush_bf16((bf16_t*)g.C, DIN, pm * 256, pn * 256, 256, lds, tz);
    } else if (EPI == 1) {
        float* C = (float*)g.C;
#pragma unroll
        for (int ai = 0; ai < 2; ++ai)
#pragma unroll
            for (int m = 0; m < 4; ++m) {
                const size_t ro = (size_t)(pm * 256 + ai * 128 + row0 + m * 16) * D + pn * 256 + colw;
#pragma unroll
                for (int bj = 0; bj < 2; ++bj)
#pragma unroll
                    for (int n = 0; n < 2; ++n) { const f32x4 xr = *(const f32x4*)(g.R + ro + bj * 128 + n * 64);
                        *(f32x4*)(C + ro + bj * 128 + n * 64) = acc[ai][bj][m][n] + xr; }
            }
    } else if (EPI == 2) {
        unsigned char* C = (unsigned char*)g.C;
        f32x4 bgate[2], bup1[2];
#pragma unroll
        for (int n = 0; n < 2; ++n) { bgate[n] = *(LAS3 const f32x4*)(lds + LDS_BIAS + (n * 64 + colw) * 4); bup1[n] = *(LAS3 const f32x4*)(lds + LDS_BIAS + (128 + n * 64 + colw) * 4); }
#pragma unroll
        for (int ai = 0; ai < 2; ++ai)
#pragma unroll
            for (int m = 0; m < 4; ++m) {
                const int r = pm * 256 + ai * 128 + row0 + m * 16;
                {
                    LAS3 char* rp = lds + (ai * 128 + row0 + m * 16) * EST_F8 + colw;
#pragma unroll
                    for (int n = 0; n < 2; ++n) {
                        float o[4];
#pragma unroll
                        for (int j = 0; j < 4; j += 2) {
                            typedef float f32x2 __attribute__((ext_vector_type(2)));
                            f32x2 gt = (f32x2){acc[ai][0][m][n][j], acc[ai][0][m][n][j + 1]} + (f32x2){bgate[n][j], bgate[n][j + 1]};
                            f32x2 up = (f32x2){acc[ai][1][m][n][j], acc[ai][1][m][n][j + 1]} + (f32x2){bup1[n][j], bup1[n][j + 1]};
                            gt.x = fminf(gt.x, 7.0f); gt.y = fminf(gt.y, 7.0f);
                            up.x = __builtin_amdgcn_fmed3f(up.x, -6.0f, 8.0f); up.y = __builtin_amdgcn_fmed3f(up.y, -6.0f, 8.0f);
                            const f32x2 xe = gt * (-2.45546696f);
                            f32x2 ex; ex.x = __builtin_amdgcn_exp2f(xe.x); ex.y = __builtin_amdgcn_exp2f(xe.y);
                            const f32x2 den = ex + 1.0f;
                            f32x2 rc; rc.x = __builtin_amdgcn_rcpf(den.x); rc.y = __builtin_amdgcn_rcpf(den.y);
                            const f32x2 res = (gt * rc) * up;
                            o[j] = res.x; o[j + 1] = res.y;
                        }
                        int w = __builtin_amdgcn_cvt_pk_fp8_f32(o[0], o[1], 0, false);
                        w = __builtin_amdgcn_cvt_pk_fp8_f32(o[2], o[3], w, true);
                        *(LAS3 int*)(rp + n * 64) = w;
                    }
                }
            }
        { const int nv = ecnt - pm * 256; epi_flush_f8(C, DFF, g.abase + pm * 256, pn * 128, nv < 256 ? nv : 256, lds, tz); }
    } else {
        bf16_t* C = (bf16_t*)g.C;
        f32x4 bv[2][2];
#pragma unroll
        for (int bj = 0; bj < 2; ++bj)
#pragma unroll
            for (int n = 0; n < 2; ++n) bv[bj][n] = *(LAS3 const f32x4*)(lds + LDS_BIAS + (bj * 128 + n * 64 + colw) * 4);
#pragma unroll
        for (int ai = 0; ai < 2; ++ai)
#pragma unroll
            for (int m = 0; m < 4; ++m) {
                LAS3 char* rp = lds + (ai * 128 + row0 + m * 16) * EST_F8W + colw;
#pragma unroll
                for (int bj = 0; bj < 2; ++bj)
#pragma unroll
                    for (int n = 0; n < 2; ++n) { const f32x4 v = acc[ai][bj][m][n] + bv[bj][n];
                        int w = __builtin_amdgcn_cvt_pk_fp8_f32(v[0], v[1], 0, false); w = __builtin_amdgcn_cvt_pk_fp8_f32(v[2], v[3], w, true);
                        *(LAS3 int*)(rp + bj * 128 + n * 64) = w; }
            }
        { const int nv = ecnt - pm * 256; epi_flush_f8w((unsigned char*)g.C, D, ebase + pm * 256, pn * 256, nv < 256 ? nv : 256, lds, tz); }
    }
    if (EPI >= 2 && tz == 0) *sy.qslot = sy.qtag | nx;
}


template <int EPI>
__device__ __forceinline__ void gemm_tile_img(const GemmArgs& g, int pm, int pn, int e, int ebase, int ecnt, LAS3 char* lds, int wid, const unsigned char* img, const TileSync& sy, int kh = -1) {
    int tid = wid * 64 + lane_id(); asm volatile("" : "+v"(tid));
    const int lane = tid & 63;
    unsigned aoff[2][2];
#pragma unroll
    for (int h = 0; h < 2; ++h)
#pragma unroll
        for (int i = 0; i < 2; ++i) {
            const int rih = (i * 8 + wid) * 8 + (lane >> 3);
            const int chunk = (lane & 7) ^ ((rih >> 1) & 7);
            int r = pm * 256 + h * 128 + rih;
            unsigned grow;
            if (EPI == 2) { if (r >= ecnt) r = ecnt - 1; grow = (unsigned)(g.list[e * T + r] >> 2); }
            else if (EPI == 3) { grow = (unsigned)(((g.abase >> 8) + pm) * (16 * 256) + h * 128 + rih); }
            else grow = (unsigned)r;
            aoff[h][i] = (EPI == 3) ? (grow * 128u + (unsigned)(chunk * 16)) : (EPI >= 2) ? (grow * (unsigned)D + (unsigned)(chunk * 16)) : (grow * (unsigned)D + (unsigned)(chunk * 8)) * 2u;
        }
    if (EPI >= 2) {
        if (tid < 256) {
            float bvv;
            if (EPI == 2) bvv = (tid < 128) ? g.bias[(size_t)e * (2 * DFF) + pn * 128 + tid] : g.bias[(size_t)e * (2 * DFF) + DFF + pn * 128 + (tid - 128)] + 1.0f;
            else bvv = g.bias[(size_t)e * D + pn * 256 + tid];
            *(LAS3 float*)(lds + LDS_BIAS + tid * 4) = bvv;
        }
        if (tid == 0) {
            unsigned sp = 0; while (__hip_atomic_load(sy.flag, __ATOMIC_RELAXED, __HIP_MEMORY_SCOPE_AGENT) == 0) { __builtin_amdgcn_s_sleep(8); if (++sp > (1u << 20)) break; }
            if (sy.dep) { while (__hip_atomic_load(sy.dep, __ATOMIC_RELAXED, __HIP_MEMORY_SCOPE_AGENT) < sy.depn) { __builtin_amdgcn_s_sleep(8); if (++sp > (1u << 20)) break; } }
            __builtin_amdgcn_fence(__ATOMIC_ACQUIRE, "agent"); asm volatile("s_waitcnt vmcnt(0)" ::: "memory"); }
        __syncthreads();
    }
    f32x4 acc[2][2][4][2];
    gemm_kloop_dma<(EPI >= 2), (EPI >= 2), (EPI == 2) ? 0 : (EPI == 3) ? 128 : 2 * D, false, (EPI == 3) ? 32768 : 128>(acc, (const unsigned char*)g.A, aoff, img, (EPI >= 2) ? D / 128 : (EPI == 0 && kh >= 0) ? D / 128 : D / 64, lds, tid, wid, (EPI == 0 && kh > 0) ? D / 128 : 0);
    int tz = wid * 64 + lane_id(); asm volatile("" : "+v"(tz));
    if (EPI >= 2 && sy.pend && tz == 0) __hip_atomic_fetch_add(sy.pend, 1, __ATOMIC_RELAXED, __HIP_MEMORY_SCOPE_AGENT);
    unsigned nx = 0;
    if (EPI >= 2 && tz == 0) nx = __hip_atomic_fetch_add(sy.qctr, 1u, __ATOMIC_RELAXED, __HIP_MEMORY_SCOPE_AGENT);
    const int wid2 = tz >> 6, lane2 = tz & 63;
    const int row0 = (wid2 >> 2) * 64 + (lane2 & 15), colw = (wid2 & 3) * 16 + (lane2 >> 4) * 4;
    if (EPI == 0) {
#pragma unroll
        for (int ai = 0; ai < 2; ++ai)
#pragma unroll
            for (int m = 0; m < 4; ++m) {
                f32x4 v[2][2];
#pragma unroll
                for (int bj = 0; bj < 2; ++bj)
#pragma unroll
                    for (int n = 0; n < 2; ++n) v[bj][n] = acc[ai][bj][m][n];
                epi_stage_bf16(v, ai * 128 + row0 + m * 16, colw, lds);
            }
        if (kh > 0) epi_flush_bf16((bf16_t*)g.R, DIN - 4096, pm * 256, pn * 256 - 4096, 256, lds, tz);
        else epi_flush_bf16((bf16_t*)g.C, DIN, pm * 256, pn * 256, 256, lds, tz);
    } else if (EPI == 1) {
        float* C = (float*)g.C;
#pragma unroll
        for (int ai = 0; ai < 2; ++ai)
#pragma unroll
            for (int m = 0; m < 4; ++m) {
                const size_t ro = (size_t)(pm * 256 + ai * 128 + row0 + m * 16) * D + pn * 256 + colw;
#pragma unroll
                for (int bj = 0; bj < 2; ++bj)
#pragma unroll
                    for (int n = 0; n < 2; ++n) { const f32x4 xr = *(const f32x4*)(g.R + ro + bj * 128 + n * 64);
                        *(f32x4*)(C + ro + bj * 128 + n * 64) = acc[ai][bj][m][n] + xr; }
            }
    } else if (EPI == 2) {
        unsigned char* C = (unsigned char*)g.C;
        f32x4 bgate[2], bup1[2];
#pragma unroll
        for (int n = 0; n < 2; ++n) { bgate[n] = *(LAS3 const f32x4*)(lds + LDS_BIAS + (n * 64 + colw) * 4); bup1[n] = *(LAS3 const f32x4*)(lds + LDS_BIAS + (128 + n * 64 + colw) * 4); }
#pragma unroll
        for (int ai = 0; ai < 2; ++ai)
#pragma unroll
            for (int m = 0; m < 4; ++m) {
                const int r = pm * 256 + ai * 128 + row0 + m * 16;
                {
                    LAS3 char* rp = lds + (ai * 128 + row0 + m * 16) * EST_F8 + colw;
#pragma unroll
                    for (int n = 0; n < 2; ++n) {
                        float o[4];
#pragma unroll
                        for (int j = 0; j < 4; j += 2) {
                            typedef float f32x2 __attribute__((ext_vector_type(2)));
                            f32x2 gt = (f32x2){acc[ai][0][m][n][j], acc[ai][0][m][n][j + 1]} + (f32x2){bgate[n][j], bgate[n][j + 1]};
                            f32x2 up = (f32x2){acc[ai][1][m][n][j], acc[ai][1][m][n][j + 1]} + (f32x2){bup1[n][j], bup1[n][j + 1]};
                            gt.x = fminf(gt.x, 7.0f); gt.y = fminf(gt.y, 7.0f);
                            up.x = __builtin_amdgcn_fmed3f(up.x, -6.0f, 8.0f); up.y = __builtin_amdgcn_fmed3f(up.y, -6.0f, 8.0f);
                            const f32x2 xe = gt * (-2.45546696f);
                            f32x2 ex; ex.x = __builtin_amdgcn_exp2f(xe.x); ex.y = __builtin_amdgcn_exp2f(xe.y);
                            const f32x2 den = ex + 1.0f;
                            f32x2 rc; rc.x = __builtin_amdgcn_rcpf(den.x); rc.y = __builtin_amdgcn_rcpf(den.y);
                            const f32x2 res = (gt * rc) * up;
                            o[j] = res.x; o[j + 1] = res.y;
                        }
                        int w = __builtin_amdgcn_cvt_pk_fp8_f32(o[0], o[1], 0, false);
                        w = __builtin_amdgcn_cvt_pk_fp8_f32(o[2], o[3], w, true);
                        *(LAS3 int*)(rp + n * 64) = w;
                    }
                }
            }
        { const int nv = ecnt - pm * 256; epi_flush_f8(C, DFF, g.abase + pm * 256, pn * 128, nv < 256 ? nv : 256, lds, tz); }
    } else {
        bf16_t* C = (bf16_t*)g.C;
        f32x4 bv[2][2];
#pragma unroll
        for (int bj = 0; bj < 2; ++bj)
#pragma unroll
            for (int n = 0; n < 2; ++n) bv[bj][n] = *(LAS3 const f32x4*)(lds + LDS_BIAS + (bj * 128 + n * 64 + colw) * 4);
#pragma unroll
        for (int ai = 0; ai < 2; ++ai)
#pragma unroll
            for (int m = 0; m < 4; ++m) {
                LAS3 char* rp = lds + (ai * 128 + row0 + m * 16) * EST_F8W + colw;
#pragma unroll
                for (int bj = 0; bj < 2; ++bj)
#pragma unroll
                    for (int n = 0; n < 2; ++n) { const f32x4 v = acc[ai][bj][m][n] + bv[bj][n];
                        int w = __builtin_amdgcn_cvt_pk_fp8_f32(v[0], v[1], 0, false); w = __builtin_amdgcn_cvt_pk_fp8_f32(v[2], v[3], w, true);
                        *(LAS3 int*)(rp + bj * 128 + n * 64) = w; }
            }
        { const int nv = ecnt - pm * 256; epi_flush_f8w((unsigned char*)g.C, D, ebase + pm * 256, pn * 256, nv < 256 ? nv : 256, lds, tz); }
    }
    if (EPI >= 2 && tz == 0) *sy.qslot = sy.qtag | nx;
}

#define XB_TMO      128
#define XB_XCNT(j)  (256  + 64 * (j))
#define XB_XSUB(j)  (1280 + 64 * (j))
#define XB_XGEN(j)  (2304 + 64 * (j))
#define XB_TOP      3328
#define XB_TOPGEN   3392
#define XCD_BAR_WORDS 3456
#define XB_SPIN_CAP (1u << 18)
#define LAS __attribute__((address_space(3)))

__device__ __forceinline__ unsigned xb_ld(unsigned* p)              { return __hip_atomic_load(p, __ATOMIC_RELAXED, __HIP_MEMORY_SCOPE_AGENT); }
__device__ __forceinline__ unsigned xb_add(unsigned* p, unsigned v) { return __hip_atomic_fetch_add(p, v, __ATOMIC_RELAXED, __HIP_MEMORY_SCOPE_AGENT); }
__device__ __forceinline__ unsigned xb_xcc_id() { return (unsigned)__builtin_amdgcn_s_getreg((3 << 11) | 20) & 0xFu; }
#define XB_SPIN(cond, bar) do { unsigned _sp = 0; while (cond) { __builtin_amdgcn_s_sleep(1); \
    if ((++_sp & 255u) == 0u) { if (xb_ld(&(bar)[XB_TMO])) break; if (_sp > XB_SPIN_CAP) { atomicAdd(&(bar)[XB_TMO], 1u); break; } } } } while (0)

struct XcdBarrier {
    unsigned* bar; unsigned x;
    volatile LAS unsigned* st;
};
__device__ __forceinline__ XcdBarrier xcd_barrier_post(unsigned* bar, volatile LAS unsigned* st, int tid) {
    XcdBarrier b; b.bar = bar; b.x = xb_xcc_id(); b.st = st;
    if (tid == 0) (void)xb_add(&bar[XB_XCNT(b.x)], 1u);
    return b;
}
__device__ __forceinline__ void xcd_barrier_complete(unsigned* bar, unsigned x, unsigned& nloc, unsigned& nx) {
    const unsigned G = gridDim.x * gridDim.y * gridDim.z;
    unsigned sum, cnt, mine, sp = 0u;
    for (;;) {
        sum = 0u; cnt = 0u; mine = 0u;
#pragma unroll
        for (unsigned j = 0; j < 16; ++j) { const unsigned c = xb_ld(&bar[XB_XCNT(j)]); sum += c; cnt += (c > 0u) ? 1u : 0u; mine = (j == x) ? c : mine; }
        if (sum == G) break;
        __builtin_amdgcn_s_sleep(1);
        if ((++sp & 255u) == 0u) { if (xb_ld(&bar[XB_TMO])) break; if (sp > XB_SPIN_CAP) { atomicAdd(&bar[XB_TMO], 1u); break; } }
    }
    nloc = mine > 0u ? mine : 1u; nx = cnt > 0u ? cnt : 1u;
}
__device__ __forceinline__ void xcd_barrier(const XcdBarrier& b, int tid) {
    asm volatile("s_waitcnt vmcnt(0)" ::: "memory");
    __syncthreads();
    if (tid == 0) {
        unsigned* bar = b.bar;
        __builtin_amdgcn_s_waitcnt(0);
        unsigned nloc = b.st[0], nx = b.st[1];
        if (nloc == 0u) { xcd_barrier_complete(bar, b.x, nloc, nx); b.st[0] = nloc; b.st[1] = nx; }
        const unsigned old = xb_add(&bar[XB_XSUB(b.x)], 1u);
        const unsigned gen = old / nloc;
        if (old + 1u == (gen + 1u) * nloc) {
            __builtin_amdgcn_fence(__ATOMIC_RELEASE, "agent");
            asm volatile("s_waitcnt vmcnt(0)" ::: "memory");
            const unsigned og = xb_add(&bar[XB_TOP], 1u);
            const unsigned tg = og / nx;
            if (og + 1u == (tg + 1u) * nx) xb_add(&bar[XB_TOPGEN], 1u);
            else XB_SPIN(xb_ld(&bar[XB_TOPGEN]) == tg, bar);
            __builtin_amdgcn_fence(__ATOMIC_ACQUIRE, "agent");
            xb_add(&bar[XB_XGEN(b.x)], 1u);
            asm volatile("s_waitcnt vmcnt(0)" ::: "memory");
        } else {
            XB_SPIN(xb_ld(&bar[XB_XGEN(b.x)]) == gen, bar);
            __builtin_amdgcn_fence(__ATOMIC_ACQUIRE, "agent");
            asm volatile("s_waitcnt vmcnt(0)" ::: "memory");
        }
    }
    __syncthreads();
}

struct Params {
    const float *x, *ln_mix_g, *w_in, *conv_w, *sgu_ln_g, *sgu_ln_b, *sgu_w, *sgu_b, *gn_conv, *gn_sgu, *w_out, *ln_ffn_g, *w_router, *b_router,
                *w_gate_up, *b_gate_up, *w_down, *b_down, *ln_final_g;
    float* out;
    unsigned* bar; int* cnt; int* list; int* sel; float* gates;
    bf16_t *xn, *proj, *proj2, *y, *xn2, *act, *outp; float* h;
    unsigned char *img_in, *img_out;
    unsigned char *img_gu, *img_dn;
    int* flag;
    unsigned* qctr;
    int* done;
};
constexpr int LDS_MISC = 256 * EST_BF16;
constexpr int LDS_TOTAL = LDS_MISC + 4096;

__device__ __forceinline__ void phase_rmsnorm(const float* __restrict__ x, const float* __restrict__ g, bf16_t* __restrict__ y, int wid) {
    int lane = lane_id(); asm volatile("" : "+v"(lane));
    for (int t = blockIdx.x * 8 + wid; t < T; t += gridDim.x * 8) {
        const float* xr = x + (size_t)t * D;
        f32x4 v[8]; float s = 0.f;
#pragma unroll
        for (int j = 0; j < 8; ++j) { v[j] = *(const f32x4*)(xr + j * 256 + lane * 4); s += v[j][0] * v[j][0] + v[j][1] * v[j][1] + v[j][2] * v[j][2] + v[j][3] * v[j][3]; }
        s = wave_sum(s);
        const float r = rsqrtf(s * (1.0f / D) + EPS);
#pragma unroll
        for (int j = 0; j < 8; ++j) {
            const f32x4 gg = *(const f32x4*)(g + j * 256 + lane * 4);
            u32x2 o; o.x = cvt_pk_bf16(v[j][0] * r * gg[0], v[j][1] * r * gg[1]); o.y = cvt_pk_bf16(v[j][2] * r * gg[2], v[j][3] * r * gg[3]);
            *(u32x2*)(y + (size_t)t * D + j * 256 + lane * 4) = o;
        }
    }
}

__device__ __forceinline__ float gelu_f(float v) {
    const float av = fabsf(v), dd = av * 0.2316418882f + 1.0f;
    const float tt = __builtin_amdgcn_rcpf(dd);
    float q = tt * 0.5307027145f + (-0.7265760135f); q = q * tt + 0.7107068705f; q = q * tt + (-0.142248368f); q = q * tt + 0.127414796f; q = q * tt;
    const float e = __builtin_amdgcn_exp2f((v * v) * (-0.72134752044f));
    const float m = v * (q * e);
    return v < 0.f ? m : v - m;
}
typedef float f32x16 __attribute__((ext_vector_type(16)));

__device__ __forceinline__ void phase_mixer(const Params& p, LAS3 char* lds, int wid) {
    int lane = lane_id(); asm volatile("" : "+v"(lane));
    const int n = lane & 31, kh = lane >> 5;
    const bf16_t* __restrict__ proj = p.proj;
    LAS3 float* stat = (LAS3 float*)(lds + 32768);
    const int nunits = (T / 128) * 16;
    for (int it = 0; it * (int)gridDim.x < nunits; ++it) {
        const int b = blockIdx.x;
        int u = it * gridDim.x + b;
        if (u >= nunits) break;
        int chunk, g;
        if ((gridDim.x & 15) == 0) { chunk = (b >> 4) + (gridDim.x >> 4) * it; g = ((b & 15) + 8 * (it & 1)) & 15; } else { chunk = u >> 4; g = u & 15; }
        const int t0 = chunk * 128;
        if (g < 8) {
            const int c = g * 128 + 2 * lane;
            const int r0 = t0 + 16 * wid;
            const bf16_t* base = proj + (size_t)r0 * DIN + c;
            const float w00 = p.conv_w[c], w01 = p.conv_w[c + 1], w10 = p.conv_w[DC + c], w11 = p.conv_w[DC + c + 1], w20 = p.conv_w[2 * DC + c], w21 = p.conv_w[2 * DC + c + 1];
            const float g0 = p.gn_conv[c], g1 = p.gn_conv[c + 1];
            const bool has_hist = ((r0 % SEQ) != 0);
            float z2a = 0.f, z2b = 0.f, z1a = 0.f, z1b = 0.f;
            if (has_hist) {
                const unsigned c2 = *(const unsigned*)(base - 2 * (ptrdiff_t)DIN + DC), h2 = *(const unsigned*)(base - 2 * (ptrdiff_t)DIN + 2 * DC);
                const unsigned c1 = *(const unsigned*)(base - (ptrdiff_t)DIN + DC), h1 = *(const unsigned*)(base - (ptrdiff_t)DIN + 2 * DC);
                z2a = bf16_lo(c2) * bf16_lo(h2); z2b = bf16_hi(c2) * bf16_hi(h2); z1a = bf16_lo(c1) * bf16_lo(h1); z1b = bf16_hi(c1) * bf16_hi(h1);
            }
#pragma unroll 1
            for (int hb = 0; hb < 16; hb += 8) {
                unsigned bg[8], cg[8], hg[8];
#pragma unroll
                for (int i = 0; i < 8; ++i) { bg[i] = *(const unsigned*)(base + (size_t)(hb + i) * DIN); cg[i] = *(const unsigned*)(base + (size_t)(hb + i) * DIN + DC); hg[i] = *(const unsigned*)(base + (size_t)(hb + i) * DIN + 2 * DC); }
#pragma unroll
                for (int i = 0; i < 8; ++i) {
                    const float z0a = bf16_lo(cg[i]) * bf16_lo(hg[i]), z0b = bf16_hi(cg[i]) * bf16_hi(hg[i]);
                    const float ya = bf16_lo(bg[i]) * (w00 * z2a + w10 * z1a + w20 * z0a);
                    const float yb = bf16_hi(bg[i]) * (w01 * z2b + w11 * z1b + w21 * z0b);
                    z2a = z1a; z2b = z1b; z1a = z0a; z1b = z0b;
                    const float ss = wave_sum(ya * ya + yb * yb);
                    const float rs = rsqrtf(ss * (1.0f / 128.0f) + EPS);
                    *(unsigned*)(p.y + (size_t)(r0 + hb + i) * D + c) = cvt_pk_bf16(ya * rs * g0, yb * rs * g1);
                }
            }
            __syncthreads(); __syncthreads(); __syncthreads();
        } else {
            const int hd = g - 8;
            {
                const int s0 = 16 * wid + 8 * kh;
                const bf16_t* vb = proj + (size_t)(t0 + s0) * DIN + 4096 + hd * 128 + 4 * n;
                const bf16_t* vb2 = p.proj2 + (size_t)(t0 + s0) * (DIN - 4096) + hd * 128 + 4 * n;
                u32x2 raw[8], raw2[8];
#pragma unroll
                for (int j = 0; j < 8; ++j) { raw[j] = *(const u32x2*)(vb + (size_t)j * DIN); raw2[j] = *(const u32x2*)(vb2 + (size_t)j * (DIN - 4096)); }
                const f32x4 lg = *(const f32x4*)(p.sgu_ln_g + hd * 128 + 4 * n), lb = *(const f32x4*)(p.sgu_ln_b + hd * 128 + 4 * n);
                float vn[8][4];
#pragma unroll
                for (int j = 0; j < 8; ++j) {
                    const float a0 = gelu_f(bf16_lo(raw[j].x) + bf16_lo(raw2[j].x)), a1 = gelu_f(bf16_hi(raw[j].x) + bf16_hi(raw2[j].x)), a2 = gelu_f(bf16_lo(raw[j].y) + bf16_lo(raw2[j].y)), a3 = gelu_f(bf16_hi(raw[j].y) + bf16_hi(raw2[j].y));
                    const float mu = half_sum32((a0 + a1) + (a2 + a3)) * (1.0f / 128.0f);
                    const float d0 = a0 - mu, d1 = a1 - mu, d2 = a2 - mu, d3 = a3 - mu;
                    const float rs = rsqrtf(half_sum32((d0 * d0 + d1 * d1) + (d2 * d2 + d3 * d3)) * (1.0f / 128.0f) + EPS);
                    vn[j][0] = d0 * rs * lg[0] + lb[0]; vn[j][1] = d1 * rs * lg[1] + lb[1]; vn[j][2] = d2 * rs * lg[2] + lb[2]; vn[j][3] = d3 * rs * lg[3] + lb[3];
                }
                __syncthreads();
#pragma unroll
                for (int c = 0; c < 4; ++c) {
                    u32x4 f; f.x = cvt_pk_bf16(vn[0][c], vn[1][c]); f.y = cvt_pk_bf16(vn[2][c], vn[3][c]); f.z = cvt_pk_bf16(vn[4][c], vn[5][c]); f.w = cvt_pk_bf16(vn[6][c], vn[7][c]);
                    *(LAS3 u32x4*)(lds + ((wid * 4 + c) * 64 + lane) * 16) = f;
                }
            }
            __syncthreads();
            {
                const int mt = wid >> 1, cp = (wid & 1) * 2;
                const int trow = 32 * mt + n;
                const float* Wr = p.sgu_w + (size_t)hd * 16384 + (size_t)trow * 128 + 8 * kh;
                f32x16 acc0, acc1;
#pragma unroll
                for (int r = 0; r < 16; ++r) { acc0[r] = 0.f; acc1[r] = 0.f; }
                for (int ks = 0; ks <= 2 * mt + 1; ++ks) {
                    const f32x4 wa = *(const f32x4*)(Wr + 16 * ks), wb = *(const f32x4*)(Wr + 16 * ks + 4);
                    const int sb = 16 * ks + 8 * kh;
                    float wv[8] = {wa[0], wa[1], wa[2], wa[3], wb[0], wb[1], wb[2], wb[3]};
#pragma unroll
                    for (int j = 0; j < 8; ++j) wv[j] = (sb + j <= trow) ? wv[j] : 0.f;
                    u32x4 af; af.x = cvt_pk_bf16(wv[0], wv[1]); af.y = cvt_pk_bf16(wv[2], wv[3]); af.z = cvt_pk_bf16(wv[4], wv[5]); af.w = cvt_pk_bf16(wv[6], wv[7]);
                    const u32x4 b0 = *(LAS3 const u32x4*)(lds + ((ks * 4 + cp) * 64 + lane) * 16);
                    const u32x4 b1 = *(LAS3 const u32x4*)(lds + ((ks * 4 + cp + 1) * 64 + lane) * 16);
                    acc0 = __builtin_amdgcn_mfma_f32_32x32x16_bf16(__builtin_bit_cast(bf16x8, af), __builtin_bit_cast(bf16x8, b0), acc0, 0, 0, 0);
                    acc1 = __builtin_amdgcn_mfma_f32_32x32x16_bf16(__builtin_bit_cast(bf16x8, af), __builtin_bit_cast(bf16x8, b1), acc1, 0, 0, 0);
                }
                const bf16_t* ub = proj + (size_t)t0 * DIN + 3072 + hd * 128 + 4 * n + cp;
                float ya[16], yb[16];
#pragma unroll
                for (int r = 0; r < 16; ++r) {
                    const int tt = 32 * mt + (r & 3) + 8 * (r >> 2) + 4 * kh;
                    const unsigned uu = *(const unsigned*)(ub + (size_t)tt * DIN);
                    const float bias = p.sgu_b[hd * 128 + tt];
                    ya[r] = gelu_f(bf16_lo(uu)) * (acc0[r] + bias);
                    yb[r] = gelu_f(bf16_hi(uu)) * (acc1[r] + bias);
                    const float ps = half_sum32(ya[r] * ya[r] + yb[r] * yb[r]);
                    if (n == 0) stat[tt * 2 + (wid & 1)] = ps;
                }
                __syncthreads();
                const float g0 = p.gn_sgu[hd * 128 + 4 * n + cp], g1 = p.gn_sgu[hd * 128 + 4 * n + cp + 1];
#pragma unroll
                for (int r = 0; r < 16; ++r) {
                    const int tt = 32 * mt + (r & 3) + 8 * (r >> 2) + 4 * kh;
                    const float rs = rsqrtf((stat[tt * 2] + stat[tt * 2 + 1]) * (1.0f / 128.0f) + EPS);
                    *(unsigned*)(p.y + (size_t)(t0 + tt) * D + DC + hd * 128 + 4 * n + cp) = cvt_pk_bf16(ya[r] * rs * g0, yb[r] * rs * g1);
                }
            }
        }
    }
}

__device__ __forceinline__ void phase_router(const Params& p, LAS3 char* lds, int wid) {
    LAS3 float* part = (LAS3 float*)lds;
    LAS3 float* ssqp = (LAS3 float*)(lds + 34816);
    LAS3 float* logit = (LAS3 float*)(lds + 36864);
    LAS3 float* rstd = (LAS3 float*)(lds + 41984);
    LAS3 int* lhist = (LAS3 int*)(lds + 42240);
    LAS3 int* gbase = (LAS3 int*)(lds + 42368);
    int lane = lane_id(); asm volatile("" : "+v"(lane));
    const int n = lane & 31, kh = lane >> 5, tid = wid * 64 + lane;
    for (int grp = blockIdx.x; grp < T / 32; grp += gridDim.x) {
        const int t0 = grp * 32;
        __syncthreads();
        if (tid < 32) lhist[tid] = 0;
        {
            const float* hrow = p.h + (size_t)(t0 + n) * D + wid * 256 + 4 * kh;
            const float* grow = p.ln_ffn_g + wid * 256 + 4 * kh;
            const float* wrow = p.w_router + (size_t)(wid * 256 + 4 * kh) * 32 + n;
            f32x16 acc;
#pragma unroll
            for (int r = 0; r < 16; ++r) acc[r] = 0.f;
            float ssq = 0.f;
#pragma unroll 1
            for (int jj = 0; jj < 32; jj += 8) {
                f32x4 hv[8], gv[8];
#pragma unroll
                for (int j = 0; j < 8; ++j) { hv[j] = *(const f32x4*)(hrow + 8 * (jj + j)); gv[j] = *(const f32x4*)(grow + 8 * (jj + j)); }
#pragma unroll
                for (int j = 0; j < 8; ++j)
#pragma unroll
                    for (int i = 0; i < 4; ++i) {
                        const float a = hv[j][i];
                        ssq += a * a;
                        const float bw = wrow[(size_t)(8 * (jj + j) + i) * 32];
                        acc = __builtin_amdgcn_mfma_f32_32x32x2f32(a * gv[j][i], bw, acc, 0, 0, 0);
                    }
            }
            ssq += xor32(ssq);
            if (kh == 0) ssqp[wid * 32 + n] = ssq;
#pragma unroll
            for (int r = 0; r < 16; ++r) part[(wid * 32 + ((r & 3) + 8 * (r >> 2) + 4 * kh)) * 33 + n] = acc[r];
        }
        __syncthreads();
        if (tid < 32) { float s = 0.f;
#pragma unroll
            for (int w = 0; w < 8; ++w) s += ssqp[w * 32 + tid];
            rstd[tid] = rsqrtf(s * (1.0f / D) + EPS); }
        __syncthreads();
#pragma unroll
        for (int i = 0; i < 2; ++i) {
            const int idx = tid + 512 * i, tk = idx >> 5, e = idx & 31;
            float s = 0.f;
#pragma unroll
            for (int w = 0; w < 8; ++w) s += part[(w * 32 + tk) * 33 + e];
            logit[tk * 33 + e] = s * rstd[tk] + p.b_router[e];
        }
        __syncthreads();
        int se[4] = {0, 0, 0, 0}, sl[4] = {0, 0, 0, 0}; float sx[4] = {0.f, 0.f, 0.f, 0.f}; float sden = 1.f;
        if (tid < 32) {
            float v0 = 0.f; sden = 0.f;
#pragma unroll
            for (int k = 0; k < 4; ++k) {
                int bi = 0; float bv = -3.0e38f;
                for (int i = 0; i < 32; ++i) { const float l = logit[tid * 33 + i]; if (l > bv) { bv = l; bi = i; } }
                logit[tid * 33 + bi] = -3.4e38f;
                if (k == 0) v0 = bv;
                sx[k] = __expf(bv - v0); sden += sx[k];
                se[k] = bi; sl[k] = atomicAdd((int*)&lhist[bi], 1);
            }
        }
        __syncthreads();
        if (tid < 32) { const int c = lhist[tid]; gbase[tid] = c ? atomicAdd(&p.cnt[tid], c) : 0; }
        __syncthreads();
        if (tid < 32) {
            const int t = t0 + tid;
            const float inv = 1.0f / sden;
#pragma unroll
            for (int k = 0; k < 4; ++k) {
                const int slot = gbase[se[k]] + sl[k];
                p.gates[t * 4 + k] = sx[k] * inv;
                p.list[se[k] * T + slot] = t * 4 + k;
                p.sel[t * 4 + k] = (se[k] << 16) | slot;
            }
        }
#pragma unroll 1
        for (int q = 0; q < 4; ++q) {
            const int tk = wid * 4 + q;
            const float r = rstd[tk];
            const float* hr = p.h + (size_t)(t0 + tk) * D;
#pragma unroll
            for (int j = 0; j < 8; ++j) {
                const f32x4 hv = *(const f32x4*)(hr + j * 256 + lane * 4), gg = *(const f32x4*)(p.ln_ffn_g + j * 256 + lane * 4);
                int o = __builtin_amdgcn_cvt_pk_fp8_f32(hv[0] * r * gg[0], hv[1] * r * gg[1], 0, false);
                o = __builtin_amdgcn_cvt_pk_fp8_f32(hv[2] * r * gg[2], hv[3] * r * gg[3], o, true);
                *(int*)((unsigned char*)p.xn2 + (size_t)(t0 + tk) * D + j * 256 + lane * 4) = o;
            }
        }
    }
}

__device__ __forceinline__ void phase_final(const Params& p, LAS3 char* lds, int wid) {
    LAS3 int* base = (LAS3 int*)(lds + LDS_MISC + 2048);
    int lane = lane_id(); asm volatile("" : "+v"(lane));
    if (wid == 0 && lane == 0) { int a = 0; for (int i = 0; i < NE; ++i) { base[i] = a; a += p.cnt[i]; } }
    __syncthreads();
    for (int t = blockIdx.x * 8 + wid; t < T; t += gridDim.x * 8) {
        float gk[4]; const unsigned char* op[4];
#pragma unroll
        for (int k = 0; k < 4; ++k) { const int s = p.sel[t * 4 + k]; gk[k] = p.gates[t * 4 + k]; op[k] = (const unsigned char*)p.outp + (size_t)(base[s >> 16] + (s & 0xffff)) * D; }
        f32x4 v[8]; float ss = 0.f;
#pragma unroll
        for (int j = 0; j < 8; ++j) {
            const int c = j * 256 + lane * 4;
            f32x4 a = *(const f32x4*)(p.h + (size_t)t * D + c);
#pragma unroll
            for (int k = 0; k < 4; ++k) { const int o = *(const int*)(op[k] + c);
                typedef float f32x2 __attribute__((ext_vector_type(2)));
                const f32x2 lo = __builtin_amdgcn_cvt_pk_f32_fp8(o, false), hi = __builtin_amdgcn_cvt_pk_f32_fp8(o, true);
                a[0] += gk[k] * lo.x; a[1] += gk[k] * lo.y; a[2] += gk[k] * hi.x; a[3] += gk[k] * hi.y; }
            v[j] = a; ss += a[0] * a[0] + a[1] * a[1] + a[2] * a[2] + a[3] * a[3];
        }
        ss = wave_sum(ss);
        const float r = rsqrtf(ss * (1.0f / D) + EPS);
#pragma unroll
        for (int j = 0; j < 8; ++j) { const int c = j * 256 + lane * 4; const f32x4 gg = *(const f32x4*)(p.ln_final_g + c);
            f32x4 o; o[0] = v[j][0] * r * gg[0]; o[1] = v[j][1] * r * gg[1]; o[2] = v[j][2] * r * gg[2]; o[3] = v[j][3] * r * gg[3];
            *(f32x4*)(p.out + (size_t)t * D + c) = o; }
    }
}

__device__ __forceinline__ void expert_span(const int* cnt, int e, int& ebase, int& ecnt, int& abase) {
    const int l = lane_id();
    const int c = (l < NE) ? cnt[l] : 0;
    ebase = __builtin_amdgcn_readfirstlane((int)wave_sum((l < e) ? (float)c : 0.0f));
    abase = 256 * __builtin_amdgcn_readfirstlane((int)wave_sum((l < e) ? (float)((c + 255) >> 8) : 0.0f));
    ecnt = __builtin_amdgcn_readlane(c, e);
}

#ifndef MOE_MERGED
#define MOE_MERGED 1
#endif
#ifndef MOE_LAG2
#define MOE_LAG2 16
#define MOE_LAG3 16
#endif
__device__ __forceinline__ int wave_imax(int v) {
#define SWZ_XORI(v, o) __builtin_amdgcn_ds_swizzle(v, ((o) << 10) | 0x1F)
    v = max(v, SWZ_XORI(v, 16)); v = max(v, SWZ_XORI(v, 8)); v = max(v, SWZ_XORI(v, 4)); v = max(v, SWZ_XORI(v, 2)); v = max(v, SWZ_XORI(v, 1));
    const int l = lane_id(); return max(v, __builtin_amdgcn_ds_bpermute((l ^ 32) << 2, v));
#undef SWZ_XORI
}
template <int EPI>
__device__ __forceinline__ int* moe_phase(const Params& p, LAS3 char* lds, int wid, int* pend_in) {
    constexpr int NCQ = (EPI == 2) ? 2 : 1, NS = NE * NCQ, NCOL = NCQ * 8, MOE_LAG = (EPI == 2) ? MOE_LAG2 : MOE_LAG3;
    unsigned* qctr = p.qctr + ((EPI == 2) ? 0 : 8);
    LAS3 unsigned* slot = (LAS3 unsigned*)(lds + LDS_MISC + 64);
    constexpr int NSL = NS + MOE_LAG;
    LAS3 int* pre = (LAS3 int*)(lds + LDS_MISC + 256);
    LAS3 int* mtv = (LAS3 int*)(lds + LDS_MISC + 768);
    static_assert(NSL + 1 <= 128, "prefix table size");
    __syncthreads();
    { const int t0 = wid * 64 + lane_id(); if (t0 < NE) mtv[t0] = (p.cnt[t0] + 255) >> 8; }
    __syncthreads();
    { const int t0 = wid * 64 + lane_id();
      if (t0 == 0) { int a = 0;
          for (int s = 0; s <= NSL; ++s) { pre[s] = a;
              if (s < NSL) { int nv = (s < NS && mtv[s / NCQ] > 0) ? 1 : 0; const int sc = s - MOE_LAG;
                  if (sc >= 0 && sc < NS) { const int m = mtv[sc / NCQ]; nv += (m > 1) ? m - 1 : 0; }
                  a += nv; } } } }
    __syncthreads();
    const int total = __builtin_amdgcn_readfirstlane(pre[NSL]);
    const int q0 = (int)(xb_xcc_id() & 7u);
    GemmArgs g{};
    if (EPI == 2) { g.A = p.xn2; g.B = p.w_gate_up; g.C = p.act; g.bias = p.b_gate_up; g.list = p.list; }
    else { g.A = p.act; g.B = p.w_down; g.C = p.outp; g.bias = p.b_down; }
    __syncthreads();
    { const int t0 = wid * 64 + lane_id(); if (t0 == 0) slot[0] = ((unsigned)q0 << 20) | __hip_atomic_fetch_add(&qctr[q0], 1u, __ATOMIC_RELAXED, __HIP_MEMORY_SCOPE_AGENT); }
    int* pend = pend_in;
    int par = 0;
    for (;;) {
        __syncthreads();
        const unsigned code = (unsigned)__builtin_amdgcn_readfirstlane((int)slot[par]);
        if (code == 0xFFFFFFFFu) break;
        const int qq = (int)(code >> 20), i = (int)(code & 0xFFFFFu);
        bool ran = false;
        if (i < total) {
            int s, j;
            { const int l = lane_id();
              const bool c1 = (l + 1 <= NSL) && (pre[(l + 1 <= NSL) ? l + 1 : 0] <= i), c2 = (l + 65 <= NSL) && (pre[(l + 65 <= NSL) ? l + 65 : 0] <= i);
              s = __builtin_popcountll(__builtin_amdgcn_ballot_w64(c1)) + __builtin_popcountll(__builtin_amdgcn_ballot_w64(c2));
              j = i - __builtin_amdgcn_readfirstlane(pre[s]); }
            const bool hasP = (s < NS) && (__builtin_amdgcn_readfirstlane(mtv[(s < NS) ? s / NCQ : 0]) > 0);
            const int k = (hasP && j == 0) ? 0 : j + (hasP ? 0 : 1);
            const int sl = (k == 0) ? s : s - MOE_LAG;
            if (sl >= 0 && sl < NS) {
                const int e = sl / NCQ, pn = qq + 8 * (sl % NCQ);
                int ebase, ecnt, abase; expert_span(p.cnt, e, ebase, ecnt, abase); g.abase = abase;
                if (k < ((ecnt + 255) >> 8)) {
                    TileSync sy{}; sy.flag = p.flag + ((EPI == 2) ? 0 : NE * 16) + e * NCOL + pn; sy.qctr = qctr + qq; sy.qtag = (unsigned)qq << 20; sy.qslot = slot + (par ^ 1);
                    if (MOE_MERGED) { sy.pend = pend; if (EPI == 3) { sy.dep = p.done + e * 32 + k; sy.depn = 16; } }
                    unsigned char* img = ((EPI == 2) ? p.img_gu : p.img_dn) + (size_t)(e * NCOL + pn) * 524288;
                    if (k == 0) gemm_tile<EPI>(g, 0, pn, e, ebase, ecnt, lds, wid, img, sy);
                    else gemm_tile_img<EPI>(g, k, pn, e, ebase, ecnt, lds, wid, img, sy);
                    pend = (MOE_MERGED && EPI == 2) ? p.done + e * 32 + k : nullptr;
                    ran = true;
                }
            }
            if (!ran) { const int t0 = wid * 64 + lane_id();
                if (t0 == 0) slot[par ^ 1] = ((unsigned)qq << 20) | __hip_atomic_fetch_add(&qctr[qq], 1u, __ATOMIC_RELAXED, __HIP_MEMORY_SCOPE_AGENT); }
        } else {
            const int t0 = wid * 64 + lane_id();
            if (t0 == 0) { unsigned cv[8];
                unsigned qx; asm volatile("s_getreg_b32 %0, hwreg(HW_REG_XCC_ID, 0, 3)" : "=s"(qx));
#pragma unroll
                for (int d = 0; d < 8; ++d) cv[d] = __hip_atomic_load(&qctr[(qx + d) & 7u], __ATOMIC_RELAXED, __HIP_MEMORY_SCOPE_AGENT);
                unsigned c = 0xFFFFFFFFu;
#pragma unroll
                for (int d = 7; d >= 0; --d) if (cv[d] < (unsigned)total) c = (qx + d) & 7u;
                if (c != 0xFFFFFFFFu) c = (c << 20) | __hip_atomic_fetch_add(&qctr[c], 1u, __ATOMIC_RELAXED, __HIP_MEMORY_SCOPE_AGENT);
                slot[par ^ 1] = c; }
        }
        par ^= 1;
    }
    return pend;
}

__global__ void __launch_bounds__(512, 2) k_mega(Params p) {
    extern __shared__ __attribute__((aligned(16))) char smem[];
    LAS3 char* lds = (LAS3 char*)smem;
    volatile LAS unsigned* xbw = (volatile LAS unsigned*)(lds + LDS_MISC);
    int wid = __builtin_amdgcn_readfirstlane((int)(threadIdx.x >> 6)); asm volatile("" : "+s"(wid));
    const int tid0 = wid * 64 + lane_id();
    if (tid0 == 0) { xbw[0] = 0u; xbw[1] = 0u; xbw[2] = 0u; xbw[3] = 0u; }
    __syncthreads();
    XcdBarrier bar = xcd_barrier_post(p.bar, xbw, tid0);
    const int nb = gridDim.x;
    const int vb = ((nb & 7) == 0) ? (int)(blockIdx.x & 7) * (nb >> 3) + (int)(blockIdx.x >> 3) : (int)blockIdx.x;

    if (blockIdx.x == 0 && tid0 < NE) p.cnt[tid0] = 0;
    phase_rmsnorm(p.x, p.ln_mix_g, p.xn, wid);
    for (int it = vb; it < 28 * 4; it += nb) {
        const int tile = it >> 2, kq = it & 3;
        if (tile < 20) convert_tile<false, DIN>(p.w_in + (size_t)kq * 512 * DIN, tile * 256, tile * 256 + 128, 8, p.img_in + (size_t)tile * 1048576 + (size_t)kq * 8 * 32768, lds, wid);
        else convert_tile<false, D>(p.w_out + (size_t)kq * 512 * D, (tile - 20) * 256, (tile - 20) * 256 + 128, 8, p.img_out + (size_t)(tile - 20) * 1048576 + (size_t)kq * 8 * 32768, lds, wid);
    }
    xcd_barrier(bar, wid * 64 + lane_id());
    { GemmArgs g{}; g.A = p.xn; g.C = p.proj; g.R = (const float*)p.proj2;
      for (int u = vb; u < 32 * 16 + 256; u += nb) {
          if (u < 32 * 16) gemm_tile_img<0>(g, u & 31, u >> 5, 0, 0, T, lds, wid, p.img_in + (size_t)(u >> 5) * 1048576, TileSync{});
          else { const int v = u - 32 * 16, pn = 16 + (v >> 6), pm = v & 31, kh = (v >> 5) & 1;
                 gemm_tile_img<0>(g, pm, pn, 0, 0, T, lds, wid, p.img_in + (size_t)pn * 1048576, TileSync{}, kh); } } }
    xcd_barrier(bar, wid * 64 + lane_id());
    phase_mixer(p, lds, wid);
    xcd_barrier(bar, wid * 64 + lane_id());
    { GemmArgs g{}; g.A = p.y; g.C = p.h; g.R = p.x;
      for (int u = vb; u < 32 * 8; u += nb) gemm_tile_img<1>(g, u & 31, u >> 5, 0, 0, T, lds, wid, p.img_out + (size_t)(u >> 5) * 1048576, TileSync{}); }
    xcd_barrier(bar, wid * 64 + lane_id());
    phase_router(p, lds, wid);
    xcd_barrier(bar, wid * 64 + lane_id());
    { int* pend = moe_phase<2>(p, lds, wid, nullptr);
      if (pend) {
          asm volatile("s_waitcnt vmcnt(0)" ::: "memory"); __syncthreads();
          const int t0 = wid * 64 + lane_id(); if (t0 == 0) __hip_atomic_fetch_add(pend, 1, __ATOMIC_RELAXED, __HIP_MEMORY_SCOPE_AGENT); }
      if (!MOE_MERGED) xcd_barrier(bar, wid * 64 + lane_id());
      (void)moe_phase<3>(p, lds, wid, nullptr); }
    xcd_barrier(bar, wid * 64 + lane_id());
    phase_final(p, lds, wid);
}
}

extern "C" void kernel_launch(void* const* d_in, const int* in_sizes, int n_in, void* d_out, int out_size, void* d_ws, size_t ws_size,
                              hipStream_t stream) {
    Params p{};
    p.x = (const float*)d_in[0]; p.ln_mix_g = (const float*)d_in[1]; p.w_in = (const float*)d_in[2]; p.conv_w = (const float*)d_in[3];
    p.sgu_ln_g = (const float*)d_in[4]; p.sgu_ln_b = (const float*)d_in[5]; p.sgu_w = (const float*)d_in[6]; p.sgu_b = (const float*)d_in[7];
    p.gn_conv = (const float*)d_in[8]; p.gn_sgu = (const float*)d_in[9]; p.w_out = (const float*)d_in[10]; p.ln_ffn_g = (const float*)d_in[11];
    p.w_router = (const float*)d_in[12]; p.b_router = (const float*)d_in[13]; p.w_gate_up = (const float*)d_in[14]; p.b_gate_up = (const float*)d_in[15];
    p.w_down = (const float*)d_in[16]; p.b_down = (const float*)d_in[17]; p.ln_final_g = (const float*)d_in[18];
    p.out = (float*)d_out;

    char* ws = (char*)d_ws;
    size_t off = 0;
    auto take = [&](size_t bytes) { char* q = ws + off; off += (bytes + 255) & ~(size_t)255; return q; };
    constexpr int SYNC_WORDS = XCD_BAR_WORDS + NE * 24 + 64 + NE * 32;
    p.bar = (unsigned*)take(SYNC_WORDS * 4);
    p.flag = (int*)(p.bar + XCD_BAR_WORDS); p.qctr = p.bar + XCD_BAR_WORDS + NE * 24; p.done = (int*)(p.bar + XCD_BAR_WORDS + NE * 24 + 64);
    p.cnt = (int*)take(256);
    p.list = (int*)take((size_t)NE * T * 4);
    p.sel = (int*)take((size_t)NPAIR * 4);
    p.gates = (float*)take((size_t)NPAIR * 4);
    p.xn = (bf16_t*)take((size_t)T * D * 2);
    p.proj = (bf16_t*)take((size_t)T * DIN * 2);
    p.proj2 = (bf16_t*)take((size_t)T * (DIN - 4096) * 2);
    p.y = (bf16_t*)take((size_t)T * D * 2);
    p.h = (float*)take((size_t)T * D * 4);
    p.xn2 = (bf16_t*)take((size_t)T * D * 2);
    p.act = (bf16_t*)take((size_t)(ACT_ROWS + NE * 256) * DFF * 2);
    p.outp = (bf16_t*)take((size_t)ACT_ROWS * D * 2);
    p.img_in = (unsigned char*)take((size_t)20 * 1048576);
    p.img_out = (unsigned char*)take((size_t)8 * 1048576);
    p.img_gu = (unsigned char*)take((size_t)NE * 16 * 524288);
    p.img_dn = (unsigned char*)take((size_t)NE * 8 * 524288);
    if (off > ws_size) { fprintf(stderr, "workspace too small: need %zu have %zu\n", off, ws_size); return; }

    static int grid = 0;
    if (!grid) {
        int dev = 0, cus = 0, per_cu = 0;
        (void)hipGetDevice(&dev);
        (void)hipDeviceGetAttribute(&cus, hipDeviceAttributeMultiprocessorCount, dev);
        (void)hipFuncSetAttribute((const void*)k_mega, hipFuncAttributeMaxDynamicSharedMemorySize, LDS_TOTAL);
        (void)hipOccupancyMaxActiveBlocksPerMultiprocessor(&per_cu, (const void*)k_mega, 512, LDS_TOTAL);
        if (per_cu < 1) { fprintf(stderr, "occupancy query says 0 blocks per CU\n"); per_cu = 1; }
        grid = cus * 1;
    }
    (void)hipMemsetAsync(p.bar, 0, SYNC_WORDS * 4, stream);
    k_mega<<<grid, 512, LDS_TOTAL, stream>>>(p);
}
```

```cpp
#include <hip/hip_runtime.h>
#include <stdint.h>
#include <stdio.h>

namespace {
constexpr int T = 8192, D = 2048, DIN = 5120, DC = 1024, NE = 32, DFF = 2048, SEQ = 4096;
constexpr int NPAIR = T * 4, ACT_ROWS = NPAIR + 256;
constexpr float EPS = 1e-5f;

#define LAS3 __attribute__((address_space(3)))
typedef short bf16x8 __attribute__((ext_vector_type(8)));
typedef float f32x4 __attribute__((ext_vector_type(4)));
typedef unsigned u32x4 __attribute__((ext_vector_type(4)));
typedef unsigned u32x2 __attribute__((ext_vector_type(2)));
typedef unsigned short bf16_t;

constexpr int GBK = 64, GHTB = 128 * 64 * 2;
constexpr int GEMM_LDS = 8 * GHTB;

__device__ __forceinline__ unsigned cvt_pk_bf16(float lo, float hi) {
    unsigned r; asm("v_cvt_pk_bf16_f32 %0, %1, %2" : "=v"(r) : "v"(lo), "v"(hi)); return r;
}
__device__ __forceinline__ float bf16_lo(unsigned u) { return __uint_as_float(u << 16); }
__device__ __forceinline__ float bf16_hi(unsigned u) { return __uint_as_float(u & 0xffff0000u); }

__device__ __forceinline__ void dma16(const void* sbase, unsigned voff, unsigned lds_dst) {
    unsigned keep;
    asm volatile("s_mov_b32 %0, m0\n\ts_mov_b32 m0, %3\n\ts_nop 2\n\tglobal_load_lds_dwordx4 %1, %2\n\ts_mov_b32 m0, %0"
                 : "=&s"(keep) : "v"(voff), "s"(sbase), "s"(lds_dst) : "memory");
}
#define G_WAIT_V(n) asm volatile("s_waitcnt vmcnt(" #n ")" ::: "memory")
#define G_WAIT_L(n) asm volatile("s_waitcnt lgkmcnt(" #n ")" ::: "memory")
#define G_BAR do { asm volatile("" ::: "memory"); __builtin_amdgcn_s_barrier(); asm volatile("" ::: "memory"); } while (0)
#define G_SCHED __builtin_amdgcn_sched_barrier(0)

template <int LDB, int VAR = 0>
__device__ __forceinline__ void gemm_kloop(f32x4 (&acc)[2][2][4][2], const bf16_t* __restrict__ A, const unsigned (&aoff)[2][2],
                                           const float* __restrict__ B, unsigned boff, int nt, LAS3 char* lds, int tid, int wid, size_t astep = GBK, size_t bstep = (size_t)GBK * LDB) {
    const int lane = tid & 63, wr = wid >> 2, wc = wid & 3, fr = lane & 15, fq = lane >> 4;
    const int c0 = fq ^ (fr >> 1);
    const int a_rd0 = (wr * 64 + fr) * 128 + c0 * 16, a_rd1 = (wr * 64 + fr) * 128 + (c0 ^ 4) * 16;
    const int b_rd0 = (wc * 16 + fr) * 128 + ((c0 ^ (wc & 1)) * 16), b_rd1 = (wc * 16 + fr) * 128 + ((c0 ^ (wc & 1) ^ 4) * 16);
    const int k8 = wid, n4 = tid & 63, bhalf = n4 >> 5, nloc = (n4 & 31) * 4;
    const int sw0 = (((n4 & 3) * 2) & 7) ^ ((n4 >> 2) & 1), sw1 = (((n4 & 3) * 2 + 1) & 7) ^ ((n4 >> 2) & 1);
    const int b_wr0 = (4 + bhalf) * GHTB + nloc * 128 + ((k8 ^ sw0) << 4);
    const int b_wr1 = (4 + bhalf) * GHTB + (nloc + 2) * 128 + ((k8 ^ sw1) << 4);
    const unsigned boffb = boff * 4u;
    const unsigned lds_u = (unsigned)(unsigned long)lds;
    const unsigned bw_a0 = lds_u + (unsigned)b_wr0, bw_a1 = lds_u + (unsigned)b_wr1;
    const int a_dma0 = wid * 1024, a_dma1 = (8 + wid) * 1024;

#define SA_(b, h) (((b) * 2 + (h)) * GHTB)
#define SB_(b, h) ((4 + (b) * 2 + (h)) * GHTB)
#define STAGE_A(b, h, kt) do { const bf16_t* _g = A + (size_t)(kt) * astep; \
        dma16((const void*)_g, aoff[h][0], lds_u + SA_(b, h) + a_dma0); \
        dma16((const void*)_g, aoff[h][1], lds_u + SA_(b, h) + a_dma1); } while (0)
#define BLOAD2(R, kt, j0) asm volatile("s_nop 4\n\tglobal_load_dwordx4 %0, %2, %3\n\tglobal_load_dwordx4 %1, %2, %4" \
        : "=&v"(R[(j0) & 3]), "=&v"(R[((j0) & 3) + 1]) : "v"(boffb), "s"(B + (size_t)(kt) * bstep + (size_t)(j0) * LDB), "s"(B + (size_t)(kt) * bstep + (size_t)((j0) + 1) * LDB) : "memory")
#define BWAIT(R, n) asm volatile("s_waitcnt vmcnt(" #n ")" : "+v"(R[0]), "+v"(R[1]), "+v"(R[2]), "+v"(R[3]) :: "memory")
#define BWRITE_H(R, b, hi) do { _Pragma("unroll") for (int _i = 0; _i < 4; ++_i) { u32x2 _w; \
            _w.x = cvt_pk_bf16(R[0][_i], R[1][_i]); _w.y = cvt_pk_bf16(R[2][_i], R[3][_i]); \
            asm volatile("ds_write_b64 %0, %1 offset:%2" :: "v"((_i < 2) ? bw_a0 : bw_a1), "v"(_w), "n"((b) * 2 * GHTB + (_i & 1) * 128 + (hi) * 8) : "memory"); } } while (0)
#define LDA(dst, b, h) do { _Pragma("unroll") for (int _m = 0; _m < 4; ++_m) { \
        dst[_m][0] = *(LAS3 const bf16x8*)(lds + SA_(b, h) + a_rd0 + _m * 2048); \
        dst[_m][1] = *(LAS3 const bf16x8*)(lds + SA_(b, h) + a_rd1 + _m * 2048); } } while (0)
#define LDB_(dst, b, h) do { _Pragma("unroll") for (int _n = 0; _n < 2; ++_n) { \
        dst[_n][0] = *(LAS3 const bf16x8*)(lds + SB_(b, h) + b_rd0 + _n * 8192); \
        dst[_n][1] = *(LAS3 const bf16x8*)(lds + SB_(b, h) + b_rd1 + _n * 8192); } } while (0)
#define MMA(ai, bj, Af, Bf) do { __builtin_amdgcn_s_setprio(1); \
        _Pragma("unroll") for (int _m = 0; _m < 4; ++_m) _Pragma("unroll") for (int _n = 0; _n < 2; ++_n) _Pragma("unroll") for (int _k = 0; _k < 2; ++_k) \
            acc[ai][bj][_m][_n] = __builtin_amdgcn_mfma_f32_16x16x32_bf16(Bf[_n][_k], Af[_m][_k], acc[ai][bj][_m][_n], 0, 0, 0); \
        __builtin_amdgcn_s_setprio(0); } while (0)

    f32x4 blo[4], bhi[4];
    bf16x8 At[4][2], B0[2][2], B1[2][2];
#pragma unroll
    for (int ai = 0; ai < 2; ++ai)
#pragma unroll
        for (int bj = 0; bj < 2; ++bj)
#pragma unroll
            for (int m = 0; m < 4; ++m)
#pragma unroll
                for (int n = 0; n < 2; ++n) acc[ai][bj][m][n] = (f32x4){0.f, 0.f, 0.f, 0.f};

    __builtin_amdgcn_s_waitcnt(0);
    const int p1 = (1 < nt) ? 1 : 0;
    BLOAD2(blo, 0, 0); BLOAD2(blo, 0, 2); BLOAD2(bhi, 0, 4); BLOAD2(bhi, 0, 6); STAGE_A(0, 0, 0); STAGE_A(0, 1, 0);
    BWAIT(blo, 4); BWAIT(bhi, 4); BWRITE_H(blo, 0, 0); BWRITE_H(bhi, 0, 1);
    BLOAD2(blo, p1, 0); BLOAD2(blo, p1, 2); STAGE_A(1, 0, p1); BLOAD2(bhi, p1, 4);
    G_WAIT_V(2);
    G_WAIT_L(0);
    { int wr1 = wid >> 2; asm volatile("" : "+s"(wr1)); if (wr1 == 1) G_BAR; }
    G_BAR;
    for (int t = 0; t < nt; t += 2) {
        const int t1 = (t + 1 < nt) ? t + 1 : nt - 1, t2 = (t + 2 < nt) ? t + 2 : nt - 1, t3 = (t + 3 < nt) ? t + 3 : nt - 1;
        LDB_(B0, 0, 0); G_SCHED; LDA(At, 0, 0); BLOAD2(bhi, t1, 6); STAGE_A(1, 1, t1);
        G_WAIT_L(8); G_BAR; G_WAIT_L(0); MMA(0, 0, At, B0); G_BAR; G_SCHED;
        LDB_(B1, 0, 1); BWAIT(blo, 8); BWRITE_H(blo, 1, 0); BLOAD2(blo, t2, 0);
        G_BAR; G_WAIT_L(0); MMA(0, 1, At, B1); G_BAR;
        LDA(At, 0, 1); BLOAD2(blo, t2, 2); STAGE_A(0, 0, t2);
        G_BAR; G_WAIT_L(0); MMA(1, 0, At, B0); G_BAR; G_SCHED;
        BWAIT(bhi, 8); BWRITE_H(bhi, 1, 1); BLOAD2(bhi, t2, 4);
        G_WAIT_V(8); G_WAIT_L(0); G_BAR; MMA(1, 1, At, B1); G_BAR;
        LDB_(B0, 1, 0); G_SCHED; LDA(At, 1, 0); BLOAD2(bhi, t2, 6); STAGE_A(0, 1, t2);
        G_WAIT_L(8); G_BAR; G_WAIT_L(0); MMA(0, 0, At, B0); G_BAR; G_SCHED;
        LDB_(B1, 1, 1); BWAIT(blo, 8); BWRITE_H(blo, 0, 0); BLOAD2(blo, t3, 0);
        G_BAR; G_WAIT_L(0); MMA(0, 1, At, B1); G_BAR;
        LDA(At, 1, 1); BLOAD2(blo, t3, 2); STAGE_A(1, 0, t3);
        G_BAR; G_WAIT_L(0); MMA(1, 0, At, B0); G_BAR; G_SCHED;
        BWAIT(bhi, 8); BWRITE_H(bhi, 0, 1); BLOAD2(bhi, t3, 4);
        G_WAIT_V(8); G_WAIT_L(0); G_BAR; MMA(1, 1, At, B1); G_BAR;
    }
    G_WAIT_V(0); G_WAIT_L(0);
    { int wr0 = wid >> 2; asm volatile("" : "+s"(wr0)); if (wr0 == 0) G_BAR; }
    G_BAR;
#undef SA_
#undef SB_
#undef STAGE_A
#undef BLOAD2
#undef BWRITE_H
#undef BWAIT
#undef LDA
#undef LDB_
#undef MMA
}

typedef int v8i32 __attribute__((ext_vector_type(8)));
typedef short v2s16 __attribute__((ext_vector_type(2)));
typedef int i32x4 __attribute__((ext_vector_type(4)));
#ifndef F8_WSCALE
#define F8_WSCALE 0.00390625f
#endif
template <int LDB, int ROWB = 0, int ASTEP = 128>
__device__ __forceinline__ void gemm_kloop_f8(f32x4 (&acc)[2][2][4][2], const unsigned char* __restrict__ A, const unsigned (&aoff)[2][2],
                                              const float* __restrict__ B, unsigned boff, int nt, LAS3 char* lds, int tid, int wid, unsigned char* __restrict__ img, int pam = 1, int pbm = 1) {
    const int lane = tid & 63, wr = wid >> 2, wc = wid & 3, fr = lane & 15, fq = lane >> 4;
    const int c0 = fq ^ (fr >> 1);
    const int a_rd0 = (wr * 64 + fr) * 128 + c0 * 16, a_rd1 = (wr * 64 + fr) * 128 + (c0 ^ 4) * 16;
    const int b_rd0 = (wc * 16 + fr) * 128 + ((c0 ^ (wc & 1)) * 16), b_rd1 = (wc * 16 + fr) * 128 + ((c0 ^ (wc & 1) ^ 4) * 16);
    const int k8 = wid, n4 = tid & 63, bhalf = n4 >> 5, nloc = (n4 & 31) * 4;
    const int sw0 = (((n4 & 3) * 2) & 7) ^ ((n4 >> 2) & 1), sw1 = (((n4 & 3) * 2 + 1) & 7) ^ ((n4 >> 2) & 1);
    const int b_wr0 = (4 + bhalf) * GHTB + nloc * 128 + ((k8 ^ sw0) << 4);
    const int b_wr1 = (4 + bhalf) * GHTB + (nloc + 2) * 128 + ((k8 ^ sw1) << 4);
    const unsigned boffb = boff * 4u;
    const unsigned lds_u = (unsigned)(unsigned long)lds;
    const unsigned bw_a0 = lds_u + (unsigned)b_wr0, bw_a1 = lds_u + (unsigned)b_wr1;
    const int a_dma0 = wid * 1024, a_dma1 = (8 + wid) * 1024;
    const size_t bstep = (size_t)128 * LDB * pbm, astepb = (size_t)ASTEP * pam;
    const unsigned cp_lds = lds_u + 4 * GHTB + (unsigned)wid * 4096u + (unsigned)lane * 16u;
    const unsigned char* cp_g = (const unsigned char*)((uintptr_t)img - (uintptr_t)(lds_u + 4 * GHTB));
    u32x4 cp0, cp1;
#define CPRD(b, h) asm volatile("ds_read_b128 %0, %2 offset:%3\n\tds_read_b128 %1, %2 offset:%4" : "=&v"(cp0), "=&v"(cp1) : "v"(cp_lds), "n"((b) * 2 * GHTB + (h) * 2048), "n"((b) * 2 * GHTB + (h) * 2048 + 1024) : "memory")
#define CPST(tc, h) asm volatile("s_nop 4\n\tglobal_store_dwordx4 %2, %0, %3 sc1\n\tglobal_store_dwordx4 %2, %1, %3 offset:1024 sc1\n\ts_nop 1" :: "v"(cp0), "v"(cp1), "v"(cp_lds), "s"(cp_g + (size_t)(tc) * 32768 + (h) * 2048) : "memory")

#define SA_(b, h) (((b) * 2 + (h)) * GHTB)
#define SB_(b, h) ((4 + (b) * 2 + (h)) * GHTB)
#define STAGE_A(b, h, kt) do { const unsigned char* _g = A + (size_t)(kt) * astepb; \
        dma16((const void*)(_g + (size_t)((h) * 128) * ROWB), ROWB ? aoff[0][0] : aoff[h][0], lds_u + SA_(b, h) + a_dma0); \
        dma16((const void*)(_g + (size_t)((h) * 128 + 64) * ROWB), ROWB ? aoff[0][0] : aoff[h][1], lds_u + SA_(b, h) + a_dma1); } while (0)
#define QLOAD(R, kt, q) do { \
        asm volatile("s_nop 4\n\tglobal_load_dwordx4 %0, %2, %3 nt\n\tglobal_load_dwordx4 %1, %2, %4 nt" : "=&v"(R[0]), "=&v"(R[1]) \
            : "v"(boffb), "s"(B + (size_t)(kt) * bstep + (size_t)(4 * (q)) * LDB), "s"(B + (size_t)(kt) * bstep + (size_t)(4 * (q) + 1) * LDB) : "memory"); \
        asm volatile("s_nop 4\n\tglobal_load_dwordx4 %0, %2, %3 nt\n\tglobal_load_dwordx4 %1, %2, %4 nt" : "=&v"(R[2]), "=&v"(R[3]) \
            : "v"(boffb), "s"(B + (size_t)(kt) * bstep + (size_t)(4 * (q) + 2) * LDB), "s"(B + (size_t)(kt) * bstep + (size_t)(4 * (q) + 3) * LDB) : "memory"); } while (0)
#define QWAIT4(R, n) QWAIT(R, n)
#define QWAIT(R, n) asm volatile("s_waitcnt vmcnt(" #n ")" : "+v"(R[0]), "+v"(R[1]), "+v"(R[2]), "+v"(R[3]) :: "memory")
#define QCVTW(R, b, q) do { _Pragma("unroll") for (int _i = 0; _i < 4; ++_i) { \
            cvd = __builtin_amdgcn_cvt_scalef32_pk_fp8_f32(cvd, R[0][_i], R[1][_i], F8_WSCALE, false); \
            cvd = __builtin_amdgcn_cvt_scalef32_pk_fp8_f32(cvd, R[2][_i], R[3][_i], F8_WSCALE, true); \
            asm volatile("ds_write_b32 %0, %1 offset:%2" :: "v"((_i < 2) ? bw_a0 : bw_a1), "v"(cvd), "n"((b) * 2 * GHTB + (_i & 1) * 128 + (q) * 4) : "memory"); } } while (0)
#define LDA1(dst, b, h, m) do { \
        dst.lo = *(LAS3 const i32x4*)(lds + SA_(b, h) + a_rd0 + (m) * 2048); \
        dst.hi = *(LAS3 const i32x4*)(lds + SA_(b, h) + a_rd1 + (m) * 2048); } while (0)
#define LDB4(dst, b) do { _Pragma("unroll") for (int _h = 0; _h < 2; ++_h) _Pragma("unroll") for (int _n = 0; _n < 2; ++_n) { \
        dst[_h * 2 + _n].lo = *(LAS3 const i32x4*)(lds + SB_(b, _h) + b_rd0 + _n * 8192); \
        dst[_h * 2 + _n].hi = *(LAS3 const i32x4*)(lds + SB_(b, _h) + b_rd1 + _n * 8192); } } while (0)
#define MF4(ai, m, slot) do { _Pragma("unroll") for (int _j = 0; _j < 4; ++_j) \
            acc[ai][_j >> 1][m][_j & 1] = __builtin_amdgcn_mfma_scale_f32_16x16x128_f8f6f4(Bx[_j], slot, acc[ai][_j >> 1][m][_j & 1], 0, 0, 0, 0x7f7f7f77, 1, 0x7f7f7f77); } while (0)
#define MMA16(ai, b, h) do { __builtin_amdgcn_s_setprio(1); MF4(ai, 0, A0); G_SCHED; LDA1(A0, b, h, 2); G_SCHED; MF4(ai, 1, A1); G_SCHED; LDA1(A1, b, h, 3); G_SCHED; \
        G_WAIT_L(2); MF4(ai, 2, A0); G_SCHED; G_WAIT_L(0); MF4(ai, 3, A1); __builtin_amdgcn_s_setprio(0); } while (0)
#define MMA16C(ai, b, h, tc) do { __builtin_amdgcn_s_setprio(1); MF4(ai, 0, A0); G_SCHED; LDA1(A0, b, h, 2); CPRD(b, 0); G_SCHED; MF4(ai, 1, A1); G_SCHED; LDA1(A1, b, h, 3); G_SCHED; \
        G_WAIT_L(2); MF4(ai, 2, A0); G_SCHED; CPST(tc, 0); CPRD(b, 1); G_WAIT_L(2); MF4(ai, 3, A1); G_SCHED; G_WAIT_L(0); CPST(tc, 1); __builtin_amdgcn_s_setprio(0); } while (0)

    f32x4 s0[4], s1[4];
    v2s16 cvd; asm("" : "=v"(cvd));
    v8i32 A0, A1, Bx[4];
#pragma unroll
    for (int ai = 0; ai < 2; ++ai)
#pragma unroll
        for (int bj = 0; bj < 2; ++bj)
#pragma unroll
            for (int m = 0; m < 4; ++m)
#pragma unroll
                for (int n = 0; n < 2; ++n) acc[ai][bj][m][n] = (f32x4){0.f, 0.f, 0.f, 0.f};

    const int p1 = (1 < nt) ? 1 : 0;
    QLOAD(acc[0][0][0], 0, 0); QLOAD(acc[0][0][2], 0, 1); QLOAD(acc[0][1][0], 0, 2); QLOAD(acc[0][1][2], 0, 3);
    STAGE_A(0, 0, 0); STAGE_A(0, 1, 0);
    QLOAD(s0, p1, 0); QLOAD(s1, p1, 1);
    __builtin_amdgcn_s_waitcnt(0);
    QWAIT4(acc[0][0][0], 0); QWAIT4(acc[0][0][2], 0); QWAIT4(acc[0][1][0], 0); QWAIT4(acc[0][1][2], 0); QWAIT(s0, 0); QWAIT(s1, 0);
    QCVTW(acc[0][0][0], 0, 0); QCVTW(acc[0][0][2], 0, 1); QCVTW(acc[0][1][0], 0, 2); QCVTW(acc[0][1][2], 0, 3);
#pragma unroll
    for (int bj = 0; bj < 2; ++bj)
#pragma unroll
        for (int m = 0; m < 4; ++m)
#pragma unroll
            for (int n = 0; n < 2; ++n) acc[0][bj][m][n] = (f32x4){0.f, 0.f, 0.f, 0.f};
    G_WAIT_L(0);
    { int wr1 = wid >> 2; asm volatile("" : "+s"(wr1)); if (wr1 == 1) G_BAR; }
    G_BAR;
#define KTILE(b, tc, tn1, tn2) do { \
          \
        LDB4(Bx, b); G_SCHED; LDA1(A0, b, 0, 0); LDA1(A1, b, 0, 1); \
        QWAIT(s0, 6); QCVTW(s0, (b) ^ 1, 0); QLOAD(s0, tn1, 2); QWAIT(s1, 6); QCVTW(s1, (b) ^ 1, 1); QLOAD(s1, tn1, 3); STAGE_A((b) ^ 1, 0, tn1); \
        G_WAIT_V(10); G_BAR; G_WAIT_L(0); MMA16C(0, b, 0, tc); G_BAR; G_SCHED; \
          \
        LDA1(A0, b, 1, 0); LDA1(A1, b, 1, 1); \
        QWAIT(s0, 10); QCVTW(s0, (b) ^ 1, 2); QLOAD(s0, tn2, 0); QWAIT(s1, 10); QCVTW(s1, (b) ^ 1, 3); QLOAD(s1, tn2, 1); STAGE_A((b) ^ 1, 1, tn1); \
        G_WAIT_V(14); G_WAIT_L(0); G_BAR; MMA16(1, b, 1); G_BAR; G_SCHED; } while (0)
    for (int t = 0; t < nt; t += 2) {
        const int t1 = (t + 1 < nt) ? t + 1 : nt - 1, t2 = (t + 2 < nt) ? t + 2 : nt - 1, t3 = (t + 3 < nt) ? t + 3 : nt - 1;
        KTILE(0, t, t1, t2);
        KTILE(1, t1, t2, t3);
    }
    G_WAIT_V(0); G_WAIT_L(0);
    { int wr0 = wid >> 2; asm volatile("" : "+s"(wr0)); if (wr0 == 0) G_BAR; }
    G_BAR;
#undef KTILE
#undef SA_
#undef SB_
#undef STAGE_A
#undef QLOAD
#undef QWAIT
#undef QCVTW
#undef LDA1
#undef MF4
#undef MMA16
#undef MMA16C
#undef LDB4
#undef QWAIT4
#undef CPRD
#undef CPST
}


__device__ __forceinline__ int lane_id() { int r; asm volatile("v_mbcnt_lo_u32_b32 %0, -1, 0\n\tv_mbcnt_hi_u32_b32 %0, -1, %0" : "=v"(r)); return r; }
#define SWZ_XOR(v, o) __int_as_float(__builtin_amdgcn_ds_swizzle(__float_as_int(v), ((o) << 10) | 0x1F))
__device__ __forceinline__ float half_sum32(float v) {
    v += SWZ_XOR(v, 16); v += SWZ_XOR(v, 8); v += SWZ_XOR(v, 4); v += SWZ_XOR(v, 2); v += SWZ_XOR(v, 1);
    return v;
}
__device__ __forceinline__ float xor32(float v) { const int l = lane_id(); return __int_as_float(__builtin_amdgcn_ds_bpermute((l ^ 32) << 2, __float_as_int(v))); }
__device__ __forceinline__ float wave_sum(float v) { v = half_sum32(v); return v + xor32(v); }
typedef int v8i32d __attribute__((ext_vector_type(8)));
typedef int i32x4d __attribute__((ext_vector_type(4)));
template <bool F8, bool BSW = false, int ROWB = 0, bool ACCUM = false, int ASTEP = 128>
__device__ __forceinline__ void gemm_kloop_dma(f32x4 (&acc)[2][2][4][2], const unsigned char* __restrict__ A, const unsigned (&aoff)[2][2],
                                               const unsigned char* __restrict__ img, int nt, LAS3 char* lds, int tid, int wid, int kbase = 0) {
    constexpr int KMASK = F8 ? 15 : 31;
#define KT_(kt) ((kbase + (kt)) & KMASK)
    const int lane = tid & 63, wr = wid >> 2, wc = wid & 3, fr = lane & 15, fq = lane >> 4;
    const int c0 = fq ^ (fr >> 1);
    const int a_rd0 = (wr * 64 + fr) * 128 + c0 * 16, a_rd1 = (wr * 64 + fr) * 128 + (c0 ^ 4) * 16;
    const int cb = BSW ? (c0 ^ (wc & 1)) : c0;
    const int b_rd0 = (wc * 16 + fr) * 128 + cb * 16, b_rd1 = (wc * 16 + fr) * 128 + (cb ^ 4) * 16;
    const unsigned lds_u = (unsigned)(unsigned long)lds;
    LAS3 const char* ap0 = lds + a_rd0; LAS3 const char* ap1 = lds + a_rd1; LAS3 const char* bp0 = lds + 4 * GHTB + b_rd0; LAS3 const char* bp1 = lds + 4 * GHTB + b_rd1;
    asm volatile("" : "+v"(ap0), "+v"(ap1), "+v"(bp0), "+v"(bp1));
    const int dma0 = wid * 1024, dma1 = (8 + wid) * 1024;
    const unsigned boffl = (unsigned)lane * 16u;

#define SA_(b, h) (((b) * 2 + (h)) * GHTB)
#define SB_(b, h) ((4 + (b) * 2 + (h)) * GHTB)
#define STG_A(b, h, kt) do { const unsigned char* _g = A + (size_t)KT_(kt) * ASTEP; \
        dma16((const void*)(_g + (size_t)((h) * 128) * ROWB), ROWB ? aoff[0][0] : aoff[h][0], lds_u + SA_(b, h) + dma0); \
        dma16((const void*)(_g + (size_t)((h) * 128 + 64) * ROWB), ROWB ? aoff[0][0] : aoff[h][1], lds_u + SA_(b, h) + dma1); } while (0)
#define STG_B(b, h, kt) do { const unsigned char* _g = img + (size_t)KT_(kt) * 32768 + (h) * 16384; \
        dma16((const void*)(_g + dma0), boffl, lds_u + SB_(b, h) + dma0); \
        dma16((const void*)(_g + dma1), boffl, lds_u + SB_(b, h) + dma1); } while (0)
#define LDA_(dst, b, h) do { _Pragma("unroll") for (int _m = 0; _m < 4; ++_m) { \
        dst[_m].lo = *(LAS3 const i32x4d*)(ap0 + SA_(b, h) + _m * 2048); \
        dst[_m].hi = *(LAS3 const i32x4d*)(ap1 + SA_(b, h) + _m * 2048); } } while (0)
#define LDBF(dst, b, h) do { _Pragma("unroll") for (int _n = 0; _n < 2; ++_n) { \
        dst[_n].lo = *(LAS3 const i32x4d*)(bp0 + (SB_(b, h) - 4 * GHTB) + _n * 8192); \
        dst[_n].hi = *(LAS3 const i32x4d*)(bp1 + (SB_(b, h) - 4 * GHTB) + _n * 8192); } } while (0)
#define MMAD(ai, bj, Af, Bf) do { __builtin_amdgcn_s_setprio(1); \
        _Pragma("unroll") for (int _m = 0; _m < 4; ++_m) _Pragma("unroll") for (int _n = 0; _n < 2; ++_n) { \
            if (F8) acc[ai][bj][_m][_n] = __builtin_amdgcn_mfma_scale_f32_16x16x128_f8f6f4(Bf[_n], Af[_m], acc[ai][bj][_m][_n], 0, 0, 0, 0x7f7f7f77, 1, 0x7f7f7f77); \
            else { const i32x4d _bl = Bf[_n].lo, _bh = Bf[_n].hi, _al = Af[_m].lo, _ah = Af[_m].hi;     \
                   acc[ai][bj][_m][_n] = __builtin_amdgcn_mfma_f32_16x16x32_bf16(__builtin_bit_cast(bf16x8, _bl), __builtin_bit_cast(bf16x8, _al), acc[ai][bj][_m][_n], 0, 0, 0); \
                   acc[ai][bj][_m][_n] = __builtin_amdgcn_mfma_f32_16x16x32_bf16(__builtin_bit_cast(bf16x8, _bh), __builtin_bit_cast(bf16x8, _ah), acc[ai][bj][_m][_n], 0, 0, 0); } } \
        __builtin_amdgcn_s_setprio(0); } while (0)

    v8i32d At[4], B0[2], B1[2];
    if (!ACCUM)
#pragma unroll
    for (int ai = 0; ai < 2; ++ai)
#pragma unroll
        for (int bj = 0; bj < 2; ++bj)
#pragma unroll
            for (int m = 0; m < 4; ++m)
#pragma unroll
                for (int n = 0; n < 2; ++n) acc[ai][bj][m][n] = (f32x4){0.f, 0.f, 0.f, 0.f};
    STG_B(0, 0, 0); STG_A(0, 0, 0); STG_B(0, 1, 0); STG_A(0, 1, 0);
    __builtin_amdgcn_s_waitcnt(0);
    { int wr1 = wid >> 2; asm volatile("" : "+s"(wr1)); if (wr1 == 1) G_BAR; }
    G_BAR;
    { const int p1 = (1 < nt) ? 1 : 0; STG_B(1, 0, p1); STG_A(1, 0, p1); STG_B(1, 1, p1); }
    G_WAIT_V(6); G_BAR;
    for (int t = 0; t < nt; t += 2) {
        const int t1 = (t + 1 < nt) ? t + 1 : nt - 1, t2 = (t + 2 < nt) ? t + 2 : nt - 1, t3 = (t + 3 < nt) ? t + 3 : nt - 1;
        LDBF(B0, 0, 0); G_SCHED; LDA_(At, 0, 0); STG_A(1, 1, t1);
        G_WAIT_L(8); G_BAR; G_WAIT_L(0); MMAD(0, 0, At, B0); G_BAR; G_SCHED;
        LDBF(B1, 0, 1); STG_B(0, 0, t2);
        G_BAR; G_WAIT_L(0); MMAD(0, 1, At, B1); G_BAR;
        LDA_(At, 0, 1); STG_A(0, 0, t2);
        G_BAR; G_WAIT_L(0); MMAD(1, 0, At, B0); G_BAR; G_SCHED;
        STG_B(0, 1, t2);
        G_WAIT_V(6); G_BAR; MMAD(1, 1, At, B1); G_BAR;
        LDBF(B0, 1, 0); G_SCHED; LDA_(At, 1, 0); STG_A(0, 1, t2);
        G_WAIT_L(8); G_BAR; G_WAIT_L(0); MMAD(0, 0, At, B0); G_BAR; G_SCHED;
        LDBF(B1, 1, 1); STG_B(1, 0, t3);
        G_BAR; G_WAIT_L(0); MMAD(0, 1, At, B1); G_BAR;
        LDA_(At, 1, 1); STG_A(1, 0, t3);
        G_BAR; G_WAIT_L(0); MMAD(1, 0, At, B0); G_BAR; G_SCHED;
        STG_B(1, 1, t3);
        G_WAIT_V(6); G_BAR; MMAD(1, 1, At, B1); G_BAR;
    }
    G_WAIT_V(0); G_WAIT_L(0);
    { int wr0 = wid >> 2; asm volatile("" : "+s"(wr0)); if (wr0 == 0) G_BAR; }
    G_BAR;
#undef SA_
#undef SB_
#undef STG_A
#undef STG_B
#undef LDA_
#undef LDBF
#undef MMAD
#undef KT_
}

template <bool F8, int LDB>
__device__ __forceinline__ void convert_tile(const float* __restrict__ W, int col0, int col1, int nkt, unsigned char* __restrict__ img, LAS3 char* lds, int wid) {
    constexpr int RPT = F8 ? 16 : 8;
    int lane = lane_id(); asm volatile("" : "+v"(lane));
    const int n4 = lane, half = n4 >> 5, nloc = (n4 & 31) * 4;
    const float* src = W + (size_t)(wid * RPT) * LDB + ((n4 < 32) ? col0 + n4 * 4 : col1 + (n4 - 32) * 4);
    for (int kt = 0; kt < nkt; ++kt) {
        f32x4 r[RPT];
#pragma unroll
        for (int j = 0; j < RPT; ++j) r[j] = __builtin_nontemporal_load((const f32x4*)(src + (size_t)(kt * (RPT * 8) + j) * LDB));
        LAS3 char* buf = lds + (kt & 1) * 32768;
#pragma unroll
        for (int i = 0; i < 4; ++i) {
            u32x4 w;
            if (F8) {
#pragma unroll
                for (int q = 0; q < 4; ++q) {
                    int d = __builtin_amdgcn_cvt_pk_fp8_f32(r[4 * q][i] * 256.0f, r[4 * q + 1][i] * 256.0f, 0, false);
                    d = __builtin_amdgcn_cvt_pk_fp8_f32(r[4 * q + 2][i] * 256.0f, r[4 * q + 3][i] * 256.0f, d, true);
                    w[q] = (unsigned)d;
                }
            } else {
                w.x = cvt_pk_bf16(r[0][i], r[1][i]); w.y = cvt_pk_bf16(r[2][i], r[3][i]); w.z = cvt_pk_bf16(r[4][i], r[5][i]); w.w = cvt_pk_bf16(r[6][i], r[7][i]);
            }
            const int row = nloc + i;
            *(LAS3 u32x4*)(buf + half * 16384 + row * 128 + ((wid ^ ((row >> 1) & 7)) << 4)) = w;
        }
        __syncthreads();
#pragma unroll
        for (int j = 0; j < 4; ++j) {
            const u32x4 v = *(LAS3 const u32x4*)(buf + wid * 4096 + j * 1024 + lane * 16);
            *(u32x4*)(img + (size_t)kt * 32768 + wid * 4096 + j * 1024 + lane * 16) = v;
        }
    }
    __syncthreads();
}

__device__ __forceinline__ float gelu_exact(float x) { return 0.5f * x * (1.0f + erff(x * 0.70710678118654752f)); }
__device__ __forceinline__ float bf2f(bf16_t v) { return __uint_as_float((unsigned)v << 16); }
__device__ __forceinline__ bf16_t f2bf(float v) { return (bf16_t)(cvt_pk_bf16(v, 0.f) & 0xffffu); }

struct GemmArgs {
    const bf16_t* A; const float* B; const float* bias; const float* R;
    void* C;
    const int* list; const int* cnt;
    int abase;
};

struct TileSync {
    int* flag;
    unsigned* qctr;
    unsigned qtag;
    LAS3 unsigned* qslot;
    int* dep; int depn;
    int* pend;
};

constexpr int EST_BF16 = 528;
constexpr int EST_F8 = 144;
constexpr int LDS_BIAS = 256 * EST_BF16 + 3072;
__device__ __forceinline__ void epi_stage_bf16(const f32x4 (&v)[2][2], int r, int colw, LAS3 char* lds) {
#pragma unroll
    for (int bj = 0; bj < 2; ++bj)
#pragma unroll
        for (int n = 0; n < 2; ++n) { u32x2 o; o.x = cvt_pk_bf16(v[bj][n][0], v[bj][n][1]); o.y = cvt_pk_bf16(v[bj][n][2], v[bj][n][3]);
            *(LAS3 u32x2*)(lds + r * EST_BF16 + (bj * 128 + n * 64 + colw) * 2) = o; }
}
__device__ __forceinline__ void epi_flush_bf16(bf16_t* C, size_t ld, int grow0, int col0, int nvalid, LAS3 char* lds, int tid) {
    __syncthreads();
    const int chunk = tid & 31, r0 = tid >> 5;
#pragma unroll 4
    for (int it = 0; it < 16; ++it) { const int row = it * 16 + r0;
        if (row < nvalid) { const u32x4 q = *(LAS3 const u32x4*)(lds + row * EST_BF16 + chunk * 16); *(u32x4*)(C + ((unsigned)(grow0 + row) * (unsigned)ld + (unsigned)(col0 + chunk * 8))) = q; } }
    __syncthreads();
}
__device__ __forceinline__ void epi_flush_f8(unsigned char* C, size_t ld, int grow0, int col0, int nvalid, LAS3 char* lds, int tid) {
    __syncthreads();
    const int chunk = tid & 7, r0 = tid >> 3;
#pragma unroll
    for (int it = 0; it < 4; ++it) { const int row = it * 64 + r0;
        if (row < nvalid) { const u32x4 q = *(LAS3 const u32x4*)(lds + row * EST_F8 + chunk * 16);
            const unsigned off = ((((unsigned)grow0 >> 8) * (unsigned)(ld >> 7) + ((unsigned)col0 >> 7)) * 256u + (unsigned)row) * 128u + (unsigned)(chunk * 16);
            asm volatile("s_nop 4\n\tglobal_store_dwordx4 %0, %1, %2 sc1 nt\n\ts_nop 1" :: "v"(off), "v"(q), "s"(C) : "memory"); } }
    __syncthreads();
}

constexpr int EST_F8W = 272;
__device__ __forceinline__ void epi_flush_f8w(unsigned char* C, size_t ld, int grow0, int col0, int nvalid, LAS3 char* lds, int tid) {
    __syncthreads();
    const int chunk = tid & 15, r0 = tid >> 4;
#pragma unroll
    for (int it = 0; it < 8; ++it) { const int row = it * 32 + r0;
        if (row < nvalid) { const u32x4 q = *(LAS3 const u32x4*)(lds + row * EST_F8W + chunk * 16);
            const unsigned off = (unsigned)(grow0 + row) * (unsigned)ld + (unsigned)(col0 + chunk * 16);
            asm volatile("s_nop 4\n\tglobal_store_dwordx4 %0, %1, %2 nt\n\ts_nop 1" :: "v"(off), "v"(q), "s"(C) : "memory"); } }
    __syncthreads();
}
template <int EPI, int VAR = 0>
__device__ __forceinline__ void gemm_tile(const GemmArgs& g, int pm, int pn, int e, int ebase, int ecnt, LAS3 char* lds, int wid, unsigned char* img, const TileSync& sy) {
    constexpr int LDB = (EPI == 0) ? DIN : (EPI == 2) ? 2 * DFF : D;
    int tid = wid * 64 + lane_id(); asm volatile("" : "+v"(tid));
    const int lane = tid & 63;
    unsigned aoff[2][2];
#pragma unroll
    for (int h = 0; h < 2; ++h)
#pragma unroll
        for (int i = 0; i < 2; ++i) {
            const int rih = (i * 8 + wid) * 8 + (lane >> 3);
            const int chunk = (lane & 7) ^ ((rih >> 1) & 7);
            int r = pm * 256 + h * 128 + rih;
            unsigned grow;
            if (EPI == 2) { if (r >= ecnt) r = ecnt - 1; grow = (unsigned)(g.list[e * T + r] >> 2); }
            else if (EPI == 3) { grow = (unsigned)(((g.abase >> 8) + pm) * (16 * 256) + h * 128 + rih); }
            else grow = (unsigned)r;
            aoff[h][i] = (EPI == 3) ? (grow * 128u + (unsigned)(chunk * 16)) : (EPI >= 2) ? (grow * (unsigned)D + (unsigned)(chunk * 16)) : (grow * (unsigned)D + (unsigned)(chunk * 8)) * 2u;
        }
    const int k8 = wid, n4 = tid & 63;
    int col;
    if (EPI == 2) col = (n4 < 32) ? pn * 128 + n4 * 4 : DFF + pn * 128 + (n4 - 32) * 4;
    else col = pn * 256 + n4 * 4;
    const unsigned boff = (unsigned)(k8 * ((EPI >= 2) ? 16 : 8)) * (unsigned)LDB + (unsigned)col;
    const float* Bp = g.B;
    if (EPI == 2) Bp += (size_t)e * D * (2 * DFF);
    if (EPI == 3) Bp += (size_t)e * DFF * D;
    if (EPI >= 2 && tid < 256) {
        float bvv;
        if (EPI == 2) bvv = (tid < 128) ? g.bias[(size_t)e * (2 * DFF) + pn * 128 + tid] : g.bias[(size_t)e * (2 * DFF) + DFF + pn * 128 + (tid - 128)] + 1.0f;
        else bvv = g.bias[(size_t)e * D + pn * 256 + tid];
        *(LAS3 float*)(lds + LDS_BIAS + tid * 4) = bvv;
    }
    if (EPI >= 2) {
        if (tid == 0) {
            if (sy.dep) { unsigned sp = 0; while (__hip_atomic_load(sy.dep, __ATOMIC_RELAXED, __HIP_MEMORY_SCOPE_AGENT) < sy.depn) { __builtin_amdgcn_s_sleep(8); if (++sp > (1u << 20)) break; }
                __builtin_amdgcn_fence(__ATOMIC_ACQUIRE, "agent"); asm volatile("s_waitcnt vmcnt(0)" ::: "memory"); } }
        if (sy.dep) __syncthreads();
    }
    f32x4 acc[2][2][4][2];
    if (EPI >= 2) gemm_kloop_f8<LDB, (EPI == 3) ? 128 : 0, (EPI == 3) ? 32768 : 128>(acc, (const unsigned char*)g.A, aoff, Bp, boff, D / 128, lds, tid, wid, img);
    else gemm_kloop<LDB, VAR>(acc, g.A, aoff, Bp, boff, D / GBK, lds, tid, wid);
    int tz = wid * 64 + lane_id(); asm volatile("" : "+v"(tz));
    if (EPI >= 2 && sy.pend && tz == 0) __hip_atomic_fetch_add(sy.pend, 1, __ATOMIC_RELAXED, __HIP_MEMORY_SCOPE_AGENT);
    unsigned nx = 0;
    if (EPI >= 2 && tz == 0) nx = __hip_atomic_fetch_add(sy.qctr, 1u, __ATOMIC_RELAXED, __HIP_MEMORY_SCOPE_AGENT);
    if (EPI >= 2 && tz == 0) __hip_atomic_store(sy.flag, 1, __ATOMIC_RELAXED, __HIP_MEMORY_SCOPE_AGENT);
    const int wid2 = tz >> 6, lane2 = tz & 63;
    const int row0 = (wid2 >> 2) * 64 + (lane2 & 15), colw = (wid2 & 3) * 16 + (lane2 >> 4) * 4;
    if (EPI == 0) {
#pragma unroll
        for (int ai = 0; ai < 2; ++ai)
#pragma unroll
            for (int m = 0; m < 4; ++m) {
                f32x4 v[2][2];
#pragma unroll
                for (int bj = 0; bj < 2; ++bj)
#pragma unroll
                    for (int n = 0; n < 2; ++n) v[bj][n] = acc[ai][bj][m][n];
                epi_stage_bf16(v, ai * 128 + row0 + m * 16, colw, lds);
            }
        epi_flush_bf16((bf16_t*)g.C, DIN, pm * 256, pn * 256, 256, lds, tz);
    } else if (EPI == 1) {
        float* C = (float*)g.C;
#pragma unroll
        for (int ai = 0; ai < 2; ++ai)
#pragma unroll
            for (int m = 0; m < 4; ++m) {
                const size_t ro = (size_t)(pm * 256 + ai * 128 + row0 + m * 16) * D + pn * 256 + colw;
#pragma unroll
                for (int bj = 0; bj < 2; ++bj)
#pragma unroll
                    for (int n = 0; n < 2; ++n) { const f32x4 xr = __builtin_nontemporal_load((const f32x4*)(g.R + ro + bj * 128 + n * 64));
                        *(f32x4*)(C + ro + bj * 128 + n * 64) = acc[ai][bj][m][n] + xr; }
            }
    } else if (EPI == 2) {
        unsigned char* C = (unsigned char*)g.C;
        f32x4 bgate[2], bup1[2];
#pragma unroll
        for (int n = 0; n < 2; ++n) { bgate[n] = *(LAS3 const f32x4*)(lds + LDS_BIAS + (n * 64 + colw) * 4); bup1[n] = *(LAS3 const f32x4*)(lds + LDS_BIAS + (128 + n * 64 + colw) * 4); }
#pragma unroll
        for (int ai = 0; ai < 2; ++ai)
#pragma unroll
            for (int m = 0; m < 4; ++m) {
                const int r = pm * 256 + ai * 128 + row0 + m * 16;
                {
                    LAS3 char* rp = lds + (ai * 128 + row0 + m * 16) * EST_F8 + colw;
#pragma unroll
                    for (int n = 0; n < 2; ++n) {
                        float o[4];
#pragma unroll
                        for (int j = 0; j < 4; j += 2) {
                            typedef float f32x2 __attribute__((ext_vector_type(2)));
                            f32x2 gt = (f32x2){acc[ai][0][m][n][j], acc[ai][0][m][n][j + 1]} + (f32x2){bgate[n][j], bgate[n][j + 1]};
                            f32x2 up = (f32x2){acc[ai][1][m][n][j], acc[ai][1][m][n][j + 1]} + (f32x2){bup1[n][j], bup1[n][j + 1]};
                            gt.x = fminf(gt.x, 7.0f); gt.y = fminf(gt.y, 7.0f);
                            up.x = __builtin_amdgcn_fmed3f(up.x, -6.0f, 8.0f); up.y = __builtin_amdgcn_fmed3f(up.y, -6.0f, 8.0f);
                            const f32x2 xe = gt * (-2.45546696f);
                            f32x2 ex; ex.x = __builtin_amdgcn_exp2f(xe.x); ex.y = __builtin_amdgcn_exp2f(xe.y);
                            const f32x2 den = ex + 1.0f;
                            f32x2 rc; rc.x = __builtin_amdgcn_rcpf(den.x); rc.y = __builtin_amdgcn_rcpf(den.y);
                            const f32x2 res = (gt * rc) * up;
                            o[j] = res.x; o[j + 1] = res.y;
                        }
                        int w = __builtin_amdgcn_cvt_pk_fp8_f32(o[0], o[1], 0, false);
                        w = __builtin_amdgcn_cvt_pk_fp8_f32(o[2], o[3], w, true);
                        *(LAS3 int*)(rp + n * 64) = w;
                    }
                }
            }
        { const int nv = ecnt - pm * 256; epi_flush_f8(C, DFF, g.abase + pm * 256, pn * 128, nv < 256 ? nv : 256, lds, tz); }
    } else {
        bf16_t* C = (bf16_t*)g.C;
        f32x4 bv[2][2];
#pragma unroll
        for (int bj = 0; bj < 2; ++bj)
#pragma unroll
            for (int n = 0; n < 2; ++n) bv[bj][n] = *(LAS3 const f32x4*)(lds + LDS_BIAS + (bj * 128 + n * 64 + colw) * 4);
#pragma unroll
        for (int ai = 0; ai < 2; ++ai)
#pragma unroll
            for (int m = 0; m < 4; ++m) {
                LAS3 char* rp = lds + (ai * 128 + row0 + m * 16) * EST_F8W + colw;
#pragma unroll
                for (int bj = 0; bj < 2; ++bj)
#pragma unroll
                    for (int n = 0; n < 2; ++n) { const f32x4 v = acc[ai][bj][m][n] + bv[bj][n];
                        int w = __builtin_amdgcn_cvt_pk_fp8_f32(v[0], v[1], 0, false); w = __builtin_amdgcn_cvt_pk_fp8_f32(v[2], v[3], w, true);
                        *(LAS3 int*)(rp + bj * 128 + n * 64) = w; }
            }
        { const int nv = ecnt - pm * 256; epi_flush_f8w((unsigned char*)g.C, D, ebase + pm * 256, pn * 256, nv < 256 ? nv : 256, lds, tz); }
    }
    if (EPI >= 2 && tz == 0) *sy.qslot = sy.qtag | nx;
}


template <int EPI>
__device__ __forceinline__ void gemm_tile_img(const GemmArgs& g, int pm, int pn, int e, int ebase, int ecnt, LAS3 char* lds, int wid, const unsigned char* img, const TileSync& sy, int kh = -1) {
    int tid = wid * 64 + lane_id(); asm volatile("" : "+v"(tid));
    const int lane = tid & 63;
    unsigned aoff[2][2];
#pragma unroll
    for (int h = 0; h < 2; ++h)
#pragma unroll
        for (int i = 0; i < 2; ++i) {
            const int rih = (i * 8 + wid) * 8 + (lane >> 3);
            const int chunk = (lane & 7) ^ ((rih >> 1) & 7);
            int r = pm * 256 + h * 128 + rih;
            unsigned grow;
            if (EPI == 2) { if (r >= ecnt) r = ecnt - 1; grow = (unsigned)(g.list[e * T + r] >> 2); }
            else if (EPI == 3) { grow = (unsigned)(((g.abase >> 8) + pm) * (16 * 256) + h * 128 + rih); }
            else grow = (unsigned)r;
            aoff[h][i] = (EPI == 3) ? (grow * 128u + (unsigned)(chunk * 16)) : (EPI >= 2) ? (grow * (unsigned)D + (unsigned)(chunk * 16)) : (grow * (unsigned)D + (unsigned)(chunk * 8)) * 2u;
        }
    if (EPI >= 2) {
        if (tid < 256) {
            float bvv;
            if (EPI == 2) bvv = (tid < 128) ? g.bias[(size_t)e * (2 * DFF) + pn * 128 + tid] : g.bias[(size_t)e * (2 * DFF) + DFF + pn * 128 + (tid - 128)] + 1.0f;
            else bvv = g.bias[(size_t)e * D + pn * 256 + tid];
            *(LAS3 float*)(lds + LDS_BIAS + tid * 4) = bvv;
        }
        if (tid == 0) {
            unsigned sp = 0; while (__hip_atomic_load(sy.flag, __ATOMIC_RELAXED, __HIP_MEMORY_SCOPE_AGENT) == 0) { __builtin_amdgcn_s_sleep(8); if (++sp > (1u << 20)) break; }
            if (sy.dep) { while (__hip_atomic_load(sy.dep, __ATOMIC_RELAXED, __HIP_MEMORY_SCOPE_AGENT) < sy.depn) { __builtin_amdgcn_s_sleep(8); if (++sp > (1u << 20)) break; } }
            __builtin_amdgcn_fence(__ATOMIC_ACQUIRE, "agent"); asm volatile("s_waitcnt vmcnt(0)" ::: "memory"); }
        __syncthreads();
    }
    f32x4 acc[2][2][4][2];
    gemm_kloop_dma<(EPI >= 2), (EPI >= 2), (EPI == 2) ? 0 : (EPI == 3) ? 128 : 2 * D, false, (EPI == 3) ? 32768 : 128>(acc, (const unsigned char*)g.A, aoff, img, (EPI >= 2) ? D / 128 : (EPI == 0 && kh >= 0) ? D / 128 : D / 64, lds, tid, wid, (EPI == 0 && kh > 0) ? D / 128 : 0);
    int tz = wid * 64 + lane_id(); asm volatile("" : "+v"(tz));
    if (EPI >= 2 && sy.pend && tz == 0) __hip_atomic_fetch_add(sy.pend, 1, __ATOMIC_RELAXED, __HIP_MEMORY_SCOPE_AGENT);
    unsigned nx = 0;
    if (EPI >= 2 && tz == 0) nx = __hip_atomic_fetch_add(sy.qctr, 1u, __ATOMIC_RELAXED, __HIP_MEMORY_SCOPE_AGENT);
    const int wid2 = tz >> 6, lane2 = tz & 63;
    const int row0 = (wid2 >> 2) * 64 + (lane2 & 15), colw = (wid2 & 3) * 16 + (lane2 >> 4) * 4;
    if (EPI == 0) {
#pragma unroll
        for (int ai = 0; ai < 2; ++ai)
#pragma unroll
            for (int m = 0; m < 4; ++m) {
                f32x4 v[2][2];
#pragma unroll
                for (int bj = 0; bj < 2; ++bj)
#pragma unroll
                    for (int n = 0; n < 2; ++n) v[bj][n] = acc[ai][bj][m][n];
                epi_stage_bf16(v, ai * 128 + row0 + m * 16, colw, lds);
            }
        if (kh > 0) epi_flush_bf16((bf16_t*)g.R, DIN - 4096, pm * 256, pn * 256 - 4096, 256, lds, tz);
        else epi_flush_bf16((bf16_t*)g.C, DIN, pm * 256, pn * 256, 256, lds, tz);
    } else if (EPI == 1) {
        float* C = (float*)g.C;
#pragma unroll
        for (int ai = 0; ai < 2; ++ai)
#pragma unroll
            for (int m = 0; m < 4; ++m) {
                const size_t ro = (size_t)(pm * 256 + ai * 128 + row0 + m * 16) * D + pn * 256 + colw;
#pragma unroll
                for (int bj = 0; bj < 2; ++bj)
#pragma unroll
                    for (int n = 0; n < 2; ++n) { const f32x4 xr = __builtin_nontemporal_load((const f32x4*)(g.R + ro + bj * 128 + n * 64));
                        *(f32x4*)(C + ro + bj * 128 + n * 64) = acc[ai][bj][m][n] + xr; }
            }
    } else if (EPI == 2) {
        unsigned char* C = (unsigned char*)g.C;
        f32x4 bgate[2], bup1[2];
#pragma unroll
        for (int n = 0; n < 2; ++n) { bgate[n] = *(LAS3 const f32x4*)(lds + LDS_BIAS + (n * 64 + colw) * 4); bup1[n] = *(LAS3 const f32x4*)(lds + LDS_BIAS + (128 + n * 64 + colw) * 4); }
#pragma unroll
        for (int ai = 0; ai < 2; ++ai)
#pragma unroll
            for (int m = 0; m < 4; ++m) {
                const int r = pm * 256 + ai * 128 + row0 + m * 16;
                {
                    LAS3 char* rp = lds + (ai * 128 + row0 + m * 16) * EST_F8 + colw;
#pragma unroll
                    for (int n = 0; n < 2; ++n) {
                        float o[4];
#pragma unroll
                        for (int j = 0; j < 4; j += 2) {
                            typedef float f32x2 __attribute__((ext_vector_type(2)));
                            f32x2 gt = (f32x2){acc[ai][0][m][n][j], acc[ai][0][m][n][j + 1]} + (f32x2){bgate[n][j], bgate[n][j + 1]};
                            f32x2 up = (f32x2){acc[ai][1][m][n][j], acc[ai][1][m][n][j + 1]} + (f32x2){bup1[n][j], bup1[n][j + 1]};
                            gt.x = fminf(gt.x, 7.0f); gt.y = fminf(gt.y, 7.0f);
                            up.x = __builtin_amdgcn_fmed3f(up.x, -6.0f, 8.0f); up.y = __builtin_amdgcn_fmed3f(up.y, -6.0f, 8.0f);
                            const f32x2 xe = gt * (-2.45546696f);
                            f32x2 ex; ex.x = __builtin_amdgcn_exp2f(xe.x); ex.y = __builtin_amdgcn_exp2f(xe.y);
                            const f32x2 den = ex + 1.0f;
                            f32x2 rc; rc.x = __builtin_amdgcn_rcpf(den.x); rc.y = __builtin_amdgcn_rcpf(den.y);
                            const f32x2 res = (gt * rc) * up;
                            o[j] = res.x; o[j + 1] = res.y;
                        }
                        int w = __builtin_amdgcn_cvt_pk_fp8_f32(o[0], o[1], 0, false);
                        w = __builtin_amdgcn_cvt_pk_fp8_f32(o[2], o[3], w, true);
                        *(LAS3 int*)(rp + n * 64) = w;
                    }
                }
            }
        { const int nv = ecnt - pm * 256; epi_flush_f8(C, DFF, g.abase + pm * 256, pn * 128, nv < 256 ? nv : 256, lds, tz); }
    } else {
        bf16_t* C = (bf16_t*)g.C;
        f32x4 bv[2][2];
#pragma unroll
        for (int bj = 0; bj < 2; ++bj)
#pragma unroll
            for (int n = 0; n < 2; ++n) bv[bj][n] = *(LAS3 const f32x4*)(lds + LDS_BIAS + (bj * 128 + n * 64 + colw) * 4);
#pragma unroll
        for (int ai = 0; ai < 2; ++ai)
#pragma unroll
            for (int m = 0; m < 4; ++m) {
                LAS3 char* rp = lds + (ai * 128 + row0 + m * 16) * EST_F8W + colw;
#pragma unroll
                for (int bj = 0; bj < 2; ++bj)
#pragma unroll
                    for (int n = 0; n < 2; ++n) { const f32x4 v = acc[ai][bj][m][n] + bv[bj][n];
                        int w = __builtin_amdgcn_cvt_pk_fp8_f32(v[0], v[1], 0, false); w = __builtin_amdgcn_cvt_pk_fp8_f32(v[2], v[3], w, true);
                        *(LAS3 int*)(rp + bj * 128 + n * 64) = w; }
            }
        { const int nv = ecnt - pm * 256; epi_flush_f8w((unsigned char*)g.C, D, ebase + pm * 256, pn * 256, nv < 256 ? nv : 256, lds, tz); }
    }
    if (EPI >= 2 && tz == 0) *sy.qslot = sy.qtag | nx;
}

#define XB_TMO      128
#define XB_XCNT(j)  (256  + 64 * (j))
#define XB_XSUB(j)  (1280 + 64 * (j))
#define XB_XGEN(j)  (2304 + 64 * (j))
#define XB_TOP      3328
#define XB_TOPGEN   3392
#define XCD_BAR_WORDS 3456
#define XB_SPIN_CAP (1u << 18)
#define LAS __attribute__((address_space(3)))

__device__ __forceinline__ unsigned xb_ld(unsigned* p)              { return __hip_atomic_load(p, __ATOMIC_RELAXED, __HIP_MEMORY_SCOPE_AGENT); }
__device__ __forceinline__ unsigned xb_add(unsigned* p, unsigned v) { return __hip_atomic_fetch_add(p, v, __ATOMIC_RELAXED, __HIP_MEMORY_SCOPE_AGENT); }
__device__ __forceinline__ unsigned xb_xcc_id() { return (unsigned)__builtin_amdgcn_s_getreg((3 << 11) | 20) & 0xFu; }
#define XB_SPIN(cond, bar) do { unsigned _sp = 0; while (cond) { __builtin_amdgcn_s_sleep(1); \
    if ((++_sp & 255u) == 0u) { if (xb_ld(&(bar)[XB_TMO])) break; if (_sp > XB_SPIN_CAP) { atomicAdd(&(bar)[XB_TMO], 1u); break; } } } } while (0)

struct XcdBarrier {
    unsigned* bar; unsigned x;
    volatile LAS unsigned* st;
};
__device__ __forceinline__ XcdBarrier xcd_barrier_post(unsigned* bar, volatile LAS unsigned* st, int tid) {
    XcdBarrier b; b.bar = bar; b.x = xb_xcc_id(); b.st = st;
    if (tid == 0) (void)xb_add(&bar[XB_XCNT(b.x)], 1u);
    return b;
}
__device__ __forceinline__ void xcd_barrier_complete(unsigned* bar, unsigned x, unsigned& nloc, unsigned& nx) {
    const unsigned G = gridDim.x * gridDim.y * gridDim.z;
    unsigned sum, cnt, mine, sp = 0u;
    for (;;) {
        sum = 0u; cnt = 0u; mine = 0u;
#pragma unroll
        for (unsigned j = 0; j < 16; ++j) { const unsigned c = xb_ld(&bar[XB_XCNT(j)]); sum += c; cnt += (c > 0u) ? 1u : 0u; mine = (j == x) ? c : mine; }
        if (sum == G) break;
        __builtin_amdgcn_s_sleep(1);
        if ((++sp & 255u) == 0u) { if (xb_ld(&bar[XB_TMO])) break; if (sp > XB_SPIN_CAP) { atomicAdd(&bar[XB_TMO], 1u); break; } }
    }
    nloc = mine > 0u ? mine : 1u; nx = cnt > 0u ? cnt : 1u;
}
__device__ __forceinline__ void xcd_barrier(const XcdBarrier& b, int tid) {
    asm volatile("s_waitcnt vmcnt(0)" ::: "memory");
    __syncthreads();
    if (tid == 0) {
        unsigned* bar = b.bar;
        __builtin_amdgcn_s_waitcnt(0);
        unsigned nloc = b.st[0], nx = b.st[1];
        if (nloc == 0u) { xcd_barrier_complete(bar, b.x, nloc, nx); b.st[0] = nloc; b.st[1] = nx; }
        const unsigned old = xb_add(&bar[XB_XSUB(b.x)], 1u);
        const unsigned gen = old / nloc;
        if (old + 1u == (gen + 1u) * nloc) {
            __builtin_amdgcn_fence(__ATOMIC_RELEASE, "agent");
            asm volatile("s_waitcnt vmcnt(0)" ::: "memory");
            const unsigned og = xb_add(&bar[XB_TOP], 1u);
            const unsigned tg = og / nx;
            if (og + 1u == (tg + 1u) * nx) xb_add(&bar[XB_TOPGEN], 1u);
            else XB_SPIN(xb_ld(&bar[XB_TOPGEN]) == tg, bar);
            __builtin_amdgcn_fence(__ATOMIC_ACQUIRE, "agent");
            xb_add(&bar[XB_XGEN(b.x)], 1u);
            asm volatile("s_waitcnt vmcnt(0)" ::: "memory");
        } else {
            XB_SPIN(xb_ld(&bar[XB_XGEN(b.x)]) == gen, bar);
            __builtin_amdgcn_fence(__ATOMIC_ACQUIRE, "agent");
            asm volatile("s_waitcnt vmcnt(0)" ::: "memory");
        }
    }
    __syncthreads();
}

struct Params {
    const float *x, *ln_mix_g, *w_in, *conv_w, *sgu_ln_g, *sgu_ln_b, *sgu_w, *sgu_b, *gn_conv, *gn_sgu, *w_out, *ln_ffn_g, *w_router, *b_router,
                *w_gate_up, *b_gate_up, *w_down, *b_down, *ln_final_g;
    float* out;
    unsigned* bar; int* cnt; int* list; int* sel; float* gates;
    bf16_t *xn, *proj, *proj2, *y, *xn2, *act, *outp; float* h;
    unsigned char *img_in, *img_out;
    unsigned char *img_gu, *img_dn;
    int* flag;
    unsigned* qctr;
    int* done;
};
constexpr int LDS_MISC = 256 * EST_BF16;
constexpr int LDS_TOTAL = LDS_MISC + 4096;

__device__ __forceinline__ void phase_rmsnorm(const float* __restrict__ x, const float* __restrict__ g, bf16_t* __restrict__ y, int wid) {
    int lane = lane_id(); asm volatile("" : "+v"(lane));
    for (int t = blockIdx.x * 8 + wid; t < T; t += gridDim.x * 8) {
        const float* xr = x + (size_t)t * D;
        f32x4 v[8]; float s = 0.f;
#pragma unroll
        for (int j = 0; j < 8; ++j) { v[j] = *(const f32x4*)(xr + j * 256 + lane * 4); s += v[j][0] * v[j][0] + v[j][1] * v[j][1] + v[j][2] * v[j][2] + v[j][3] * v[j][3]; }
        s = wave_sum(s);
        const float r = rsqrtf(s * (1.0f / D) + EPS);
#pragma unroll
        for (int j = 0; j < 8; ++j) {
            const f32x4 gg = *(const f32x4*)(g + j * 256 + lane * 4);
            u32x2 o; o.x = cvt_pk_bf16(v[j][0] * r * gg[0], v[j][1] * r * gg[1]); o.y = cvt_pk_bf16(v[j][2] * r * gg[2], v[j][3] * r * gg[3]);
            *(u32x2*)(y + (size_t)t * D + j * 256 + lane * 4) = o;
        }
    }
}

__device__ __forceinline__ float gelu_f(float v) {
    const float av = fabsf(v), dd = av * 0.2316418882f + 1.0f;
    const float tt = __builtin_amdgcn_rcpf(dd);
    float q = tt * 0.5307027145f + (-0.7265760135f); q = q * tt + 0.7107068705f; q = q * tt + (-0.142248368f); q = q * tt + 0.127414796f; q = q * tt;
    const float e = __builtin_amdgcn_exp2f((v * v) * (-0.72134752044f));
    const float m = v * (q * e);
    return v < 0.f ? m : v - m;
}
typedef float f32x16 __attribute__((ext_vector_type(16)));

__device__ __forceinline__ void phase_mixer(const Params& p, LAS3 char* lds, int wid) {
    int lane = lane_id(); asm volatile("" : "+v"(lane));
    const int n = lane & 31, kh = lane >> 5;
    const bf16_t* __restrict__ proj = p.proj;
    LAS3 float* stat = (LAS3 float*)(lds + 32768);
    const int nunits = (T / 128) * 16;
    for (int it = 0; it * (int)gridDim.x < nunits; ++it) {
        const int b = blockIdx.x;
        int u = it * gridDim.x + b;
        if (u >= nunits) break;
        int chunk, g;
        if ((gridDim.x & 15) == 0) { chunk = (b >> 4) + (gridDim.x >> 4) * it; g = ((b & 15) + 8 * (it & 1)) & 15; } else { chunk = u >> 4; g = u & 15; }
        const int t0 = chunk * 128;
        if (g < 8) {
            const int c = g * 128 + 2 * lane;
            const int r0 = t0 + 16 * wid;
            const bf16_t* base = proj + (size_t)r0 * DIN + c;
            const float w00 = p.conv_w[c], w01 = p.conv_w[c + 1], w10 = p.conv_w[DC + c], w11 = p.conv_w[DC + c + 1], w20 = p.conv_w[2 * DC + c], w21 = p.conv_w[2 * DC + c + 1];
            const float g0 = p.gn_conv[c], g1 = p.gn_conv[c + 1];
            const bool has_hist = ((r0 % SEQ) != 0);
            float z2a = 0.f, z2b = 0.f, z1a = 0.f, z1b = 0.f;
            if (has_hist) {
                const unsigned c2 = *(const unsigned*)(base - 2 * (ptrdiff_t)DIN + DC), h2 = *(const unsigned*)(base - 2 * (ptrdiff_t)DIN + 2 * DC);
                const unsigned c1 = *(const unsigned*)(base - (ptrdiff_t)DIN + DC), h1 = *(const unsigned*)(base - (ptrdiff_t)DIN + 2 * DC);
                z2a = bf16_lo(c2) * bf16_lo(h2); z2b = bf16_hi(c2) * bf16_hi(h2); z1a = bf16_lo(c1) * bf16_lo(h1); z1b = bf16_hi(c1) * bf16_hi(h1);
            }
#pragma unroll 1
            for (int hb = 0; hb < 16; hb += 8) {
                unsigned bg[8], cg[8], hg[8];
#pragma unroll
                for (int i = 0; i < 8; ++i) { bg[i] = *(const unsigned*)(base + (size_t)(hb + i) * DIN); cg[i] = *(const unsigned*)(base + (size_t)(hb + i) * DIN + DC); hg[i] = *(const unsigned*)(base + (size_t)(hb + i) * DIN + 2 * DC); }
#pragma unroll
                for (int i = 0; i < 8; ++i) {
                    const float z0a = bf16_lo(cg[i]) * bf16_lo(hg[i]), z0b = bf16_hi(cg[i]) * bf16_hi(hg[i]);
                    const float ya = bf16_lo(bg[i]) * (w00 * z2a + w10 * z1a + w20 * z0a);
                    const float yb = bf16_hi(bg[i]) * (w01 * z2b + w11 * z1b + w21 * z0b);
                    z2a = z1a; z2b = z1b; z1a = z0a; z1b = z0b;
                    const float ss = wave_sum(ya * ya + yb * yb);
                    const float rs = rsqrtf(ss * (1.0f / 128.0f) + EPS);
                    *(unsigned*)(p.y + (size_t)(r0 + hb + i) * D + c) = cvt_pk_bf16(ya * rs * g0, yb * rs * g1);
                }
            }
            __syncthreads(); __syncthreads(); __syncthreads();
        } else {
            const int hd = g - 8;
            {
                const int s0 = 16 * wid + 8 * kh;
                const bf16_t* vb = proj + (size_t)(t0 + s0) * DIN + 4096 + hd * 128 + 4 * n;
                const bf16_t* vb2 = p.proj2 + (size_t)(t0 + s0) * (DIN - 4096) + hd * 128 + 4 * n;
                u32x2 raw[8], raw2[8];
#pragma unroll
                for (int j = 0; j < 8; ++j) { raw[j] = *(const u32x2*)(vb + (size_t)j * DIN); raw2[j] = *(const u32x2*)(vb2 + (size_t)j * (DIN - 4096)); }
                const f32x4 lg = *(const f32x4*)(p.sgu_ln_g + hd * 128 + 4 * n), lb = *(const f32x4*)(p.sgu_ln_b + hd * 128 + 4 * n);
                float vn[8][4];
#pragma unroll
                for (int j = 0; j < 8; ++j) {
                    const float a0 = gelu_f(bf16_lo(raw[j].x) + bf16_lo(raw2[j].x)), a1 = gelu_f(bf16_hi(raw[j].x) + bf16_hi(raw2[j].x)), a2 = gelu_f(bf16_lo(raw[j].y) + bf16_lo(raw2[j].y)), a3 = gelu_f(bf16_hi(raw[j].y) + bf16_hi(raw2[j].y));
                    const float mu = half_sum32((a0 + a1) + (a2 + a3)) * (1.0f / 128.0f);
                    const float d0 = a0 - mu, d1 = a1 - mu, d2 = a2 - mu, d3 = a3 - mu;
                    const float rs = rsqrtf(half_sum32((d0 * d0 + d1 * d1) + (d2 * d2 + d3 * d3)) * (1.0f / 128.0f) + EPS);
                    vn[j][0] = d0 * rs * lg[0] + lb[0]; vn[j][1] = d1 * rs * lg[1] + lb[1]; vn[j][2] = d2 * rs * lg[2] + lb[2]; vn[j][3] = d3 * rs * lg[3] + lb[3];
                }
                __syncthreads();
#pragma unroll
                for (int c = 0; c < 4; ++c) {
                    u32x4 f; f.x = cvt_pk_bf16(vn[0][c], vn[1][c]); f.y = cvt_pk_bf16(vn[2][c], vn[3][c]); f.z = cvt_pk_bf16(vn[4][c], vn[5][c]); f.w = cvt_pk_bf16(vn[6][c], vn[7][c]);
                    *(LAS3 u32x4*)(lds + ((wid * 4 + c) * 64 + lane) * 16) = f;
                }
            }
            __syncthreads();
            {
                const int mt = wid >> 1, cp = (wid & 1) * 2;
                const int trow = 32 * mt + n;
                const float* Wr = p.sgu_w + (size_t)hd * 16384 + (size_t)trow * 128 + 8 * kh;
                f32x16 acc0, acc1;
#pragma unroll
                for (int r = 0; r < 16; ++r) { acc0[r] = 0.f; acc1[r] = 0.f; }
                for (int ks = 0; ks <= 2 * mt + 1; ++ks) {
                    const f32x4 wa = *(const f32x4*)(Wr + 16 * ks), wb = *(const f32x4*)(Wr + 16 * ks + 4);
                    const int sb = 16 * ks + 8 * kh;
                    float wv[8] = {wa[0], wa[1], wa[2], wa[3], wb[0], wb[1], wb[2], wb[3]};
#pragma unroll
                    for (int j = 0; j < 8; ++j) wv[j] = (sb + j <= trow) ? wv[j] : 0.f;
                    u32x4 af; af.x = cvt_pk_bf16(wv[0], wv[1]); af.y = cvt_pk_bf16(wv[2], wv[3]); af.z = cvt_pk_bf16(wv[4], wv[5]); af.w = cvt_pk_bf16(wv[6], wv[7]);
                    const u32x4 b0 = *(LAS3 const u32x4*)(lds + ((ks * 4 + cp) * 64 + lane) * 16);
                    const u32x4 b1 = *(LAS3 const u32x4*)(lds + ((ks * 4 + cp + 1) * 64 + lane) * 16);
                    acc0 = __builtin_amdgcn_mfma_f32_32x32x16_bf16(__builtin_bit_cast(bf16x8, af), __builtin_bit_cast(bf16x8, b0), acc0, 0, 0, 0);
                    acc1 = __builtin_amdgcn_mfma_f32_32x32x16_bf16(__builtin_bit_cast(bf16x8, af), __builtin_bit_cast(bf16x8, b1), acc1, 0, 0, 0);
                }
                const bf16_t* ub = proj + (size_t)t0 * DIN + 3072 + hd * 128 + 4 * n + cp;
                float ya[16], yb[16];
#pragma unroll
                for (int r = 0; r < 16; ++r) {
                    const int tt = 32 * mt + (r & 3) + 8 * (r >> 2) + 4 * kh;
                    const unsigned uu = *(const unsigned*)(ub + (size_t)tt * DIN);
                    const float bias = p.sgu_b[hd * 128 + tt];
                    ya[r] = gelu_f(bf16_lo(uu)) * (acc0[r] + bias);
                    yb[r] = gelu_f(bf16_hi(uu)) * (acc1[r] + bias);
                    const float ps = half_sum32(ya[r] * ya[r] + yb[r] * yb[r]);
                    if (n == 0) stat[tt * 2 + (wid & 1)] = ps;
                }
                __syncthreads();
                const float g0 = p.gn_sgu[hd * 128 + 4 * n + cp], g1 = p.gn_sgu[hd * 128 + 4 * n + cp + 1];
#pragma unroll
                for (int r = 0; r < 16; ++r) {
                    const int tt = 32 * mt + (r & 3) + 8 * (r >> 2) + 4 * kh;
                    const float rs = rsqrtf((stat[tt * 2] + stat[tt * 2 + 1]) * (1.0f / 128.0f) + EPS);
                    *(unsigned*)(p.y + (size_t)(t0 + tt) * D + DC + hd * 128 + 4 * n + cp) = cvt_pk_bf16(ya[r] * rs * g0, yb[r] * rs * g1);
                }
            }
        }
    }
}

__device__ __forceinline__ void phase_router(const Params& p, LAS3 char* lds, int wid) {
    LAS3 float* part = (LAS3 float*)lds;
    LAS3 float* ssqp = (LAS3 float*)(lds + 34816);
    LAS3 float* logit = (LAS3 float*)(lds + 36864);
    LAS3 float* rstd = (LAS3 float*)(lds + 41984);
    LAS3 int* lhist = (LAS3 int*)(lds + 42240);
    LAS3 int* gbase = (LAS3 int*)(lds + 42368);
    int lane = lane_id(); asm volatile("" : "+v"(lane));
    const int n = lane & 31, kh = lane >> 5, tid = wid * 64 + lane;
    for (int grp = blockIdx.x; grp < T / 32; grp += gridDim.x) {
        const int t0 = grp * 32;
        __syncthreads();
        if (tid < 32) lhist[tid] = 0;
        {
            const float* hrow = p.h + (size_t)(t0 + n) * D + wid * 256 + 4 * kh;
            const float* grow = p.ln_ffn_g + wid * 256 + 4 * kh;
            const float* wrow = p.w_router + (size_t)(wid * 256 + 4 * kh) * 32 + n;
            f32x16 acc;
#pragma unroll
            for (int r = 0; r < 16; ++r) acc[r] = 0.f;
            float ssq = 0.f;
#pragma unroll 1
            for (int jj = 0; jj < 32; jj += 8) {
                f32x4 hv[8], gv[8];
#pragma unroll
                for (int j = 0; j < 8; ++j) { hv[j] = *(const f32x4*)(hrow + 8 * (jj + j)); gv[j] = *(const f32x4*)(grow + 8 * (jj + j)); }
#pragma unroll
                for (int j = 0; j < 8; ++j)
#pragma unroll
                    for (int i = 0; i < 4; ++i) {
                        const float a = hv[j][i];
                        ssq += a * a;
                        const float bw = wrow[(size_t)(8 * (jj + j) + i) * 32];
                        acc = __builtin_amdgcn_mfma_f32_32x32x2f32(a * gv[j][i], bw, acc, 0, 0, 0);
                    }
            }
            ssq += xor32(ssq);
            if (kh == 0) ssqp[wid * 32 + n] = ssq;
#pragma unroll
            for (int r = 0; r < 16; ++r) part[(wid * 32 + ((r & 3) + 8 * (r >> 2) + 4 * kh)) * 33 + n] = acc[r];
        }
        __syncthreads();
        if (tid < 32) { float s = 0.f;
#pragma unroll
            for (int w = 0; w < 8; ++w) s += ssqp[w * 32 + tid];
            rstd[tid] = rsqrtf(s * (1.0f / D) + EPS); }
        __syncthreads();
#pragma unroll
        for (int i = 0; i < 2; ++i) {
            const int idx = tid + 512 * i, tk = idx >> 5, e = idx & 31;
            float s = 0.f;
#pragma unroll
            for (int w = 0; w < 8; ++w) s += part[(w * 32 + tk) * 33 + e];
            logit[tk * 33 + e] = s * rstd[tk] + p.b_router[e];
        }
        __syncthreads();
        int se[4] = {0, 0, 0, 0}, sl[4] = {0, 0, 0, 0}; float sx[4] = {0.f, 0.f, 0.f, 0.f}; float sden = 1.f;
        if (tid < 32) {
            float v0 = 0.f; sden = 0.f;
#pragma unroll
            for (int k = 0; k < 4; ++k) {
                int bi = 0; float bv = -3.0e38f;
                for (int i = 0; i < 32; ++i) { const float l = logit[tid * 33 + i]; if (l > bv) { bv = l; bi = i; } }
                logit[tid * 33 + bi] = -3.4e38f;
                if (k == 0) v0 = bv;
                sx[k] = __expf(bv - v0); sden += sx[k];
                se[k] = bi; sl[k] = atomicAdd((int*)&lhist[bi], 1);
            }
        }
        __syncthreads();
        if (tid < 32) { const int c = lhist[tid]; gbase[tid] = c ? atomicAdd(&p.cnt[tid], c) : 0; }
        __syncthreads();
        if (tid < 32) {
            const int t = t0 + tid;
            const float inv = 1.0f / sden;
#pragma unroll
            for (int k = 0; k < 4; ++k) {
                const int slot = gbase[se[k]] + sl[k];
                p.gates[t * 4 + k] = sx[k] * inv;
                p.list[se[k] * T + slot] = t * 4 + k;
                p.sel[t * 4 + k] = (se[k] << 16) | slot;
            }
        }
#pragma unroll 1
        for (int q = 0; q < 4; ++q) {
            const int tk = wid * 4 + q;
            const float r = rstd[tk];
            const float* hr = p.h + (size_t)(t0 + tk) * D;
#pragma unroll
            for (int j = 0; j < 8; ++j) {
                const f32x4 hv = *(const f32x4*)(hr + j * 256 + lane * 4), gg = *(const f32x4*)(p.ln_ffn_g + j * 256 + lane * 4);
                int o = __builtin_amdgcn_cvt_pk_fp8_f32(hv[0] * r * gg[0], hv[1] * r * gg[1], 0, false);
                o = __builtin_amdgcn_cvt_pk_fp8_f32(hv[2] * r * gg[2], hv[3] * r * gg[3], o, true);
                *(int*)((unsigned char*)p.xn2 + (size_t)(t0 + tk) * D + j * 256 + lane * 4) = o;
            }
        }
    }
}

__device__ __forceinline__ void phase_final(const Params& p, LAS3 char* lds, int wid) {
    LAS3 int* base = (LAS3 int*)(lds + LDS_MISC + 2048);
    int lane = lane_id(); asm volatile("" : "+v"(lane));
    if (wid == 0 && lane == 0) { int a = 0; for (int i = 0; i < NE; ++i) { base[i] = a; a += p.cnt[i]; } }
    __syncthreads();
    for (int t = blockIdx.x * 8 + wid; t < T; t += gridDim.x * 8) {
        float gk[4]; const unsigned char* op[4];
#pragma unroll
        for (int k = 0; k < 4; ++k) { const int s = p.sel[t * 4 + k]; gk[k] = p.gates[t * 4 + k]; op[k] = (const unsigned char*)p.outp + (size_t)(base[s >> 16] + (s & 0xffff)) * D; }
        f32x4 v[8]; float ss = 0.f;
#pragma unroll
        for (int j = 0; j < 8; ++j) {
            const int c = j * 256 + lane * 4;
            f32x4 a = __builtin_nontemporal_load((const f32x4*)(p.h + (size_t)t * D + c));
#pragma unroll
            for (int k = 0; k < 4; ++k) { const int o = __builtin_nontemporal_load((const int*)(op[k] + c));
                typedef float f32x2 __attribute__((ext_vector_type(2)));
                const f32x2 lo = __builtin_amdgcn_cvt_pk_f32_fp8(o, false), hi = __builtin_amdgcn_cvt_pk_f32_fp8(o, true);
                a[0] += gk[k] * lo.x; a[1] += gk[k] * lo.y; a[2] += gk[k] * hi.x; a[3] += gk[k] * hi.y; }
            v[j] = a; ss += a[0] * a[0] + a[1] * a[1] + a[2] * a[2] + a[3] * a[3];
        }
        ss = wave_sum(ss);
        const float r = rsqrtf(ss * (1.0f / D) + EPS);
#pragma unroll
        for (int j = 0; j < 8; ++j) { const int c = j * 256 + lane * 4; const f32x4 gg = *(const f32x4*)(p.ln_final_g + c);
            f32x4 o; o[0] = v[j][0] * r * gg[0]; o[1] = v[j][1] * r * gg[1]; o[2] = v[j][2] * r * gg[2]; o[3] = v[j][3] * r * gg[3];
            __builtin_nontemporal_store(o, (f32x4*)(p.out + (size_t)t * D + c)); }
    }
}

__device__ __forceinline__ void expert_span(const int* cnt, int e, int& ebase, int& ecnt, int& abase) {
    const int l = lane_id();
    const int c = (l < NE) ? cnt[l] : 0;
    ebase = __builtin_amdgcn_readfirstlane((int)wave_sum((l < e) ? (float)c : 0.0f));
    abase = 256 * __builtin_amdgcn_readfirstlane((int)wave_sum((l < e) ? (float)((c + 255) >> 8) : 0.0f));
    ecnt = __builtin_amdgcn_readlane(c, e);
}

#ifndef MOE_MERGED
#define MOE_MERGED 1
#endif
#ifndef MOE_LAG2
#define MOE_LAG2 16
#define MOE_LAG3 16
#endif
__device__ __forceinline__ int wave_imax(int v) {
#define SWZ_XORI(v, o) __builtin_amdgcn_ds_swizzle(v, ((o) << 10) | 0x1F)
    v = max(v, SWZ_XORI(v, 16)); v = max(v, SWZ_XORI(v, 8)); v = max(v, SWZ_XORI(v, 4)); v = max(v, SWZ_XORI(v, 2)); v = max(v, SWZ_XORI(v, 1));
    const int l = lane_id(); return max(v, __builtin_amdgcn_ds_bpermute((l ^ 32) << 2, v));
#undef SWZ_XORI
}
template <int EPI>
__device__ __forceinline__ int* moe_phase(const Params& p, LAS3 char* lds, int wid, int* pend_in) {
    constexpr int NCQ = (EPI == 2) ? 2 : 1, NS = NE * NCQ, NCOL = NCQ * 8, MOE_LAG = (EPI == 2) ? MOE_LAG2 : MOE_LAG3;
    unsigned* qctr = p.qctr + ((EPI == 2) ? 0 : 8);
    LAS3 unsigned* slot = (LAS3 unsigned*)(lds + LDS_MISC + 64);
    constexpr int NSL = NS + MOE_LAG;
    LAS3 int* pre = (LAS3 int*)(lds + LDS_MISC + 256);
    LAS3 int* mtv = (LAS3 int*)(lds + LDS_MISC + 768);
    static_assert(NSL + 1 <= 128, "prefix table size");
    __syncthreads();
    { const int t0 = wid * 64 + lane_id(); if (t0 < NE) mtv[t0] = (p.cnt[t0] + 255) >> 8; }
    __syncthreads();
    { const int t0 = wid * 64 + lane_id();
      if (t0 == 0) { int a = 0;
          for (int s = 0; s <= NSL; ++s) { pre[s] = a;
              if (s < NSL) { int nv = (s < NS && mtv[s / NCQ] > 0) ? 1 : 0; const int sc = s - MOE_LAG;
                  if (sc >= 0 && sc < NS) { const int m = mtv[sc / NCQ]; nv += (m > 1) ? m - 1 : 0; }
                  a += nv; } } } }
    __syncthreads();
    const int total = __builtin_amdgcn_readfirstlane(pre[NSL]);
    const int q0 = (int)(xb_xcc_id() & 7u);
    GemmArgs g{};
    if (EPI == 2) { g.A = p.xn2; g.B = p.w_gate_up; g.C = p.act; g.bias = p.b_gate_up; g.list = p.list; }
    else { g.A = p.act; g.B = p.w_down; g.C = p.outp; g.bias = p.b_down; }
    __syncthreads();
    { const int t0 = wid * 64 + lane_id(); if (t0 == 0) slot[0] = ((unsigned)q0 << 20) | __hip_atomic_fetch_add(&qctr[q0], 1u, __ATOMIC_RELAXED, __HIP_MEMORY_SCOPE_AGENT); }
    int* pend = pend_in;
    int par = 0;
    for (;;) {
        __syncthreads();
        const unsigned code = (unsigned)__builtin_amdgcn_readfirstlane((int)slot[par]);
        if (code == 0xFFFFFFFFu) break;
        const int qq = (int)(code >> 20), i = (int)(code & 0xFFFFFu);
        bool ran = false;
        if (i < total) {
            int s, j;
            { const int l = lane_id();
              const bool c1 = (l + 1 <= NSL) && (pre[(l + 1 <= NSL) ? l + 1 : 0] <= i), c2 = (l + 65 <= NSL) && (pre[(l + 65 <= NSL) ? l + 65 : 0] <= i);
              s = __builtin_popcountll(__builtin_amdgcn_ballot_w64(c1)) + __builtin_popcountll(__builtin_amdgcn_ballot_w64(c2));
              j = i - __builtin_amdgcn_readfirstlane(pre[s]); }
            const bool hasP = (s < NS) && (__builtin_amdgcn_readfirstlane(mtv[(s < NS) ? s / NCQ : 0]) > 0);
            const int k = (hasP && j == 0) ? 0 : j + (hasP ? 0 : 1);
            const int sl = (k == 0) ? s : s - MOE_LAG;
            if (sl >= 0 && sl < NS) {
                const int e = sl / NCQ, pn = qq + 8 * (sl % NCQ);
                int ebase, ecnt, abase; expert_span(p.cnt, e, ebase, ecnt, abase); g.abase = abase;
                if (k < ((ecnt + 255) >> 8)) {
                    TileSync sy{}; sy.flag = p.flag + ((EPI == 2) ? 0 : NE * 16) + e * NCOL + pn; sy.qctr = qctr + qq; sy.qtag = (unsigned)qq << 20; sy.qslot = slot + (par ^ 1);
                    if (MOE_MERGED) { sy.pend = pend; if (EPI == 3) { sy.dep = p.done + e * 32 + k; sy.depn = 16; } }
                    unsigned char* img = ((EPI == 2) ? p.img_gu : p.img_dn) + (size_t)(e * NCOL + pn) * 524288;
                    if (k == 0) gemm_tile<EPI>(g, 0, pn, e, ebase, ecnt, lds, wid, img, sy);
                    else gemm_tile_img<EPI>(g, k, pn, e, ebase, ecnt, lds, wid, img, sy);
                    pend = (MOE_MERGED && EPI == 2) ? p.done + e * 32 + k : nullptr;
                    ran = true;
                }
            }
            if (!ran) { const int t0 = wid * 64 + lane_id();
                if (t0 == 0) slot[par ^ 1] = ((unsigned)qq << 20) | __hip_atomic_fetch_add(&qctr[qq], 1u, __ATOMIC_RELAXED, __HIP_MEMORY_SCOPE_AGENT); }
        } else {
            const int t0 = wid * 64 + lane_id();
            if (t0 == 0) { unsigned cv[8];
                unsigned qx; asm volatile("s_getreg_b32 %0, hwreg(HW_REG_XCC_ID, 0, 3)" : "=s"(qx));
#pragma unroll
                for (int d = 0; d < 8; ++d) cv[d] = __hip_atomic_load(&qctr[(qx + d) & 7u], __ATOMIC_RELAXED, __HIP_MEMORY_SCOPE_AGENT);
                unsigned c = 0xFFFFFFFFu;
#pragma unroll
                for (int d = 7; d >= 0; --d) if (cv[d] < (unsigned)total) c = (qx + d) & 7u;
                if (c != 0xFFFFFFFFu) c = (c << 20) | __hip_atomic_fetch_add(&qctr[c], 1u, __ATOMIC_RELAXED, __HIP_MEMORY_SCOPE_AGENT);
                slot[par ^ 1] = c; }
        }
        par ^= 1;
    }
    return pend;
}

__global__ void __launch_bounds__(512, 2) k_mega(Params p) {
    extern __shared__ __attribute__((aligned(16))) char smem[];
    LAS3 char* lds = (LAS3 char*)smem;
    volatile LAS unsigned* xbw = (volatile LAS unsigned*)(lds + LDS_MISC);
    int wid = __builtin_amdgcn_readfirstlane((int)(threadIdx.x >> 6)); asm volatile("" : "+s"(wid));
    const int tid0 = wid * 64 + lane_id();
    if (tid0 == 0) { xbw[0] = 0u; xbw[1] = 0u; xbw[2] = 0u; xbw[3] = 0u; }
    __syncthreads();
    XcdBarrier bar = xcd_barrier_post(p.bar, xbw, tid0);
    const int nb = gridDim.x;
    const int vb = ((nb & 7) == 0) ? (int)(blockIdx.x & 7) * (nb >> 3) + (int)(blockIdx.x >> 3) : (int)blockIdx.x;

    if (blockIdx.x == 0 && tid0 < NE) p.cnt[tid0] = 0;
    phase_rmsnorm(p.x, p.ln_mix_g, p.xn, wid);
    for (int it = vb; it < 28 * 4; it += nb) {
        const int tile = it >> 2, kq = it & 3;
        if (tile < 20) convert_tile<false, DIN>(p.w_in + (size_t)kq * 512 * DIN, tile * 256, tile * 256 + 128, 8, p.img_in + (size_t)tile * 1048576 + (size_t)kq * 8 * 32768, lds, wid);
        else convert_tile<false, D>(p.w_out + (size_t)kq * 512 * D, (tile - 20) * 256, (tile - 20) * 256 + 128, 8, p.img_out + (size_t)(tile - 20) * 1048576 + (size_t)kq * 8 * 32768, lds, wid);
    }
    xcd_barrier(bar, wid * 64 + lane_id());
    { GemmArgs g{}; g.A = p.xn; g.C = p.proj; g.R = (const float*)p.proj2;
      for (int u = vb; u < 32 * 16 + 256; u += nb) {
          if (u < 32 * 16) gemm_tile_img<0>(g, u & 31, u >> 5, 0, 0, T, lds, wid, p.img_in + (size_t)(u >> 5) * 1048576, TileSync{});
          else { const int v = u - 32 * 16, pn = 16 + (v >> 6), pm = v & 31, kh = (v >> 5) & 1;
                 gemm_tile_img<0>(g, pm, pn, 0, 0, T, lds, wid, p.img_in + (size_t)pn * 1048576, TileSync{}, kh); } } }
    xcd_barrier(bar, wid * 64 + lane_id());
    phase_mixer(p, lds, wid);
    xcd_barrier(bar, wid * 64 + lane_id());
    { GemmArgs g{}; g.A = p.y; g.C = p.h; g.R = p.x;
      for (int u = vb; u < 32 * 8; u += nb) gemm_tile_img<1>(g, u & 31, u >> 5, 0, 0, T, lds, wid, p.img_out + (size_t)(u >> 5) * 1048576, TileSync{}); }
    xcd_barrier(bar, wid * 64 + lane_id());
    phase_router(p, lds, wid);
    xcd_barrier(bar, wid * 64 + lane_id());
    { int* pend = moe_phase<2>(p, lds, wid, nullptr);
      if (pend) {
          asm volatile("s_waitcnt vmcnt(0)" ::: "memory"); __syncthreads();
          const int t0 = wid * 64 + lane_id(); if (t0 == 0) __hip_atomic_fetch_add(pend, 1, __ATOMIC_RELAXED, __HIP_MEMORY_SCOPE_AGENT); }
      if (!MOE_MERGED) xcd_barrier(bar, wid * 64 + lane_id());
      (void)moe_phase<3>(p, lds, wid, nullptr); }
    xcd_barrier(bar, wid * 64 + lane_id());
    phase_final(p, lds, wid);
}
}

extern "C" void kernel_launch(void* const* d_in, const int* in_sizes, int n_in, void* d_out, int out_size, void* d_ws, size_t ws_size,
                              hipStream_t stream) {
    Params p{};
    p.x = (const float*)d_in[0]; p.ln_mix_g = (const float*)d_in[1]; p.w_in = (const float*)d_in[2]; p.conv_w = (const float*)d_in[3];
    p.sgu_ln_g = (const float*)d_in[4]; p.sgu_ln_b = (const float*)d_in[5]; p.sgu_w = (const float*)d_in[6]; p.sgu_b = (const float*)d_in[7];
    p.gn_conv = (const float*)d_in[8]; p.gn_sgu = (const float*)d_in[9]; p.w_out = (const float*)d_in[10]; p.ln_ffn_g = (const float*)d_in[11];
    p.w_router = (const float*)d_in[12]; p.b_router = (const float*)d_in[13]; p.w_gate_up = (const float*)d_in[14]; p.b_gate_up = (const float*)d_in[15];
    p.w_down = (const float*)d_in[16]; p.b_down = (const float*)d_in[17]; p.ln_final_g = (const float*)d_in[18];
    p.out = (float*)d_out;

    char* ws = (char*)d_ws;
    size_t off = 0;
    auto take = [&](size_t bytes) { char* q = ws + off; off += (bytes + 255) & ~(size_t)255; return q; };
    constexpr int SYNC_WORDS = XCD_BAR_WORDS + NE * 24 + 64 + NE * 32;
    p.bar = (unsigned*)take(SYNC_WORDS * 4);
    p.flag = (int*)(p.bar + XCD_BAR_WORDS); p.qctr = p.bar + XCD_BAR_WORDS + NE * 24; p.done = (int*)(p.bar + XCD_BAR_WORDS + NE * 24 + 64);
    p.cnt = (int*)take(256);
    p.list = (int*)take((size_t)NE * T * 4);
    p.sel = (int*)take((size_t)NPAIR * 4);
    p.gates = (float*)take((size_t)NPAIR * 4);
    p.xn = (bf16_t*)take((size_t)T * D * 2);
    p.proj = (bf16_t*)take((size_t)T * DIN * 2);
    p.proj2 = (bf16_t*)take((size_t)T * (DIN - 4096) * 2);
    p.y = (bf16_t*)take((size_t)T * D * 2);
    p.h = (float*)take((size_t)T * D * 4);
    p.xn2 = (bf16_t*)take((size_t)T * D * 2);
    p.act = (bf16_t*)take((size_t)(ACT_ROWS + NE * 256) * DFF * 2);
    p.outp = (bf16_t*)take((size_t)ACT_ROWS * D * 2);
    p.img_in = (unsigned char*)take((size_t)20 * 1048576);
    p.img_out = (unsigned char*)take((size_t)8 * 1048576);
    p.img_gu = (unsigned char*)take((size_t)NE * 16 * 524288);
    p.img_dn = (unsigned char*)take((size_t)NE * 8 * 524288);
    if (off > ws_size) { fprintf(stderr, "workspace too small: need %zu have %zu\n", off, ws_size); return; }

    static int grid = 0;
    if (!grid) {
        int dev = 0, cus = 0, per_cu = 0;
        (void)hipGetDevice(&dev);
        (void)hipDeviceGetAttribute(&cus, hipDeviceAttributeMultiprocessorCount, dev);
        (void)hipFuncSetAttribute((const void*)k_mega, hipFuncAttributeMaxDynamicSharedMemorySize, LDS_TOTAL);
        (void)hipOccupancyMaxActiveBlocksPerMultiprocessor(&per_cu, (const void*)k_mega, 512, LDS_TOTAL);
        if (per_cu < 1) { fprintf(stderr, "occupancy query says 0 blocks per CU\n"); per_cu = 1; }
        grid = cus * 1;
    }
    (void)hipMemsetAsync(p.bar, 0, SYNC_WORDS * 4, stream);
    k_mega<<<grid, 512, LDS_TOTAL, stream>>>(p);
}
```

```cpp
#include <hip/hip_runtime.h>
#include <stdint.h>
#include <stdio.h>

namespace {
constexpr int T = 8192, D = 2048, DIN = 5120, DC = 1024, NE = 32, DFF = 2048, SEQ = 4096;
constexpr int NPAIR = T * 4, ACT_ROWS = NPAIR + 256;
constexpr float EPS = 1e-5f;

#define LAS3 __attribute__((address_space(3)))
typedef short bf16x8 __attribute__((ext_vector_type(8)));
typedef float f32x4 __attribute__((ext_vector_type(4)));
typedef unsigned u32x4 __attribute__((ext_vector_type(4)));
typedef unsigned u32x2 __attribute__((ext_vector_type(2)));
typedef unsigned short bf16_t;

constexpr int GBK = 64, GHTB = 128 * 64 * 2;
constexpr int GEMM_LDS = 8 * GHTB;

__device__ __forceinline__ unsigned cvt_pk_bf16(float lo, float hi) {
    unsigned r; asm("v_cvt_pk_bf16_f32 %0, %1, %2" : "=v"(r) : "v"(lo), "v"(hi)); return r;
}
__device__ __forceinline__ float bf16_lo(unsigned u) { return __uint_as_float(u << 16); }
__device__ __forceinline__ float bf16_hi(unsigned u) { return __uint_as_float(u & 0xffff0000u); }

__device__ __forceinline__ void dma16(const void* sbase, unsigned voff, unsigned lds_dst) {
    unsigned keep;
    asm volatile("s_mov_b32 %0, m0\n\ts_mov_b32 m0, %3\n\ts_nop 2\n\tglobal_load_lds_dwordx4 %1, %2\n\ts_mov_b32 m0, %0"
                 : "=&s"(keep) : "v"(voff), "s"(sbase), "s"(lds_dst) : "memory");
}
#define G_WAIT_V(n) asm volatile("s_waitcnt vmcnt(" #n ")" ::: "memory")
#define G_WAIT_L(n) asm volatile("s_waitcnt lgkmcnt(" #n ")" ::: "memory")
#define G_BAR do { asm volatile("" ::: "memory"); __builtin_amdgcn_s_barrier(); asm volatile("" ::: "memory"); } while (0)
#define G_SCHED __builtin_amdgcn_sched_barrier(0)

template <int LDB, int VAR = 0>
__device__ __forceinline__ void gemm_kloop(f32x4 (&acc)[2][2][4][2], const bf16_t* __restrict__ A, const unsigned (&aoff)[2][2],
                                           const float* __restrict__ B, unsigned boff, int nt, LAS3 char* lds, int tid, int wid, size_t astep = GBK, size_t bstep = (size_t)GBK * LDB) {
    const int lane = tid & 63, wr = wid >> 2, wc = wid & 3, fr = lane & 15, fq = lane >> 4;
    const int c0 = fq ^ (fr >> 1);
    const int a_rd0 = (wr * 64 + fr) * 128 + c0 * 16, a_rd1 = (wr * 64 + fr) * 128 + (c0 ^ 4) * 16;
    const int b_rd0 = (wc * 16 + fr) * 128 + ((c0 ^ (wc & 1)) * 16), b_rd1 = (wc * 16 + fr) * 128 + ((c0 ^ (wc & 1) ^ 4) * 16);
    const int k8 = wid, n4 = tid & 63, bhalf = n4 >> 5, nloc = (n4 & 31) * 4;
    const int sw0 = (((n4 & 3) * 2) & 7) ^ ((n4 >> 2) & 1), sw1 = (((n4 & 3) * 2 + 1) & 7) ^ ((n4 >> 2) & 1);
    const int b_wr0 = (4 + bhalf) * GHTB + nloc * 128 + ((k8 ^ sw0) << 4);
    const int b_wr1 = (4 + bhalf) * GHTB + (nloc + 2) * 128 + ((k8 ^ sw1) << 4);
    const unsigned boffb = boff * 4u;
    const unsigned lds_u = (unsigned)(unsigned long)lds;
    const unsigned bw_a0 = lds_u + (unsigned)b_wr0, bw_a1 = lds_u + (unsigned)b_wr1;
    const int a_dma0 = wid * 1024, a_dma1 = (8 + wid) * 1024;

#define SA_(b, h) (((b) * 2 + (h)) * GHTB)
#define SB_(b, h) ((4 + (b) * 2 + (h)) * GHTB)
#define STAGE_A(b, h, kt) do { const bf16_t* _g = A + (size_t)(kt) * astep; \
        dma16((const void*)_g, aoff[h][0], lds_u + SA_(b, h) + a_dma0); \
        dma16((const void*)_g, aoff[h][1], lds_u + SA_(b, h) + a_dma1); } while (0)
#define BLOAD2(R, kt, j0) asm volatile("s_nop 4\n\tglobal_load_dwordx4 %0, %2, %3\n\tglobal_load_dwordx4 %1, %2, %4" \
        : "=&v"(R[(j0) & 3]), "=&v"(R[((j0) & 3) + 1]) : "v"(boffb), "s"(B + (size_t)(kt) * bstep + (size_t)(j0) * LDB), "s"(B + (size_t)(kt) * bstep + (size_t)((j0) + 1) * LDB) : "memory")
#define BWAIT(R, n) asm volatile("s_waitcnt vmcnt(" #n ")" : "+v"(R[0]), "+v"(R[1]), "+v"(R[2]), "+v"(R[3]) :: "memory")
#define BWRITE_H(R, b, hi) do { _Pragma("unroll") for (int _i = 0; _i < 4; ++_i) { u32x2 _w; \
            _w.x = cvt_pk_bf16(R[0][_i], R[1][_i]); _w.y = cvt_pk_bf16(R[2][_i], R[3][_i]); \
            asm volatile("ds_write_b64 %0, %1 offset:%2" :: "v"((_i < 2) ? bw_a0 : bw_a1), "v"(_w), "n"((b) * 2 * GHTB + (_i & 1) * 128 + (hi) * 8) : "memory"); } } while (0)
#define LDA(dst, b, h) do { _Pragma("unroll") for (int _m = 0; _m < 4; ++_m) { \
        dst[_m][0] = *(LAS3 const bf16x8*)(lds + SA_(b, h) + a_rd0 + _m * 2048); \
        dst[_m][1] = *(LAS3 const bf16x8*)(lds + SA_(b, h) + a_rd1 + _m * 2048); } } while (0)
#define LDB_(dst, b, h) do { _Pragma("unroll") for (int _n = 0; _n < 2; ++_n) { \
        dst[_n][0] = *(LAS3 const bf16x8*)(lds + SB_(b, h) + b_rd0 + _n * 8192); \
        dst[_n][1] = *(LAS3 const bf16x8*)(lds + SB_(b, h) + b_rd1 + _n * 8192); } } while (0)
#define MMA(ai, bj, Af, Bf) do { __builtin_amdgcn_s_setprio(1); \
        _Pragma("unroll") for (int _m = 0; _m < 4; ++_m) _Pragma("unroll") for (int _n = 0; _n < 2; ++_n) _Pragma("unroll") for (int _k = 0; _k < 2; ++_k) \
            acc[ai][bj][_m][_n] = __builtin_amdgcn_mfma_f32_16x16x32_bf16(Bf[_n][_k], Af[_m][_k], acc[ai][bj][_m][_n], 0, 0, 0); \
        __builtin_amdgcn_s_setprio(0); } while (0)

    f32x4 blo[4], bhi[4];
    bf16x8 At[4][2], B0[2][2], B1[2][2];
#pragma unroll
    for (int ai = 0; ai < 2; ++ai)
#pragma unroll
        for (int bj = 0; bj < 2; ++bj)
#pragma unroll
            for (int m = 0; m < 4; ++m)
#pragma unroll
                for (int n = 0; n < 2; ++n) acc[ai][bj][m][n] = (f32x4){0.f, 0.f, 0.f, 0.f};

    __builtin_amdgcn_s_waitcnt(0);
    const int p1 = (1 < nt) ? 1 : 0;
    BLOAD2(blo, 0, 0); BLOAD2(blo, 0, 2); BLOAD2(bhi, 0, 4); BLOAD2(bhi, 0, 6); STAGE_A(0, 0, 0); STAGE_A(0, 1, 0);
    BWAIT(blo, 4); BWAIT(bhi, 4); BWRITE_H(blo, 0, 0); BWRITE_H(bhi, 0, 1);
    BLOAD2(blo, p1, 0); BLOAD2(blo, p1, 2); STAGE_A(1, 0, p1); BLOAD2(bhi, p1, 4);
    G_WAIT_V(2);
    G_WAIT_L(0);
    { int wr1 = wid >> 2; asm volatile("" : "+s"(wr1)); if (wr1 == 1) G_BAR; }
    G_BAR;
    for (int t = 0; t < nt; t += 2) {
        const int t1 = (t + 1 < nt) ? t + 1 : nt - 1, t2 = (t + 2 < nt) ? t + 2 : nt - 1, t3 = (t + 3 < nt) ? t + 3 : nt - 1;
        LDB_(B0, 0, 0); G_SCHED; LDA(At, 0, 0); BLOAD2(bhi, t1, 6); STAGE_A(1, 1, t1);
        G_WAIT_L(8); G_BAR; G_WAIT_L(0); MMA(0, 0, At, B0); G_BAR; G_SCHED;
        LDB_(B1, 0, 1); BWAIT(blo, 8); BWRITE_H(blo, 1, 0); BLOAD2(blo, t2, 0);
        G_BAR; G_WAIT_L(0); MMA(0, 1, At, B1); G_BAR;
        LDA(At, 0, 1); BLOAD2(blo, t2, 2); STAGE_A(0, 0, t2);
        G_BAR; G_WAIT_L(0); MMA(1, 0, At, B0); G_BAR; G_SCHED;
        BWAIT(bhi, 8); BWRITE_H(bhi, 1, 1); BLOAD2(bhi, t2, 4);
        G_WAIT_V(8); G_WAIT_L(0); G_BAR; MMA(1, 1, At, B1); G_BAR;
        LDB_(B0, 1, 0); G_SCHED; LDA(At, 1, 0); BLOAD2(bhi, t2, 6); STAGE_A(0, 1, t2);
        G_WAIT_L(8); G_BAR; G_WAIT_L(0); MMA(0, 0, At, B0); G_BAR; G_SCHED;
        LDB_(B1, 1, 1); BWAIT(blo, 8); BWRITE_H(blo, 0, 0); BLOAD2(blo, t3, 0);
        G_BAR; G_WAIT_L(0); MMA(0, 1, At, B1); G_BAR;
        LDA(At, 1, 1); BLOAD2(blo, t3, 2); STAGE_A(1, 0, t3);
        G_BAR; G_WAIT_L(0); MMA(1, 0, At, B0); G_BAR; G_SCHED;
        BWAIT(bhi, 8); BWRITE_H(bhi, 0, 1); BLOAD2(bhi, t3, 4);
        G_WAIT_V(8); G_WAIT_L(0); G_BAR; MMA(1, 1, At, B1); G_BAR;
    }
    G_WAIT_V(0); G_WAIT_L(0);
    { int wr0 = wid >> 2; asm volatile("" : "+s"(wr0)); if (wr0 == 0) G_BAR; }
    G_BAR;
#undef SA_
#undef SB_
#undef STAGE_A
#undef BLOAD2
#undef BWRITE_H
#undef BWAIT
#undef LDA
#undef LDB_
#undef MMA
}

typedef int v8i32 __attribute__((ext_vector_type(8)));
typedef short v2s16 __attribute__((ext_vector_type(2)));
typedef int i32x4 __attribute__((ext_vector_type(4)));
#ifndef F8_WSCALE
#define F8_WSCALE 0.00390625f
#endif
template <int LDB, int ROWB = 0, int ASTEP = 128>
__device__ __forceinline__ void gemm_kloop_f8(f32x4 (&acc)[2][2][4][2], const unsigned char* __restrict__ A, const unsigned (&aoff)[2][2],
                                              const float* __restrict__ B, unsigned boff, int nt, LAS3 char* lds, int tid, int wid, unsigned char* __restrict__ img, int pam = 1, int pbm = 1) {
    const int lane = tid & 63, wr = wid >> 2, wc = wid & 3, fr = lane & 15, fq = lane >> 4;
    const int c0 = fq ^ (fr >> 1);
    const int a_rd0 = (wr * 64 + fr) * 128 + c0 * 16, a_rd1 = (wr * 64 + fr) * 128 + (c0 ^ 4) * 16;
    const int b_rd0 = (wc * 16 + fr) * 128 + ((c0 ^ (wc & 1)) * 16), b_rd1 = (wc * 16 + fr) * 128 + ((c0 ^ (wc & 1) ^ 4) * 16);
    const int k8 = wid, n4 = tid & 63, bhalf = n4 >> 5, nloc = (n4 & 31) * 4;
    const int sw0 = (((n4 & 3) * 2) & 7) ^ ((n4 >> 2) & 1), sw1 = (((n4 & 3) * 2 + 1) & 7) ^ ((n4 >> 2) & 1);
    const int b_wr0 = (4 + bhalf) * GHTB + nloc * 128 + ((k8 ^ sw0) << 4);
    const int b_wr1 = (4 + bhalf) * GHTB + (nloc + 2) * 128 + ((k8 ^ sw1) << 4);
    const unsigned boffb = boff * 4u;
    const unsigned lds_u = (unsigned)(unsigned long)lds;
    const unsigned bw_a0 = lds_u + (unsigned)b_wr0, bw_a1 = lds_u + (unsigned)b_wr1;
    const int a_dma0 = wid * 1024, a_dma1 = (8 + wid) * 1024;
    const size_t bstep = (size_t)128 * LDB * pbm, astepb = (size_t)ASTEP * pam;
    const unsigned cp_lds = lds_u + 4 * GHTB + (unsigned)wid * 4096u + (unsigned)lane * 16u;
    const unsigned char* cp_g = (const unsigned char*)((uintptr_t)img - (uintptr_t)(lds_u + 4 * GHTB));
    u32x4 cp0, cp1;
#define CPRD(b, h) asm volatile("ds_read_b128 %0, %2 offset:%3\n\tds_read_b128 %1, %2 offset:%4" : "=&v"(cp0), "=&v"(cp1) : "v"(cp_lds), "n"((b) * 2 * GHTB + (h) * 2048), "n"((b) * 2 * GHTB + (h) * 2048 + 1024) : "memory")
#define CPST(tc, h) asm volatile("s_nop 4\n\tglobal_store_dwordx4 %2, %0, %3 sc1\n\tglobal_store_dwordx4 %2, %1, %3 offset:1024 sc1\n\ts_nop 1" :: "v"(cp0), "v"(cp1), "v"(cp_lds), "s"(cp_g + (size_t)(tc) * 32768 + (h) * 2048) : "memory")

#define SA_(b, h) (((b) * 2 + (h)) * GHTB)
#define SB_(b, h) ((4 + (b) * 2 + (h)) * GHTB)
#define STAGE_A(b, h, kt) do { const unsigned char* _g = A + (size_t)(kt) * astepb; \
        dma16((const void*)(_g + (size_t)((h) * 128) * ROWB), ROWB ? aoff[0][0] : aoff[h][0], lds_u + SA_(b, h) + a_dma0); \
        dma16((const void*)(_g + (size_t)((h) * 128 + 64) * ROWB), ROWB ? aoff[0][0] : aoff[h][1], lds_u + SA_(b, h) + a_dma1); } while (0)
#define QLOAD(R, kt, q) do { \
        asm volatile("s_nop 4\n\tglobal_load_dwordx4 %0, %2, %3 nt\n\tglobal_load_dwordx4 %1, %2, %4 nt" : "=&v"(R[0]), "=&v"(R[1]) \
            : "v"(boffb), "s"(B + (size_t)(kt) * bstep + (size_t)(4 * (q)) * LDB), "s"(B + (size_t)(kt) * bstep + (size_t)(4 * (q) + 1) * LDB) : "memory"); \
        asm volatile("s_nop 4\n\tglobal_load_dwordx4 %0, %2, %3 nt\n\tglobal_load_dwordx4 %1, %2, %4 nt" : "=&v"(R[2]), "=&v"(R[3]) \
            : "v"(boffb), "s"(B + (size_t)(kt) * bstep + (size_t)(4 * (q) + 2) * LDB), "s"(B + (size_t)(kt) * bstep + (size_t)(4 * (q) + 3) * LDB) : "memory"); } while (0)
#define QWAIT4(R, n) QWAIT(R, n)
#define QWAIT(R, n) asm volatile("s_waitcnt vmcnt(" #n ")" : "+v"(R[0]), "+v"(R[1]), "+v"(R[2]), "+v"(R[3]) :: "memory")
#define QCVTW(R, b, q) do { _Pragma("unroll") for (int _i = 0; _i < 4; ++_i) { \
            cvd = __builtin_amdgcn_cvt_scalef32_pk_fp8_f32(cvd, R[0][_i], R[1][_i], F8_WSCALE, false); \
            cvd = __builtin_amdgcn_cvt_scalef32_pk_fp8_f32(cvd, R[2][_i], R[3][_i], F8_WSCALE, true); \
            asm volatile("ds_write_b32 %0, %1 offset:%2" :: "v"((_i < 2) ? bw_a0 : bw_a1), "v"(cvd), "n"((b) * 2 * GHTB + (_i & 1) * 128 + (q) * 4) : "memory"); } } while (0)
#define LDA1(dst, b, h, m) do { \
        dst.lo = *(LAS3 const i32x4*)(lds + SA_(b, h) + a_rd0 + (m) * 2048); \
        dst.hi = *(LAS3 const i32x4*)(lds + SA_(b, h) + a_rd1 + (m) * 2048); } while (0)
#define LDB4(dst, b) do { _Pragma("unroll") for (int _h = 0; _h < 2; ++_h) _Pragma("unroll") for (int _n = 0; _n < 2; ++_n) { \
        dst[_h * 2 + _n].lo = *(LAS3 const i32x4*)(lds + SB_(b, _h) + b_rd0 + _n * 8192); \
        dst[_h * 2 + _n].hi = *(LAS3 const i32x4*)(lds + SB_(b, _h) + b_rd1 + _n * 8192); } } while (0)
#define MF4(ai, m, slot) do { _Pragma("unroll") for (int _j = 0; _j < 4; ++_j) \
            acc[ai][_j >> 1][m][_j & 1] = __builtin_amdgcn_mfma_scale_f32_16x16x128_f8f6f4(Bx[_j], slot, acc[ai][_j >> 1][m][_j & 1], 0, 0, 0, 0x7f7f7f77, 1, 0x7f7f7f77); } while (0)
#define MMA16(ai, b, h) do { __builtin_amdgcn_s_setprio(1); MF4(ai, 0, A0); G_SCHED; LDA1(A0, b, h, 2); G_SCHED; MF4(ai, 1, A1); G_SCHED; LDA1(A1, b, h, 3); G_SCHED; \
        G_WAIT_L(2); MF4(ai, 2, A0); G_SCHED; G_WAIT_L(0); MF4(ai, 3, A1); __builtin_amdgcn_s_setprio(0); } while (0)
#define MMA16C(ai, b, h, tc) do { __builtin_amdgcn_s_setprio(1); MF4(ai, 0, A0); G_SCHED; LDA1(A0, b, h, 2); CPRD(b, 0); G_SCHED; MF4(ai, 1, A1); G_SCHED; LDA1(A1, b, h, 3); G_SCHED; \
        G_WAIT_L(2); MF4(ai, 2, A0); G_SCHED; CPST(tc, 0); CPRD(b, 1); G_WAIT_L(2); MF4(ai, 3, A1); G_SCHED; G_WAIT_L(0); CPST(tc, 1); __builtin_amdgcn_s_setprio(0); } while (0)

    f32x4 s0[4], s1[4];
    v2s16 cvd; asm("" : "=v"(cvd));
    v8i32 A0, A1, Bx[4];
#pragma unroll
    for (int ai = 0; ai < 2; ++ai)
#pragma unroll
        for (int bj = 0; bj < 2; ++bj)
#pragma unroll
            for (int m = 0; m < 4; ++m)
#pragma unroll
                for (int n = 0; n < 2; ++n) acc[ai][bj][m][n] = (f32x4){0.f, 0.f, 0.f, 0.f};

    const int p1 = (1 < nt) ? 1 : 0;
    QLOAD(acc[0][0][0], 0, 0); QLOAD(acc[0][0][2], 0, 1); QLOAD(acc[0][1][0], 0, 2); QLOAD(acc[0][1][2], 0, 3);
    STAGE_A(0, 0, 0); STAGE_A(0, 1, 0);
    QLOAD(s0, p1, 0); QLOAD(s1, p1, 1);
    __builtin_amdgcn_s_waitcnt(0);
    QWAIT4(acc[0][0][0], 0); QWAIT4(acc[0][0][2], 0); QWAIT4(acc[0][1][0], 0); QWAIT4(acc[0][1][2], 0); QWAIT(s0, 0); QWAIT(s1, 0);
    QCVTW(acc[0][0][0], 0, 0); QCVTW(acc[0][0][2], 0, 1); QCVTW(acc[0][1][0], 0, 2); QCVTW(acc[0][1][2], 0, 3);
#pragma unroll
    for (int bj = 0; bj < 2; ++bj)
#pragma unroll
        for (int m = 0; m < 4; ++m)
#pragma unroll
            for (int n = 0; n < 2; ++n) acc[0][bj][m][n] = (f32x4){0.f, 0.f, 0.f, 0.f};
    G_WAIT_L(0);
    { int wr1 = wid >> 2; asm volatile("" : "+s"(wr1)); if (wr1 == 1) G_BAR; }
    G_BAR;
#define KTILE(b, tc, tn1, tn2) do { \
          \
        LDB4(Bx, b); G_SCHED; LDA1(A0, b, 0, 0); LDA1(A1, b, 0, 1); \
        QWAIT(s0, 6); QCVTW(s0, (b) ^ 1, 0); QLOAD(s0, tn1, 2); QWAIT(s1, 6); QCVTW(s1, (b) ^ 1, 1); QLOAD(s1, tn1, 3); STAGE_A((b) ^ 1, 0, tn1); \
        G_WAIT_V(10); G_BAR; G_WAIT_L(0); MMA16C(0, b, 0, tc); G_BAR; G_SCHED; \
          \
        LDA1(A0, b, 1, 0); LDA1(A1, b, 1, 1); \
        QWAIT(s0, 10); QCVTW(s0, (b) ^ 1, 2); QLOAD(s0, tn2, 0); QWAIT(s1, 10); QCVTW(s1, (b) ^ 1, 3); QLOAD(s1, tn2, 1); STAGE_A((b) ^ 1, 1, tn1); \
        G_WAIT_V(14); G_WAIT_L(0); G_BAR; MMA16(1, b, 1); G_BAR; G_SCHED; } while (0)
    for (int t = 0; t < nt; t += 2) {
        const int t1 = (t + 1 < nt) ? t + 1 : nt - 1, t2 = (t + 2 < nt) ? t + 2 : nt - 1, t3 = (t + 3 < nt) ? t + 3 : nt - 1;
        KTILE(0, t, t1, t2);
        KTILE(1, t1, t2, t3);
    }
    G_WAIT_V(0); G_WAIT_L(0);
    { int wr0 = wid >> 2; asm volatile("" : "+s"(wr0)); if (wr0 == 0) G_BAR; }
    G_BAR;
#undef KTILE
#undef SA_
#undef SB_
#undef STAGE_A
#undef QLOAD
#undef QWAIT
#undef QCVTW
#undef LDA1
#undef MF4
#undef MMA16
#undef MMA16C
#undef LDB4
#undef QWAIT4
#undef CPRD
#undef CPST
}


__device__ __forceinline__ int lane_id() { int r; asm volatile("v_mbcnt_lo_u32_b32 %0, -1, 0\n\tv_mbcnt_hi_u32_b32 %0, -1, %0" : "=v"(r)); return r; }
#define SWZ_XOR(v, o) __int_as_float(__builtin_amdgcn_ds_swizzle(__float_as_int(v), ((o) << 10) | 0x1F))
__device__ __forceinline__ float half_sum32(float v) {
    v += SWZ_XOR(v, 16); v += SWZ_XOR(v, 8); v += SWZ_XOR(v, 4); v += SWZ_XOR(v, 2); v += SWZ_XOR(v, 1);
    return v;
}
__device__ __forceinline__ float xor32(float v) { const int l = lane_id(); return __int_as_float(__builtin_amdgcn_ds_bpermute((l ^ 32) << 2, __float_as_int(v))); }
__device__ __forceinline__ float wave_sum(float v) { v = half_sum32(v); return v + xor32(v); }
typedef int v8i32d __attribute__((ext_vector_type(8)));
typedef int i32x4d __attribute__((ext_vector_type(4)));
template <bool F8, bool BSW = false, int ROWB = 0, bool ACCUM = false, int ASTEP = 128>
__device__ __forceinline__ void gemm_kloop_dma(f32x4 (&acc)[2][2][4][2], const unsigned char* __restrict__ A, const unsigned (&aoff)[2][2],
                                               const unsigned char* __restrict__ img, int nt, LAS3 char* lds, int tid, int wid, int kbase = 0) {
    constexpr int KMASK = F8 ? 15 : 31;
#define KT_(kt) ((kbase + (kt)) & KMASK)
    const int lane = tid & 63, wr = wid >> 2, wc = wid & 3, fr = lane & 15, fq = lane >> 4;
    const int c0 = fq ^ (fr >> 1);
    const int a_rd0 = (wr * 64 + fr) * 128 + c0 * 16, a_rd1 = (wr * 64 + fr) * 128 + (c0 ^ 4) * 16;
    const int cb = BSW ? (c0 ^ (wc & 1)) : c0;
    const int b_rd0 = (wc * 16 + fr) * 128 + cb * 16, b_rd1 = (wc * 16 + fr) * 128 + (cb ^ 4) * 16;
    const unsigned lds_u = (unsigned)(unsigned long)lds;
    LAS3 const char* ap0 = lds + a_rd0; LAS3 const char* ap1 = lds + a_rd1; LAS3 const char* bp0 = lds + 4 * GHTB + b_rd0; LAS3 const char* bp1 = lds + 4 * GHTB + b_rd1;
    asm volatile("" : "+v"(ap0), "+v"(ap1), "+v"(bp0), "+v"(bp1));
    const int dma0 = wid * 1024, dma1 = (8 + wid) * 1024;
    const unsigned boffl = (unsigned)lane * 16u;

#define SA_(b, h) (((b) * 2 + (h)) * GHTB)
#define SB_(b, h) ((4 + (b) * 2 + (h)) * GHTB)
#define STG_A(b, h, kt) do { const unsigned char* _g = A + (size_t)KT_(kt) * ASTEP; \
        dma16((const void*)(_g + (size_t)((h) * 128) * ROWB), ROWB ? aoff[0][0] : aoff[h][0], lds_u + SA_(b, h) + dma0); \
        dma16((const void*)(_g + (size_t)((h) * 128 + 64) * ROWB), ROWB ? aoff[0][0] : aoff[h][1], lds_u + SA_(b, h) + dma1); } while (0)
#define STG_B(b, h, kt) do { const unsigned char* _g = img + (size_t)KT_(kt) * 32768 + (h) * 16384; \
        dma16((const void*)(_g + dma0), boffl, lds_u + SB_(b, h) + dma0); \
        dma16((const void*)(_g + dma1), boffl, lds_u + SB_(b, h) + dma1); } while (0)
#define LDA_(dst, b, h) do { _Pragma("unroll") for (int _m = 0; _m < 4; ++_m) { \
        dst[_m].lo = *(LAS3 const i32x4d*)(ap0 + SA_(b, h) + _m * 2048); \
        dst[_m].hi = *(LAS3 const i32x4d*)(ap1 + SA_(b, h) + _m * 2048); } } while (0)
#define LDBF(dst, b, h) do { _Pragma("unroll") for (int _n = 0; _n < 2; ++_n) { \
        dst[_n].lo = *(LAS3 const i32x4d*)(bp0 + (SB_(b, h) - 4 * GHTB) + _n * 8192); \
        dst[_n].hi = *(LAS3 const i32x4d*)(bp1 + (SB_(b, h) - 4 * GHTB) + _n * 8192); } } while (0)
#define MMAD(ai, bj, Af, Bf) do { __builtin_amdgcn_s_setprio(1); \
        _Pragma("unroll") for (int _m = 0; _m < 4; ++_m) _Pragma("unroll") for (int _n = 0; _n < 2; ++_n) { \
            if (F8) acc[ai][bj][_m][_n] = __builtin_amdgcn_mfma_scale_f32_16x16x128_f8f6f4(Bf[_n], Af[_m], acc[ai][bj][_m][_n], 0, 0, 0, 0x7f7f7f77, 1, 0x7f7f7f77); \
            else { const i32x4d _bl = Bf[_n].lo, _bh = Bf[_n].hi, _al = Af[_m].lo, _ah = Af[_m].hi;     \
                   acc[ai][bj][_m][_n] = __builtin_amdgcn_mfma_f32_16x16x32_bf16(__builtin_bit_cast(bf16x8, _bl), __builtin_bit_cast(bf16x8, _al), acc[ai][bj][_m][_n], 0, 0, 0); \
                   acc[ai][bj][_m][_n] = __builtin_amdgcn_mfma_f32_16x16x32_bf16(__builtin_bit_cast(bf16x8, _bh), __builtin_bit_cast(bf16x8, _ah), acc[ai][bj][_m][_n], 0, 0, 0); } } \
        __builtin_amdgcn_s_setprio(0); } while (0)

    v8i32d At[4], B0[2], B1[2];
    if (!ACCUM)
#pragma unroll
    for (int ai = 0; ai < 2; ++ai)
#pragma unroll
        for (int bj = 0; bj < 2; ++bj)
#pragma unroll
            for (int m = 0; m < 4; ++m)
#pragma unroll
                for (int n = 0; n < 2; ++n) acc[ai][bj][m][n] = (f32x4){0.f, 0.f, 0.f, 0.f};
    STG_B(0, 0, 0); STG_A(0, 0, 0); STG_B(0, 1, 0); STG_A(0, 1, 0);
    __builtin_amdgcn_s_waitcnt(0);
    { int wr1 = wid >> 2; asm volatile("" : "+s"(wr1)); if (wr1 == 1) G_BAR; }
    G_BAR;
    { const int p1 = (1 < nt) ? 1 : 0; STG_B(1, 0, p1); STG_A(1, 0, p1); STG_B(1, 1, p1); }
    G_WAIT_V(6); G_BAR;
    for (int t = 0; t < nt; t += 2) {
        const int t1 = (t + 1 < nt) ? t + 1 : nt - 1, t2 = (t + 2 < nt) ? t + 2 : nt - 1, t3 = (t + 3 < nt) ? t + 3 : nt - 1;
        LDBF(B0, 0, 0); G_SCHED; LDA_(At, 0, 0); STG_A(1, 1, t1);
        G_WAIT_V(10); G_WAIT_L(8); G_BAR; G_WAIT_L(0); MMAD(0, 0, At, B0); G_BAR; G_SCHED;
        LDBF(B1, 0, 1); STG_B(0, 0, t2);
        G_WAIT_V(10); G_BAR; G_WAIT_L(0); MMAD(0, 1, At, B1); G_BAR;
        LDA_(At, 0, 1); STG_A(0, 0, t2);
        G_BAR; G_WAIT_L(0); MMAD(1, 0, At, B0); G_BAR; G_SCHED;
        STG_B(0, 1, t2);
        G_WAIT_V(10); G_BAR; MMAD(1, 1, At, B1); G_BAR;
        LDBF(B0, 1, 0); G_SCHED; LDA_(At, 1, 0); STG_A(0, 1, t2);
        G_WAIT_V(10); G_WAIT_L(8); G_BAR; G_WAIT_L(0); MMAD(0, 0, At, B0); G_BAR; G_SCHED;
        LDBF(B1, 1, 1); STG_B(1, 0, t3);
        G_WAIT_V(10); G_BAR; G_WAIT_L(0); MMAD(0, 1, At, B1); G_BAR;
        LDA_(At, 1, 1); STG_A(1, 0, t3);
        G_BAR; G_WAIT_L(0); MMAD(1, 0, At, B0); G_BAR; G_SCHED;
        STG_B(1, 1, t3);
        G_WAIT_V(10); G_BAR; MMAD(1, 1, At, B1); G_BAR;
    }
    G_WAIT_V(0); G_WAIT_L(0);
    { int wr0 = wid >> 2; asm volatile("" : "+s"(wr0)); if (wr0 == 0) G_BAR; }
    G_BAR;
#undef SA_
#undef SB_
#undef STG_A
#undef STG_B
#undef LDA_
#undef LDBF
#undef MMAD
#undef KT_
}

template <bool F8, int LDB>
__device__ __forceinline__ void convert_tile(const float* __restrict__ W, int col0, int col1, int nkt, unsigned char* __restrict__ img, LAS3 char* lds, int wid) {
    constexpr int RPT = F8 ? 16 : 8;
    int lane = lane_id(); asm volatile("" : "+v"(lane));
    const int n4 = lane, half = n4 >> 5, nloc = (n4 & 31) * 4;
    const float* src = W + (size_t)(wid * RPT) * LDB + ((n4 < 32) ? col0 + n4 * 4 : col1 + (n4 - 32) * 4);
    for (int kt = 0; kt < nkt; ++kt) {
        f32x4 r[RPT];
#pragma unroll
        for (int j = 0; j < RPT; ++j) r[j] = *(const f32x4*)(src + (size_t)(kt * (RPT * 8) + j) * LDB);
        LAS3 char* buf = lds + (kt & 1) * 32768;
#pragma unroll
        for (int i = 0; i < 4; ++i) {
            u32x4 w;
            if (F8) {
#pragma unroll
                for (int q = 0; q < 4; ++q) {
                    int d = __builtin_amdgcn_cvt_pk_fp8_f32(r[4 * q][i] * 256.0f, r[4 * q + 1][i] * 256.0f, 0, false);
                    d = __builtin_amdgcn_cvt_pk_fp8_f32(r[4 * q + 2][i] * 256.0f, r[4 * q + 3][i] * 256.0f, d, true);
                    w[q] = (unsigned)d;
                }
            } else {
                w.x = cvt_pk_bf16(r[0][i], r[1][i]); w.y = cvt_pk_bf16(r[2][i], r[3][i]); w.z = cvt_pk_bf16(r[4][i], r[5][i]); w.w = cvt_pk_bf16(r[6][i], r[7][i]);
            }
            const int row = nloc + i;
            *(LAS3 u32x4*)(buf + half * 16384 + row * 128 + ((wid ^ ((row >> 1) & 7)) << 4)) = w;
        }
        __syncthreads();
#pragma unroll
        for (int j = 0; j < 4; ++j) {
            const u32x4 v = *(LAS3 const u32x4*)(buf + wid * 4096 + j * 1024 + lane * 16);
            *(u32x4*)(img + (size_t)kt * 32768 + wid * 4096 + j * 1024 + lane * 16) = v;
        }
    }
    __syncthreads();
}

__device__ __forceinline__ float gelu_exact(float x) { return 0.5f * x * (1.0f + erff(x * 0.70710678118654752f)); }
__device__ __forceinline__ float bf2f(bf16_t v) { return __uint_as_float((unsigned)v << 16); }
__device__ __forceinline__ bf16_t f2bf(float v) { return (bf16_t)(cvt_pk_bf16(v, 0.f) & 0xffffu); }

struct GemmArgs {
    const bf16_t* A; const float* B; const float* bias; const float* R;
    void* C;
    const int* list; const int* cnt;
    int abase;
};

struct TileSync {
    int* flag;
    unsigned* qctr;
    unsigned qtag;
    LAS3 unsigned* qslot;
    int* dep; int depn;
    int* pend;
};

constexpr int EST_BF16 = 528;
constexpr int EST_F8 = 144;
constexpr int LDS_BIAS = 256 * EST_BF16 + 3072;
__device__ __forceinline__ void epi_stage_bf16(const f32x4 (&v)[2][2], int r, int colw, LAS3 char* lds) {
#pragma unroll
    for (int bj = 0; bj < 2; ++bj)
#pragma unroll
        for (int n = 0; n < 2; ++n) { u32x2 o; o.x = cvt_pk_bf16(v[bj][n][0], v[bj][n][1]); o.y = cvt_pk_bf16(v[bj][n][2], v[bj][n][3]);
            *(LAS3 u32x2*)(lds + r * EST_BF16 + (bj * 128 + n * 64 + colw) * 2) = o; }
}
__device__ __forceinline__ void epi_flush_bf16(bf16_t* C, size_t ld, int grow0, int col0, int nvalid, LAS3 char* lds, int tid) {
    __syncthreads();
    const int chunk = tid & 31, r0 = tid >> 5;
#pragma unroll 4
    for (int it = 0; it < 16; ++it) { const int row = it * 16 + r0;
        if (row < nvalid) { const u32x4 q = *(LAS3 const u32x4*)(lds + row * EST_BF16 + chunk * 16); *(u32x4*)(C + ((unsigned)(grow0 + row) * (unsigned)ld + (unsigned)(col0 + chunk * 8))) = q; } }
    __syncthreads();
}
__device__ __forceinline__ void epi_flush_f8(unsigned char* C, size_t ld, int grow0, int col0, int nvalid, LAS3 char* lds, int tid) {
    __syncthreads();
    const int chunk = tid & 7, r0 = tid >> 3;
#pragma unroll
    for (int it = 0; it < 4; ++it) { const int row = it * 64 + r0;
        if (row < nvalid) { const u32x4 q = *(LAS3 const u32x4*)(lds + row * EST_F8 + chunk * 16);
            const unsigned off = ((((unsigned)grow0 >> 8) * (unsigned)(ld >> 7) + ((unsigned)col0 >> 7)) * 256u + (unsigned)row) * 128u + (unsigned)(chunk * 16);
            asm volatile("s_nop 4\n\tglobal_store_dwordx4 %0, %1, %2 sc1 nt\n\ts_nop 1" :: "v"(off), "v"(q), "s"(C) : "memory"); } }
    __syncthreads();
}

constexpr int EST_F8W = 272;
__device__ __forceinline__ void epi_flush_f8w(unsigned char* C, size_t ld, int grow0, int col0, int nvalid, LAS3 char* lds, int tid) {
    __syncthreads();
    const int chunk = tid & 15, r0 = tid >> 4;
#pragma unroll
    for (int it = 0; it < 8; ++it) { const int row = it * 32 + r0;
        if (row < nvalid) { const u32x4 q = *(LAS3 const u32x4*)(lds + row * EST_F8W + chunk * 16);
            const unsigned off = (unsigned)(grow0 + row) * (unsigned)ld + (unsigned)(col0 + chunk * 16);
            asm volatile("s_nop 4\n\tglobal_store_dwordx4 %0, %1, %2 nt\n\ts_nop 1" :: "v"(off), "v"(q), "s"(C) : "memory"); } }
    __syncthreads();
}
template <int EPI, int VAR = 0>
__device__ __forceinline__ void gemm_tile(const GemmArgs& g, int pm, int pn, int e, int ebase, int ecnt, LAS3 char* lds, int wid, unsigned char* img, const TileSync& sy) {
    constexpr int LDB = (EPI == 0) ? DIN : (EPI == 2) ? 2 * DFF : D;
    int tid = wid * 64 + lane_id(); asm volatile("" : "+v"(tid));
    const int lane = tid & 63;
    unsigned aoff[2][2];
#pragma unroll
    for (int h = 0; h < 2; ++h)
#pragma unroll
        for (int i = 0; i < 2; ++i) {
            const int rih = (i * 8 + wid) * 8 + (lane >> 3);
            const int chunk = (lane & 7) ^ ((rih >> 1) & 7);
            int r = pm * 256 + h * 128 + rih;
            unsigned grow;
            if (EPI == 2) { if (r >= ecnt) r = ecnt - 1; grow = (unsigned)(g.list[e * T + r] >> 2); }
            else if (EPI == 3) { grow = (unsigned)(((g.abase >> 8) + pm) * (16 * 256) + h * 128 + rih); }
            else grow = (unsigned)r;
            aoff[h][i] = (EPI == 3) ? (grow * 128u + (unsigned)(chunk * 16)) : (EPI >= 2) ? (grow * (unsigned)D + (unsigned)(chunk * 16)) : (grow * (unsigned)D + (unsigned)(chunk * 8)) * 2u;
        }
    const int k8 = wid, n4 = tid & 63;
    int col;
    if (EPI == 2) col = (n4 < 32) ? pn * 128 + n4 * 4 : DFF + pn * 128 + (n4 - 32) * 4;
    else col = pn * 256 + n4 * 4;
    const unsigned boff = (unsigned)(k8 * ((EPI >= 2) ? 16 : 8)) * (unsigned)LDB + (unsigned)col;
    const float* Bp = g.B;
    if (EPI == 2) Bp += (size_t)e * D * (2 * DFF);
    if (EPI == 3) Bp += (size_t)e * DFF * D;
    if (EPI >= 2 && tid < 256) {
        float bvv;
        if (EPI == 2) bvv = (tid < 128) ? g.bias[(size_t)e * (2 * DFF) + pn * 128 + tid] : g.bias[(size_t)e * (2 * DFF) + DFF + pn * 128 + (tid - 128)] + 1.0f;
        else bvv = g.bias[(size_t)e * D + pn * 256 + tid];
        *(LAS3 float*)(lds + LDS_BIAS + tid * 4) = bvv;
    }
    if (EPI >= 2) {
        if (tid == 0) {
            if (sy.dep) { unsigned sp = 0; while (__hip_atomic_load(sy.dep, __ATOMIC_RELAXED, __HIP_MEMORY_SCOPE_AGENT) < sy.depn) { __builtin_amdgcn_s_sleep(8); if (++sp > (1u << 20)) break; }
                __builtin_amdgcn_fence(__ATOMIC_ACQUIRE, "agent"); asm volatile("s_waitcnt vmcnt(0)" ::: "memory"); } }
        if (sy.dep) __syncthreads();
    }
    f32x4 acc[2][2][4][2];
    if (EPI >= 2) gemm_kloop_f8<LDB, (EPI == 3) ? 128 : 0, (EPI == 3) ? 32768 : 128>(acc, (const unsigned char*)g.A, aoff, Bp, boff, D / 128, lds, tid, wid, img);
    else gemm_kloop<LDB, VAR>(acc, g.A, aoff, Bp, boff, D / GBK, lds, tid, wid);
    int tz = wid * 64 + lane_id(); asm volatile("" : "+v"(tz));
    if (EPI >= 2 && sy.pend && tz == 0) __hip_atomic_fetch_add(sy.pend, 1, __ATOMIC_RELAXED, __HIP_MEMORY_SCOPE_AGENT);
    unsigned nx = 0;
    if (EPI >= 2 && tz == 0) nx = __hip_atomic_fetch_add(sy.qctr, 1u, __ATOMIC_RELAXED, __HIP_MEMORY_SCOPE_AGENT);
    if (EPI >= 2 && tz == 0) __hip_atomic_store(sy.flag, 1, __ATOMIC_RELAXED, __HIP_MEMORY_SCOPE_AGENT);
    const int wid2 = tz >> 6, lane2 = tz & 63;
    const int row0 = (wid2 >> 2) * 64 + (lane2 & 15), colw = (wid2 & 3) * 16 + (lane2 >> 4) * 4;
    if (EPI == 0) {
#pragma unroll
        for (int ai = 0; ai < 2; ++ai)
#pragma unroll
            for (int m = 0; m < 4; ++m) {
                f32x4 v[2][2];
#pragma unroll
                for (int bj = 0; bj < 2; ++bj)
#pragma unroll
                    for (int n = 0; n < 2; ++n) v[bj][n] = acc[ai][bj][m][n];
                epi_stage_bf16(v, ai * 128 + row0 + m * 16, colw, lds);
            }
        epi_flush_bf16((bf16_t*)g.C, DIN, pm * 256, pn * 256, 256, lds, tz);
    } else if (EPI == 1) {
        float* C = (float*)g.C;
#pragma unroll
        for (int ai = 0; ai < 2; ++ai)
#pragma unroll
            for (int m = 0; m < 4; ++m) {
                const size_t ro = (size_t)(pm * 256 + ai * 128 + row0 + m * 16) * D + pn * 256 + colw;
#pragma unroll
                for (int bj = 0; bj < 2; ++bj)
#pragma unroll
                    for (int n = 0; n < 2; ++n) { const f32x4 xr = *(const f32x4*)(g.R + ro + bj * 128 + n * 64);
                        *(f32x4*)(C + ro + bj * 128 + n * 64) = acc[ai][bj][m][n] + xr; }
            }
    } else if (EPI == 2) {
        unsigned char* C = (unsigned char*)g.C;
        f32x4 bgate[2], bup1[2];
#pragma unroll
        for (int n = 0; n < 2; ++n) { bgate[n] = *(LAS3 const f32x4*)(lds + LDS_BIAS + (n * 64 + colw) * 4); bup1[n] = *(LAS3 const f32x4*)(lds + LDS_BIAS + (128 + n * 64 + colw) * 4); }
#pragma unroll
        for (int ai = 0; ai < 2; ++ai)
#pragma unroll
            for (int m = 0; m < 4; ++m) {
                const int r = pm * 256 + ai * 128 + row0 + m * 16;
                {
                    LAS3 char* rp = lds + (ai * 128 + row0 + m * 16) * EST_F8 + colw;
#pragma unroll
                    for (int n = 0; n < 2; ++n) {
                        float o[4];
#pragma unroll
                        for (int j = 0; j < 4; j += 2) {
                            typedef float f32x2 __attribute__((ext_vector_type(2)));
                            f32x2 gt = (f32x2){acc[ai][0][m][n][j], acc[ai][0][m][n][j + 1]} + (f32x2){bgate[n][j], bgate[n][j + 1]};
                            f32x2 up = (f32x2){acc[ai][1][m][n][j], acc[ai][1][m][n][j + 1]} + (f32x2){bup1[n][j], bup1[n][j + 1]};
                            gt.x = fminf(gt.x, 7.0f); gt.y = fminf(gt.y, 7.0f);
                            up.x = __builtin_amdgcn_fmed3f(up.x, -6.0f, 8.0f); up.y = __builtin_amdgcn_fmed3f(up.y, -6.0f, 8.0f);
                            const f32x2 xe = gt * (-2.45546696f);
                            f32x2 ex; ex.x = __builtin_amdgcn_exp2f(xe.x); ex.y = __builtin_amdgcn_exp2f(xe.y);
                            const f32x2 den = ex + 1.0f;
                            f32x2 rc; rc.x = __builtin_amdgcn_rcpf(den.x); rc.y = __builtin_amdgcn_rcpf(den.y);
                            const f32x2 res = (gt * rc) * up;
                            o[j] = res.x; o[j + 1] = res.y;
                        }
                        int w = __builtin_amdgcn_cvt_pk_fp8_f32(o[0], o[1], 0, false);
                        w = __builtin_amdgcn_cvt_pk_fp8_f32(o[2], o[3], w, true);
                        *(LAS3 int*)(rp + n * 64) = w;
                    }
                }
            }
        { const int nv = ecnt - pm * 256; epi_flush_f8(C, DFF, g.abase + pm * 256, pn * 128, nv < 256 ? nv : 256, lds, tz); }
    } else {
        bf16_t* C = (bf16_t*)g.C;
        f32x4 bv[2][2];
#pragma unroll
        for (int bj = 0; bj < 2; ++bj)
#pragma unroll
            for (int n = 0; n < 2; ++n) bv[bj][n] = *(LAS3 const f32x4*)(lds + LDS_BIAS + (bj * 128 + n * 64 + colw) * 4);
#pragma unroll
        for (int ai = 0; ai < 2; ++ai)
#pragma unroll
            for (int m = 0; m < 4; ++m) {
                LAS3 char* rp = lds + (ai * 128 + row0 + m * 16) * EST_F8W + colw;
#pragma unroll
                for (int bj = 0; bj < 2; ++bj)
#pragma unroll
                    for (int n = 0; n < 2; ++n) { const f32x4 v = acc[ai][bj][m][n] + bv[bj][n];
                        int w = __builtin_amdgcn_cvt_pk_fp8_f32(v[0], v[1], 0, false); w = __builtin_amdgcn_cvt_pk_fp8_f32(v[2], v[3], w, true);
                        *(LAS3 int*)(rp + bj * 128 + n * 64) = w; }
            }
        { const int nv = ecnt - pm * 256; epi_flush_f8w((unsigned char*)g.C, D, ebase + pm * 256, pn * 256, nv < 256 ? nv : 256, lds, tz); }
    }
    if (EPI >= 2 && tz == 0) *sy.qslot = sy.qtag | nx;
}


template <int EPI>
__device__ __forceinline__ void gemm_tile_img(const GemmArgs& g, int pm, int pn, int e, int ebase, int ecnt, LAS3 char* lds, int wid, const unsigned char* img, const TileSync& sy, int kh = -1) {
    int tid = wid * 64 + lane_id(); asm volatile("" : "+v"(tid));
    const int lane = tid & 63;
    unsigned aoff[2][2];
#pragma unroll
    for (int h = 0; h < 2; ++h)
#pragma unroll
        for (int i = 0; i < 2; ++i) {
            const int rih = (i * 8 + wid) * 8 + (lane >> 3);
            const int chunk = (lane & 7) ^ ((rih >> 1) & 7);
            int r = pm * 256 + h * 128 + rih;
            unsigned grow;
            if (EPI == 2) { if (r >= ecnt) r = ecnt - 1; grow = (unsigned)(g.list[e * T + r] >> 2); }
            else if (EPI == 3) { grow = (unsigned)(((g.abase >> 8) + pm) * (16 * 256) + h * 128 + rih); }
            else grow = (unsigned)r;
            aoff[h][i] = (EPI == 3) ? (grow * 128u + (unsigned)(chunk * 16)) : (EPI >= 2) ? (grow * (unsigned)D + (unsigned)(chunk * 16)) : (grow * (unsigned)D + (unsigned)(chunk * 8)) * 2u;
        }
    if (EPI >= 2) {
        if (tid < 256) {
            float bvv;
            if (EPI == 2) bvv = (tid < 128) ? g.bias[(size_t)e * (2 * DFF) + pn * 128 + tid] : g.bias[(size_t)e * (2 * DFF) + DFF + pn * 128 + (tid - 128)] + 1.0f;
            else bvv = g.bias[(size_t)e * D + pn * 256 + tid];
            *(LAS3 float*)(lds + LDS_BIAS + tid * 4) = bvv;
        }
        if (tid == 0) {
            unsigned sp = 0; while (__hip_atomic_load(sy.flag, __ATOMIC_RELAXED, __HIP_MEMORY_SCOPE_AGENT) == 0) { __builtin_amdgcn_s_sleep(8); if (++sp > (1u << 20)) break; }
            if (sy.dep) { while (__hip_atomic_load(sy.dep, __ATOMIC_RELAXED, __HIP_MEMORY_SCOPE_AGENT) < sy.depn) { __builtin_amdgcn_s_sleep(8); if (++sp > (1u << 20)) break; } }
            __builtin_amdgcn_fence(__ATOMIC_ACQUIRE, "agent"); asm volatile("s_waitcnt vmcnt(0)" ::: "memory"); }
        __syncthreads();
    }
    f32x4 acc[2][2][4][2];
    gemm_kloop_dma<(EPI >= 2), (EPI >= 2), (EPI == 2) ? 0 : (EPI == 3) ? 128 : 2 * D, false, (EPI == 3) ? 32768 : 128>(acc, (const unsigned char*)g.A, aoff, img, (EPI >= 2) ? D / 128 : (EPI == 0 && kh >= 0) ? D / 128 : D / 64, lds, tid, wid, (EPI == 0 && kh > 0) ? D / 128 : 0);
    int tz = wid * 64 + lane_id(); asm volatile("" : "+v"(tz));
    if (EPI >= 2 && sy.pend && tz == 0) __hip_atomic_fetch_add(sy.pend, 1, __ATOMIC_RELAXED, __HIP_MEMORY_SCOPE_AGENT);
    unsigned nx = 0;
    if (EPI >= 2 && tz == 0) nx = __hip_atomic_fetch_add(sy.qctr, 1u, __ATOMIC_RELAXED, __HIP_MEMORY_SCOPE_AGENT);
    const int wid2 = tz >> 6, lane2 = tz & 63;
    const int row0 = (wid2 >> 2) * 64 + (lane2 & 15), colw = (wid2 & 3) * 16 + (lane2 >> 4) * 4;
    if (EPI == 0) {
#pragma unroll
        for (int ai = 0; ai < 2; ++ai)
#pragma unroll
            for (int m = 0; m < 4; ++m) {
                f32x4 v[2][2];
#pragma unroll
                for (int bj = 0; bj < 2; ++bj)
#pragma unroll
                    for (int n = 0; n < 2; ++n) v[bj][n] = acc[ai][bj][m][n];
                epi_stage_bf16(v, ai * 128 + row0 + m * 16, colw, lds);
            }
        if (kh > 0) epi_flush_bf16((bf16_t*)g.R, DIN - 4096, pm * 256, pn * 256 - 4096, 256, lds, tz);
        else epi_flush_bf16((bf16_t*)g.C, DIN, pm * 256, pn * 256, 256, lds, tz);
    } else if (EPI == 1) {
        float* C = (float*)g.C;
#pragma unroll
        for (int ai = 0; ai < 2; ++ai)
#pragma unroll
            for (int m = 0; m < 4; ++m) {
                const size_t ro = (size_t)(pm * 256 + ai * 128 + row0 + m * 16) * D + pn * 256 + colw;
#pragma unroll
                for (int bj = 0; bj < 2; ++bj)
#pragma unroll
                    for (int n = 0; n < 2; ++n) { const f32x4 xr = *(const f32x4*)(g.R + ro + bj * 128 + n * 64);
                        *(f32x4*)(C + ro + bj * 128 + n * 64) = acc[ai][bj][m][n] + xr; }
            }
    } else if (EPI == 2) {
        unsigned char* C = (unsigned char*)g.C;
        f32x4 bgate[2], bup1[2];
#pragma unroll
        for (int n = 0; n < 2; ++n) { bgate[n] = *(LAS3 const f32x4*)(lds + LDS_BIAS + (n * 64 + colw) * 4); bup1[n] = *(LAS3 const f32x4*)(lds + LDS_BIAS + (128 + n * 64 + colw) * 4); }
#pragma unroll
        for (int ai = 0; ai < 2; ++ai)
#pragma unroll
            for (int m = 0; m < 4; ++m) {
                const int r = pm * 256 + ai * 128 + row0 + m * 16;
                {
                    LAS3 char* rp = lds + (ai * 128 + row0 + m * 16) * EST_F8 + colw;
#pragma unroll
                    for (int n = 0; n < 2; ++n) {
                        float o[4];
#pragma unroll
                        for (int j = 0; j < 4; j += 2) {
                            typedef float f32x2 __attribute__((ext_vector_type(2)));
                            f32x2 gt = (f32x2){acc[ai][0][m][n][j], acc[ai][0][m][n][j + 1]} + (f32x2){bgate[n][j], bgate[n][j + 1]};
                            f32x2 up = (f32x2){acc[ai][1][m][n][j], acc[ai][1][m][n][j + 1]} + (f32x2){bup1[n][j], bup1[n][j + 1]};
                            gt.x = fminf(gt.x, 7.0f); gt.y = fminf(gt.y, 7.0f);
                            up.x = __builtin_amdgcn_fmed3f(up.x, -6.0f, 8.0f); up.y = __builtin_amdgcn_fmed3f(up.y, -6.0f, 8.0f);
                            const f32x2 xe = gt * (-2.45546696f);
                            f32x2 ex; ex.x = __builtin_amdgcn_exp2f(xe.x); ex.y = __builtin_amdgcn_exp2f(xe.y);
                            const f32x2 den = ex + 1.0f;
                            f32x2 rc; rc.x = __builtin_amdgcn_rcpf(den.x); rc.y = __builtin_amdgcn_rcpf(den.y);
                            const f32x2 res = (gt * rc) * up;
                            o[j] = res.x; o[j + 1] = res.y;
                        }
                        int w = __builtin_amdgcn_cvt_pk_fp8_f32(o[0], o[1], 0, false);
                        w = __builtin_amdgcn_cvt_pk_fp8_f32(o[2], o[3], w, true);
                        *(LAS3 int*)(rp + n * 64) = w;
                    }
                }
            }
        { const int nv = ecnt - pm * 256; epi_flush_f8(C, DFF, g.abase + pm * 256, pn * 128, nv < 256 ? nv : 256, lds, tz); }
    } else {
        bf16_t* C = (bf16_t*)g.C;
        f32x4 bv[2][2];
#pragma unroll
        for (int bj = 0; bj < 2; ++bj)
#pragma unroll
            for (int n = 0; n < 2; ++n) bv[bj][n] = *(LAS3 const f32x4*)(lds + LDS_BIAS + (bj * 128 + n * 64 + colw) * 4);
#pragma unroll
        for (int ai = 0; ai < 2; ++ai)
#pragma unroll
            for (int m = 0; m < 4; ++m) {
                LAS3 char* rp = lds + (ai * 128 + row0 + m * 16) * EST_F8W + colw;
#pragma unroll
                for (int bj = 0; bj < 2; ++bj)
#pragma unroll
                    for (int n = 0; n < 2; ++n) { const f32x4 v = acc[ai][bj][m][n] + bv[bj][n];
                        int w = __builtin_amdgcn_cvt_pk_fp8_f32(v[0], v[1], 0, false); w = __builtin_amdgcn_cvt_pk_fp8_f32(v[2], v[3], w, true);
                        *(LAS3 int*)(rp + bj * 128 + n * 64) = w; }
            }
        { const int nv = ecnt - pm * 256; epi_flush_f8w((unsigned char*)g.C, D, ebase + pm * 256, pn * 256, nv < 256 ? nv : 256, lds, tz); }
    }
    if (EPI >= 2 && tz == 0) *sy.qslot = sy.qtag | nx;
}

#define XB_TMO      128
#define XB_XCNT(j)  (256  + 64 * (j))
#define XB_XSUB(j)  (1280 + 64 * (j))
#define XB_XGEN(j)  (2304 + 64 * (j))
#define XB_TOP      3328
#define XB_TOPGEN   3392
#define XCD_BAR_WORDS 3456
#define XB_SPIN_CAP (1u << 18)
#define LAS __attribute__((address_space(3)))

__device__ __forceinline__ unsigned xb_ld(unsigned* p)              { return __hip_atomic_load(p, __ATOMIC_RELAXED, __HIP_MEMORY_SCOPE_AGENT); }
__device__ __forceinline__ unsigned xb_add(unsigned* p, unsigned v) { return __hip_atomic_fetch_add(p, v, __ATOMIC_RELAXED, __HIP_MEMORY_SCOPE_AGENT); }
__device__ __forceinline__ unsigned xb_xcc_id() { return (unsigned)__builtin_amdgcn_s_getreg((3 << 11) | 20) & 0xFu; }
#define XB_SPIN(cond, bar) do { unsigned _sp = 0; while (cond) { __builtin_amdgcn_s_sleep(1); \
    if ((++_sp & 255u) == 0u) { if (xb_ld(&(bar)[XB_TMO])) break; if (_sp > XB_SPIN_CAP) { atomicAdd(&(bar)[XB_TMO], 1u); break; } } } } while (0)

struct XcdBarrier {
    unsigned* bar; unsigned x;
    volatile LAS unsigned* st;
};
__device__ __forceinline__ XcdBarrier xcd_barrier_post(unsigned* bar, volatile LAS unsigned* st, int tid) {
    XcdBarrier b; b.bar = bar; b.x = xb_xcc_id(); b.st = st;
    if (tid == 0) (void)xb_add(&bar[XB_XCNT(b.x)], 1u);
    return b;
}
__device__ __forceinline__ void xcd_barrier_complete(unsigned* bar, unsigned x, unsigned& nloc, unsigned& nx) {
    const unsigned G = gridDim.x * gridDim.y * gridDim.z;
    unsigned sum, cnt, mine, sp = 0u;
    for (;;) {
        sum = 0u; cnt = 0u; mine = 0u;
#pragma unroll
        for (unsigned j = 0; j < 16; ++j) { const unsigned c = xb_ld(&bar[XB_XCNT(j)]); sum += c; cnt += (c > 0u) ? 1u : 0u; mine = (j == x) ? c : mine; }
        if (sum == G) break;
        __builtin_amdgcn_s_sleep(1);
        if ((++sp & 255u) == 0u) { if (xb_ld(&bar[XB_TMO])) break; if (sp > XB_SPIN_CAP) { atomicAdd(&bar[XB_TMO], 1u); break; } }
    }
    nloc = mine > 0u ? mine : 1u; nx = cnt > 0u ? cnt : 1u;
}
__device__ __forceinline__ void xcd_barrier(const XcdBarrier& b, int tid) {
    asm volatile("s_waitcnt vmcnt(0)" ::: "memory");
    __syncthreads();
    if (tid == 0) {
        unsigned* bar = b.bar;
        __builtin_amdgcn_s_waitcnt(0);
        unsigned nloc = b.st[0], nx = b.st[1];
        if (nloc == 0u) { xcd_barrier_complete(bar, b.x, nloc, nx); b.st[0] = nloc; b.st[1] = nx; }
        const unsigned old = xb_add(&bar[XB_XSUB(b.x)], 1u);
        const unsigned gen = old / nloc;
        if (old + 1u == (gen + 1u) * nloc) {
            __builtin_amdgcn_fence(__ATOMIC_RELEASE, "agent");
            asm volatile("s_waitcnt vmcnt(0)" ::: "memory");
            const unsigned og = xb_add(&bar[XB_TOP], 1u);
            const unsigned tg = og / nx;
            if (og + 1u == (tg + 1u) * nx) xb_add(&bar[XB_TOPGEN], 1u);
            else XB_SPIN(xb_ld(&bar[XB_TOPGEN]) == tg, bar);
            __builtin_amdgcn_fence(__ATOMIC_ACQUIRE, "agent");
            xb_add(&bar[XB_XGEN(b.x)], 1u);
            asm volatile("s_waitcnt vmcnt(0)" ::: "memory");
        } else {
            XB_SPIN(xb_ld(&bar[XB_XGEN(b.x)]) == gen, bar);
            __builtin_amdgcn_fence(__ATOMIC_ACQUIRE, "agent");
            asm volatile("s_waitcnt vmcnt(0)" ::: "memory");
        }
    }
    __syncthreads();
}

struct Params {
    const float *x, *ln_mix_g, *w_in, *conv_w, *sgu_ln_g, *sgu_ln_b, *sgu_w, *sgu_b, *gn_conv, *gn_sgu, *w_out, *ln_ffn_g, *w_router, *b_router,
                *w_gate_up, *b_gate_up, *w_down, *b_down, *ln_final_g;
    float* out;
    unsigned* bar; int* cnt; int* list; int* sel; float* gates;
    bf16_t *xn, *proj, *proj2, *y, *xn2, *act, *outp; float* h;
    unsigned char *img_in, *img_out;
    unsigned char *img_gu, *img_dn;
    int* flag;
    unsigned* qctr;
    int* done;
};
constexpr int LDS_MISC = 256 * EST_BF16;
constexpr int LDS_TOTAL = LDS_MISC + 4096;

__device__ __forceinline__ void phase_rmsnorm(const float* __restrict__ x, const float* __restrict__ g, bf16_t* __restrict__ y, int wid) {
    int lane = lane_id(); asm volatile("" : "+v"(lane));
    for (int t = blockIdx.x * 8 + wid; t < T; t += gridDim.x * 8) {
        const float* xr = x + (size_t)t * D;
        f32x4 v[8]; float s = 0.f;
#pragma unroll
        for (int j = 0; j < 8; ++j) { v[j] = *(const f32x4*)(xr + j * 256 + lane * 4); s += v[j][0] * v[j][0] + v[j][1] * v[j][1] + v[j][2] * v[j][2] + v[j][3] * v[j][3]; }
        s = wave_sum(s);
        const float r = rsqrtf(s * (1.0f / D) + EPS);
#pragma unroll
        for (int j = 0; j < 8; ++j) {
            const f32x4 gg = *(const f32x4*)(g + j * 256 + lane * 4);
            u32x2 o; o.x = cvt_pk_bf16(v[j][0] * r * gg[0], v[j][1] * r * gg[1]); o.y = cvt_pk_bf16(v[j][2] * r * gg[2], v[j][3] * r * gg[3]);
            *(u32x2*)(y + (size_t)t * D + j * 256 + lane * 4) = o;
        }
    }
}

__device__ __forceinline__ float gelu_f(float v) {
    const float av = fabsf(v), dd = av * 0.2316418882f + 1.0f;
    const float tt = __builtin_amdgcn_rcpf(dd);
    float q = tt * 0.5307027145f + (-0.7265760135f); q = q * tt + 0.7107068705f; q = q * tt + (-0.142248368f); q = q * tt + 0.127414796f; q = q * tt;
    const float e = __builtin_amdgcn_exp2f((v * v) * (-0.72134752044f));
    const float m = v * (q * e);
    return v < 0.f ? m : v - m;
}
typedef float f32x16 __attribute__((ext_vector_type(16)));

__device__ __forceinline__ void phase_mixer(const Params& p, LAS3 char* lds, int wid) {
    int lane = lane_id(); asm volatile("" : "+v"(lane));
    const int n = lane & 31, kh = lane >> 5;
    const bf16_t* __restrict__ proj = p.proj;
    LAS3 float* stat = (LAS3 float*)(lds + 32768);
    const int nunits = (T / 128) * 16;
    for (int it = 0; it * (int)gridDim.x < nunits; ++it) {
        const int b = blockIdx.x;
        int u = it * gridDim.x + b;
        if (u >= nunits) break;
        int chunk, g;
        if ((gridDim.x & 15) == 0) { chunk = (b >> 4) + (gridDim.x >> 4) * it; g = ((b & 15) + 8 * (it & 1)) & 15; } else { chunk = u >> 4; g = u & 15; }
        const int t0 = chunk * 128;
        if (g < 8) {
            const int c = g * 128 + 2 * lane;
            const int r0 = t0 + 16 * wid;
            const bf16_t* base = proj + (size_t)r0 * DIN + c;
            const float w00 = p.conv_w[c], w01 = p.conv_w[c + 1], w10 = p.conv_w[DC + c], w11 = p.conv_w[DC + c + 1], w20 = p.conv_w[2 * DC + c], w21 = p.conv_w[2 * DC + c + 1];
            const float g0 = p.gn_conv[c], g1 = p.gn_conv[c + 1];
            const bool has_hist = ((r0 % SEQ) != 0);
            float z2a = 0.f, z2b = 0.f, z1a = 0.f, z1b = 0.f;
            if (has_hist) {
                const unsigned c2 = *(const unsigned*)(base - 2 * (ptrdiff_t)DIN + DC), h2 = *(const unsigned*)(base - 2 * (ptrdiff_t)DIN + 2 * DC);
                const unsigned c1 = *(const unsigned*)(base - (ptrdiff_t)DIN + DC), h1 = *(const unsigned*)(base - (ptrdiff_t)DIN + 2 * DC);
                z2a = bf16_lo(c2) * bf16_lo(h2); z2b = bf16_hi(c2) * bf16_hi(h2); z1a = bf16_lo(c1) * bf16_lo(h1); z1b = bf16_hi(c1) * bf16_hi(h1);
            }
#pragma unroll 1
            for (int hb = 0; hb < 16; hb += 8) {
                unsigned bg[8], cg[8], hg[8];
#pragma unroll
                for (int i = 0; i < 8; ++i) { bg[i] = *(const unsigned*)(base + (size_t)(hb + i) * DIN); cg[i] = *(const unsigned*)(base + (size_t)(hb + i) * DIN + DC); hg[i] = *(const unsigned*)(base + (size_t)(hb + i) * DIN + 2 * DC); }
#pragma unroll
                for (int i = 0; i < 8; ++i) {
                    const float z0a = bf16_lo(cg[i]) * bf16_lo(hg[i]), z0b = bf16_hi(cg[i]) * bf16_hi(hg[i]);
                    const float ya = bf16_lo(bg[i]) * (w00 * z2a + w10 * z1a + w20 * z0a);
                    const float yb = bf16_hi(bg[i]) * (w01 * z2b + w11 * z1b + w21 * z0b);
                    z2a = z1a; z2b = z1b; z1a = z0a; z1b = z0b;
                    const float ss = wave_sum(ya * ya + yb * yb);
                    const float rs = rsqrtf(ss * (1.0f / 128.0f) + EPS);
                    *(unsigned*)(p.y + (size_t)(r0 + hb + i) * D + c) = cvt_pk_bf16(ya * rs * g0, yb * rs * g1);
                }
            }
            __syncthreads(); __syncthreads(); __syncthreads();
        } else {
            const int hd = g - 8;
            {
                const int s0 = 16 * wid + 8 * kh;
                const bf16_t* vb = proj + (size_t)(t0 + s0) * DIN + 4096 + hd * 128 + 4 * n;
                const bf16_t* vb2 = p.proj2 + (size_t)(t0 + s0) * (DIN - 4096) + hd * 128 + 4 * n;
                u32x2 raw[8], raw2[8];
#pragma unroll
                for (int j = 0; j < 8; ++j) { raw[j] = *(const u32x2*)(vb + (size_t)j * DIN); raw2[j] = *(const u32x2*)(vb2 + (size_t)j * (DIN - 4096)); }
                const f32x4 lg = *(const f32x4*)(p.sgu_ln_g + hd * 128 + 4 * n), lb = *(const f32x4*)(p.sgu_ln_b + hd * 128 + 4 * n);
                float vn[8][4];
#pragma unroll
                for (int j = 0; j < 8; ++j) {
                    const float a0 = gelu_f(bf16_lo(raw[j].x) + bf16_lo(raw2[j].x)), a1 = gelu_f(bf16_hi(raw[j].x) + bf16_hi(raw2[j].x)), a2 = gelu_f(bf16_lo(raw[j].y) + bf16_lo(raw2[j].y)), a3 = gelu_f(bf16_hi(raw[j].y) + bf16_hi(raw2[j].y));
                    const float mu = half_sum32((a0 + a1) + (a2 + a3)) * (1.0f / 128.0f);
                    const float d0 = a0 - mu, d1 = a1 - mu, d2 = a2 - mu, d3 = a3 - mu;
                    const float rs = rsqrtf(half_sum32((d0 * d0 + d1 * d1) + (d2 * d2 + d3 * d3)) * (1.0f / 128.0f) + EPS);
                    vn[j][0] = d0 * rs * lg[0] + lb[0]; vn[j][1] = d1 * rs * lg[1] + lb[1]; vn[j][2] = d2 * rs * lg[2] + lb[2]; vn[j][3] = d3 * rs * lg[3] + lb[3];
                }
                __syncthreads();
#pragma unroll
                for (int c = 0; c < 4; ++c) {
                    u32x4 f; f.x = cvt_pk_bf16(vn[0][c], vn[1][c]); f.y = cvt_pk_bf16(vn[2][c], vn[3][c]); f.z = cvt_pk_bf16(vn[4][c], vn[5][c]); f.w = cvt_pk_bf16(vn[6][c], vn[7][c]);
                    *(LAS3 u32x4*)(lds + ((wid * 4 + c) * 64 + lane) * 16) = f;
                }
            }
            __syncthreads();
            {
                const int mt = wid >> 1, cp = (wid & 1) * 2;
                const int trow = 32 * mt + n;
                const float* Wr = p.sgu_w + (size_t)hd * 16384 + (size_t)trow * 128 + 8 * kh;
                f32x16 acc0, acc1;
#pragma unroll
                for (int r = 0; r < 16; ++r) { acc0[r] = 0.f; acc1[r] = 0.f; }
                for (int ks = 0; ks <= 2 * mt + 1; ++ks) {
                    const f32x4 wa = *(const f32x4*)(Wr + 16 * ks), wb = *(const f32x4*)(Wr + 16 * ks + 4);
                    const int sb = 16 * ks + 8 * kh;
                    float wv[8] = {wa[0], wa[1], wa[2], wa[3], wb[0], wb[1], wb[2], wb[3]};
#pragma unroll
                    for (int j = 0; j < 8; ++j) wv[j] = (sb + j <= trow) ? wv[j] : 0.f;
                    u32x4 af; af.x = cvt_pk_bf16(wv[0], wv[1]); af.y = cvt_pk_bf16(wv[2], wv[3]); af.z = cvt_pk_bf16(wv[4], wv[5]); af.w = cvt_pk_bf16(wv[6], wv[7]);
                    const u32x4 b0 = *(LAS3 const u32x4*)(lds + ((ks * 4 + cp) * 64 + lane) * 16);
                    const u32x4 b1 = *(LAS3 const u32x4*)(lds + ((ks * 4 + cp + 1) * 64 + lane) * 16);
                    acc0 = __builtin_amdgcn_mfma_f32_32x32x16_bf16(__builtin_bit_cast(bf16x8, af), __builtin_bit_cast(bf16x8, b0), acc0, 0, 0, 0);
                    acc1 = __builtin_amdgcn_mfma_f32_32x32x16_bf16(__builtin_bit_cast(bf16x8, af), __builtin_bit_cast(bf16x8, b1), acc1, 0, 0, 0);
                }
                const bf16_t* ub = proj + (size_t)t0 * DIN + 3072 + hd * 128 + 4 * n + cp;
                float ya[16], yb[16];
#pragma unroll
                for (int r = 0; r < 16; ++r) {
                    const int tt = 32 * mt + (r & 3) + 8 * (r >> 2) + 4 * kh;
                    const unsigned uu = *(const unsigned*)(ub + (size_t)tt * DIN);
                    const float bias = p.sgu_b[hd * 128 + tt];
                    ya[r] = gelu_f(bf16_lo(uu)) * (acc0[r] + bias);
                    yb[r] = gelu_f(bf16_hi(uu)) * (acc1[r] + bias);
                    const float ps = half_sum32(ya[r] * ya[r] + yb[r] * yb[r]);
                    if (n == 0) stat[tt * 2 + (wid & 1)] = ps;
                }
                __syncthreads();
                const float g0 = p.gn_sgu[hd * 128 + 4 * n + cp], g1 = p.gn_sgu[hd * 128 + 4 * n + cp + 1];
#pragma unroll
                for (int r = 0; r < 16; ++r) {
                    const int tt = 32 * mt + (r & 3) + 8 * (r >> 2) + 4 * kh;
                    const float rs = rsqrtf((stat[tt * 2] + stat[tt * 2 + 1]) * (1.0f / 128.0f) + EPS);
                    *(unsigned*)(p.y + (size_t)(t0 + tt) * D + DC + hd * 128 + 4 * n + cp) = cvt_pk_bf16(ya[r] * rs * g0, yb[r] * rs * g1);
                }
            }
        }
    }
}

__device__ __forceinline__ void phase_router(const Params& p, LAS3 char* lds, int wid) {
    LAS3 float* part = (LAS3 float*)lds;
    LAS3 float* ssqp = (LAS3 float*)(lds + 34816);
    LAS3 float* logit = (LAS3 float*)(lds + 36864);
    LAS3 float* rstd = (LAS3 float*)(lds + 41984);
    LAS3 int* lhist = (LAS3 int*)(lds + 42240);
    LAS3 int* gbase = (LAS3 int*)(lds + 42368);
    int lane = lane_id(); asm volatile("" : "+v"(lane));
    const int n = lane & 31, kh = lane >> 5, tid = wid * 64 + lane;
    for (int grp = blockIdx.x; grp < T / 32; grp += gridDim.x) {
        const int t0 = grp * 32;
        __syncthreads();
        if (tid < 32) lhist[tid] = 0;
        {
            const float* hrow = p.h + (size_t)(t0 + n) * D + wid * 256 + 4 * kh;
            const float* grow = p.ln_ffn_g + wid * 256 + 4 * kh;
            const float* wrow = p.w_router + (size_t)(wid * 256 + 4 * kh) * 32 + n;
            f32x16 acc;
#pragma unroll
            for (int r = 0; r < 16; ++r) acc[r] = 0.f;
            float ssq = 0.f;
#pragma unroll 1
            for (int jj = 0; jj < 32; jj += 8) {
                f32x4 hv[8], gv[8];
#pragma unroll
                for (int j = 0; j < 8; ++j) { hv[j] = *(const f32x4*)(hrow + 8 * (jj + j)); gv[j] = *(const f32x4*)(grow + 8 * (jj + j)); }
#pragma unroll
                for (int j = 0; j < 8; ++j)
#pragma unroll
                    for (int i = 0; i < 4; ++i) {
                        const float a = hv[j][i];
                        ssq += a * a;
                        const float bw = wrow[(size_t)(8 * (jj + j) + i) * 32];
                        acc = __builtin_amdgcn_mfma_f32_32x32x2f32(a * gv[j][i], bw, acc, 0, 0, 0);
                    }
            }
            ssq += xor32(ssq);
            if (kh == 0) ssqp[wid * 32 + n] = ssq;
#pragma unroll
            for (int r = 0; r < 16; ++r) part[(wid * 32 + ((r & 3) + 8 * (r >> 2) + 4 * kh)) * 33 + n] = acc[r];
        }
        __syncthreads();
        if (tid < 32) { float s = 0.f;
#pragma unroll
            for (int w = 0; w < 8; ++w) s += ssqp[w * 32 + tid];
            rstd[tid] = rsqrtf(s * (1.0f / D) + EPS); }
        __syncthreads();
#pragma unroll
        for (int i = 0; i < 2; ++i) {
            const int idx = tid + 512 * i, tk = idx >> 5, e = idx & 31;
            float s = 0.f;
#pragma unroll
            for (int w = 0; w < 8; ++w) s += part[(w * 32 + tk) * 33 + e];
            logit[tk * 33 + e] = s * rstd[tk] + p.b_router[e];
        }
        __syncthreads();
        int se[4] = {0, 0, 0, 0}, sl[4] = {0, 0, 0, 0}; float sx[4] = {0.f, 0.f, 0.f, 0.f}; float sden = 1.f;
        if (tid < 32) {
            float v0 = 0.f; sden = 0.f;
#pragma unroll
            for (int k = 0; k < 4; ++k) {
                int bi = 0; float bv = -3.0e38f;
                for (int i = 0; i < 32; ++i) { const float l = logit[tid * 33 + i]; if (l > bv) { bv = l; bi = i; } }
                logit[tid * 33 + bi] = -3.4e38f;
                if (k == 0) v0 = bv;
                sx[k] = __expf(bv - v0); sden += sx[k];
                se[k] = bi; sl[k] = atomicAdd((int*)&lhist[bi], 1);
            }
        }
        __syncthreads();
        if (tid < 32) { const int c = lhist[tid]; gbase[tid] = c ? atomicAdd(&p.cnt[tid], c) : 0; }
        __syncthreads();
        if (tid < 32) {
            const int t = t0 + tid;
            const float inv = 1.0f / sden;
#pragma unroll
            for (int k = 0; k < 4; ++k) {
                const int slot = gbase[se[k]] + sl[k];
                p.gates[t * 4 + k] = sx[k] * inv;
                p.list[se[k] * T + slot] = t * 4 + k;
                p.sel[t * 4 + k] = (se[k] << 16) | slot;
            }
        }
#pragma unroll 1
        for (int q = 0; q < 4; ++q) {
            const int tk = wid * 4 + q;
            const float r = rstd[tk];
            const float* hr = p.h + (size_t)(t0 + tk) * D;
#pragma unroll
            for (int j = 0; j < 8; ++j) {
                const f32x4 hv = *(const f32x4*)(hr + j * 256 + lane * 4), gg = *(const f32x4*)(p.ln_ffn_g + j * 256 + lane * 4);
                int o = __builtin_amdgcn_cvt_pk_fp8_f32(hv[0] * r * gg[0], hv[1] * r * gg[1], 0, false);
                o = __builtin_amdgcn_cvt_pk_fp8_f32(hv[2] * r * gg[2], hv[3] * r * gg[3], o, true);
                *(int*)((unsigned char*)p.xn2 + (size_t)(t0 + tk) * D + j * 256 + lane * 4) = o;
            }
        }
    }
}

__device__ __forceinline__ void phase_final(const Params& p, LAS3 char* lds, int wid) {
    LAS3 int* base = (LAS3 int*)(lds + LDS_MISC + 2048);
    int lane = lane_id(); asm volatile("" : "+v"(lane));
    if (wid == 0 && lane == 0) { int a = 0; for (int i = 0; i < NE; ++i) { base[i] = a; a += p.cnt[i]; } }
    __syncthreads();
    for (int t = blockIdx.x * 8 + wid; t < T; t += gridDim.x * 8) {
        float gk[4]; const unsigned char* op[4];
#pragma unroll
        for (int k = 0; k < 4; ++k) { const int s = p.sel[t * 4 + k]; gk[k] = p.gates[t * 4 + k]; op[k] = (const unsigned char*)p.outp + (size_t)(base[s >> 16] + (s & 0xffff)) * D; }
        f32x4 v[8]; float ss = 0.f;
#pragma unroll
        for (int j = 0; j < 8; ++j) {
            const int c = j * 256 + lane * 4;
            f32x4 a = *(const f32x4*)(p.h + (size_t)t * D + c);
#pragma unroll
            for (int k = 0; k < 4; ++k) { const int o = *(const int*)(op[k] + c);
                typedef float f32x2 __attribute__((ext_vector_type(2)));
                const f32x2 lo = __builtin_amdgcn_cvt_pk_f32_fp8(o, false), hi = __builtin_amdgcn_cvt_pk_f32_fp8(o, true);
                a[0] += gk[k] * lo.x; a[1] += gk[k] * lo.y; a[2] += gk[k] * hi.x; a[3] += gk[k] * hi.y; }
            v[j] = a; ss += a[0] * a[0] + a[1] * a[1] + a[2] * a[2] + a[3] * a[3];
        }
        ss = wave_sum(ss);
        const float r = rsqrtf(ss * (1.0f / D) + EPS);
#pragma unroll
        for (int j = 0; j < 8; ++j) { const int c = j * 256 + lane * 4; const f32x4 gg = *(const f32x4*)(p.ln_final_g + c);
            f32x4 o; o[0] = v[j][0] * r * gg[0]; o[1] = v[j][1] * r * gg[1]; o[2] = v[j][2] * r * gg[2]; o[3] = v[j][3] * r * gg[3];
            *(f32x4*)(p.out + (size_t)t * D + c) = o; }
    }
}

__device__ __forceinline__ void expert_span(const int* cnt, int e, int& ebase, int& ecnt, int& abase) {
    const int l = lane_id();
    const int c = (l < NE) ? cnt[l] : 0;
    ebase = __builtin_amdgcn_readfirstlane((int)wave_sum((l < e) ? (float)c : 0.0f));
    abase = 256 * __builtin_amdgcn_readfirstlane((int)wave_sum((l < e) ? (float)((c + 255) >> 8) : 0.0f));
    ecnt = __builtin_amdgcn_readlane(c, e);
}

#ifndef MOE_MERGED
#define MOE_MERGED 1
#endif
#ifndef MOE_LAG2
#define MOE_LAG2 16
#define MOE_LAG3 16
#endif
__device__ __forceinline__ int wave_imax(int v) {
#define SWZ_XORI(v, o) __builtin_amdgcn_ds_swizzle(v, ((o) << 10) | 0x1F)
    v = max(v, SWZ_XORI(v, 16)); v = max(v, SWZ_XORI(v, 8)); v = max(v, SWZ_XORI(v, 4)); v = max(v, SWZ_XORI(v, 2)); v = max(v, SWZ_XORI(v, 1));
    const int l = lane_id(); return max(v, __builtin_amdgcn_ds_bpermute((l ^ 32) << 2, v));
#undef SWZ_XORI
}
template <int EPI>
__device__ __forceinline__ int* moe_phase(const Params& p, LAS3 char* lds, int wid, int* pend_in) {
    constexpr int NCQ = (EPI == 2) ? 2 : 1, NS = NE * NCQ, NCOL = NCQ * 8, MOE_LAG = (EPI == 2) ? MOE_LAG2 : MOE_LAG3;
    unsigned* qctr = p.qctr + ((EPI == 2) ? 0 : 8);
    LAS3 unsigned* slot = (LAS3 unsigned*)(lds + LDS_MISC + 64);
    constexpr int NSL = NS + MOE_LAG;
    LAS3 int* pre = (LAS3 int*)(lds + LDS_MISC + 256);
    LAS3 int* mtv = (LAS3 int*)(lds + LDS_MISC + 768);
    static_assert(NSL + 1 <= 128, "prefix table size");
    __syncthreads();
    { const int t0 = wid * 64 + lane_id(); if (t0 < NE) mtv[t0] = (p.cnt[t0] + 255) >> 8; }
    __syncthreads();
    { const int t0 = wid * 64 + lane_id();
      if (t0 == 0) { int a = 0;
          for (int s = 0; s <= NSL; ++s) { pre[s] = a;
              if (s < NSL) { int nv = (s < NS && mtv[s / NCQ] > 0) ? 1 : 0; const int sc = s - MOE_LAG;
                  if (sc >= 0 && sc < NS) { const int m = mtv[sc / NCQ]; nv += (m > 1) ? m - 1 : 0; }
                  a += nv; } } } }
    __syncthreads();
    const int total = __builtin_amdgcn_readfirstlane(pre[NSL]);
    const int q0 = (int)(xb_xcc_id() & 7u);
    GemmArgs g{};
    if (EPI == 2) { g.A = p.xn2; g.B = p.w_gate_up; g.C = p.act; g.bias = p.b_gate_up; g.list = p.list; }
    else { g.A = p.act; g.B = p.w_down; g.C = p.outp; g.bias = p.b_down; }
    __syncthreads();
    { const int t0 = wid * 64 + lane_id(); if (t0 == 0) slot[0] = ((unsigned)q0 << 20) | __hip_atomic_fetch_add(&qctr[q0], 1u, __ATOMIC_RELAXED, __HIP_MEMORY_SCOPE_AGENT); }
    int* pend = pend_in;
    int par = 0;
    for (;;) {
        __syncthreads();
        const unsigned code = (unsigned)__builtin_amdgcn_readfirstlane((int)slot[par]);
        if (code == 0xFFFFFFFFu) break;
        const int qq = (int)(code >> 20), i = (int)(code & 0xFFFFFu);
        bool ran = false;
        if (i < total) {
            int s, j;
            { const int l = lane_id();
              const bool c1 = (l + 1 <= NSL) && (pre[(l + 1 <= NSL) ? l + 1 : 0] <= i), c2 = (l + 65 <= NSL) && (pre[(l + 65 <= NSL) ? l + 65 : 0] <= i);
              s = __builtin_popcountll(__builtin_amdgcn_ballot_w64(c1)) + __builtin_popcountll(__builtin_amdgcn_ballot_w64(c2));
              j = i - __builtin_amdgcn_readfirstlane(pre[s]); }
            const bool hasP = (s < NS) && (__builtin_amdgcn_readfirstlane(mtv[(s < NS) ? s / NCQ : 0]) > 0);
            const int k = (hasP && j == 0) ? 0 : j + (hasP ? 0 : 1);
            const int sl = (k == 0) ? s : s - MOE_LAG;
            if (sl >= 0 && sl < NS) {
                const int e = sl / NCQ, pn = qq + 8 * (sl % NCQ);
                int ebase, ecnt, abase; expert_span(p.cnt, e, ebase, ecnt, abase); g.abase = abase;
                if (k < ((ecnt + 255) >> 8)) {
                    TileSync sy{}; sy.flag = p.flag + ((EPI == 2) ? 0 : NE * 16) + e * NCOL + pn; sy.qctr = qctr + qq; sy.qtag = (unsigned)qq << 20; sy.qslot = slot + (par ^ 1);
                    if (MOE_MERGED) { sy.pend = pend; if (EPI == 3) { sy.dep = p.done + e * 32 + k; sy.depn = 16; } }
                    unsigned char* img = ((EPI == 2) ? p.img_gu : p.img_dn) + (size_t)(e * NCOL + pn) * 524288;
                    if (k == 0) gemm_tile<EPI>(g, 0, pn, e, ebase, ecnt, lds, wid, img, sy);
                    else gemm_tile_img<EPI>(g, k, pn, e, ebase, ecnt, lds, wid, img, sy);
                    pend = (MOE_MERGED && EPI == 2) ? p.done + e * 32 + k : nullptr;
                    ran = true;
                }
            }
            if (!ran) { const int t0 = wid * 64 + lane_id();
                if (t0 == 0) slot[par ^ 1] = ((unsigned)qq << 20) | __hip_atomic_fetch_add(&qctr[qq], 1u, __ATOMIC_RELAXED, __HIP_MEMORY_SCOPE_AGENT); }
        } else {
            const int t0 = wid * 64 + lane_id();
            if (t0 == 0) { unsigned cv[8];
                unsigned qx; asm volatile("s_getreg_b32 %0, hwreg(HW_REG_XCC_ID, 0, 3)" : "=s"(qx));
#pragma unroll
                for (int d = 0; d < 8; ++d) cv[d] = __hip_atomic_load(&qctr[(qx + d) & 7u], __ATOMIC_RELAXED, __HIP_MEMORY_SCOPE_AGENT);
                unsigned c = 0xFFFFFFFFu;
#pragma unroll
                for (int d = 7; d >= 0; --d) if (cv[d] < (unsigned)total) c = (qx + d) & 7u;
                if (c != 0xFFFFFFFFu) c = (c << 20) | __hip_atomic_fetch_add(&qctr[c], 1u, __ATOMIC_RELAXED, __HIP_MEMORY_SCOPE_AGENT);
                slot[par ^ 1] = c; }
        }
        par ^= 1;
    }
    return pend;
}

__global__ void __launch_bounds__(512, 2) k_mega(Params p) {
    extern __shared__ __attribute__((aligned(16))) char smem[];
    LAS3 char* lds = (LAS3 char*)smem;
    volatile LAS unsigned* xbw = (volatile LAS unsigned*)(lds + LDS_MISC);
    int wid = __builtin_amdgcn_readfirstlane((int)(threadIdx.x >> 6)); asm volatile("" : "+s"(wid));
    const int tid0 = wid * 64 + lane_id();
    if (tid0 == 0) { xbw[0] = 0u; xbw[1] = 0u; xbw[2] = 0u; xbw[3] = 0u; }
    __syncthreads();
    XcdBarrier bar = xcd_barrier_post(p.bar, xbw, tid0);
    const int nb = gridDim.x;
    const int vb = ((nb & 7) == 0) ? (int)(blockIdx.x & 7) * (nb >> 3) + (int)(blockIdx.x >> 3) : (int)blockIdx.x;

    if (blockIdx.x == 0 && tid0 < NE) p.cnt[tid0] = 0;
    phase_rmsnorm(p.x, p.ln_mix_g, p.xn, wid);
    for (int it = vb; it < 28 * 4; it += nb) {
        const int tile = it >> 2, kq = it & 3;
        if (tile < 20) convert_tile<false, DIN>(p.w_in + (size_t)kq * 512 * DIN, tile * 256, tile * 256 + 128, 8, p.img_in + (size_t)tile * 1048576 + (size_t)kq * 8 * 32768, lds, wid);
        else convert_tile<false, D>(p.w_out + (size_t)kq * 512 * D, (tile - 20) * 256, (tile - 20) * 256 + 128, 8, p.img_out + (size_t)(tile - 20) * 1048576 + (size_t)kq * 8 * 32768, lds, wid);
    }
    xcd_barrier(bar, wid * 64 + lane_id());
    { GemmArgs g{}; g.A = p.xn; g.C = p.proj; g.R = (const float*)p.proj2;
      for (int u = vb; u < 32 * 16 + 256; u += nb) {
          if (u < 32 * 16) gemm_tile_img<0>(g, u & 31, u >> 5, 0, 0, T, lds, wid, p.img_in + (size_t)(u >> 5) * 1048576, TileSync{});
          else { const int v = u - 32 * 16, pn = 16 + (v >> 6), pm = v & 31, kh = (v >> 5) & 1;
                 gemm_tile_img<0>(g, pm, pn, 0, 0, T, lds, wid, p.img_in + (size_t)pn * 1048576, TileSync{}, kh); } } }
    xcd_barrier(bar, wid * 64 + lane_id());
    phase_mixer(p, lds, wid);
    xcd_barrier(bar, wid * 64 + lane_id());
    { GemmArgs g{}; g.A = p.y; g.C = p.h; g.R = p.x;
      for (int u = vb; u < 32 * 8; u += nb) gemm_tile_img<1>(g, u & 31, u >> 5, 0, 0, T, lds, wid, p.img_out + (size_t)(u >> 5) * 1048576, TileSync{}); }
    xcd_barrier(bar, wid * 64 + lane_id());
    phase_router(p, lds, wid);
    xcd_barrier(bar, wid * 64 + lane_id());
    { int* pend = moe_phase<2>(p, lds, wid, nullptr);
      if (pend) {
          asm volatile("s_waitcnt vmcnt(0)" ::: "memory"); __syncthreads();
          const int t0 = wid * 64 + lane_id(); if (t0 == 0) __hip_atomic_fetch_add(pend, 1, __ATOMIC_RELAXED, __HIP_MEMORY_SCOPE_AGENT); }
      if (!MOE_MERGED) xcd_barrier(bar, wid * 64 + lane_id());
      (void)moe_phase<3>(p, lds, wid, nullptr); }
    xcd_barrier(bar, wid * 64 + lane_id());
    phase_final(p, lds, wid);
}
}

extern "C" void kernel_launch(void* const* d_in, const int* in_sizes, int n_in, void* d_out, int out_size, void* d_ws, size_t ws_size,
                              hipStream_t stream) {
    Params p{};
    p.x = (const float*)d_in[0]; p.ln_mix_g = (const float*)d_in[1]; p.w_in = (const float*)d_in[2]; p.conv_w = (const float*)d_in[3];
    p.sgu_ln_g = (const float*)d_in[4]; p.sgu_ln_b = (const float*)d_in[5]; p.sgu_w = (const float*)d_in[6]; p.sgu_b = (const float*)d_in[7];
    p.gn_conv = (const float*)d_in[8]; p.gn_sgu = (const float*)d_in[9]; p.w_out = (const float*)d_in[10]; p.ln_ffn_g = (const float*)d_in[11];
    p.w_router = (const float*)d_in[12]; p.b_router = (const float*)d_in[13]; p.w_gate_up = (const float*)d_in[14]; p.b_gate_up = (const float*)d_in[15];
    p.w_down = (const float*)d_in[16]; p.b_down = (const float*)d_in[17]; p.ln_final_g = (const float*)d_in[18];
    p.out = (float*)d_out;

    char* ws = (char*)d_ws;
    size_t off = 0;
    auto take = [&](size_t bytes) { char* q = ws + off; off += (bytes + 255) & ~(size_t)255; return q; };
    constexpr int SYNC_WORDS = XCD_BAR_WORDS + NE * 24 + 64 + NE * 32;
    p.bar = (unsigned*)take(SYNC_WORDS * 4);
    p.flag = (int*)(p.bar + XCD_BAR_WORDS); p.qctr = p.bar + XCD_BAR_WORDS + NE * 24; p.done = (int*)(p.bar + XCD_BAR_WORDS + NE * 24 + 64);
    p.cnt = (int*)take(256);
    p.list = (int*)take((size_t)NE * T * 4);
    p.sel = (int*)take((size_t)NPAIR * 4);
    p.gates = (float*)take((size_t)NPAIR * 4);
    p.xn = (bf16_t*)take((size_t)T * D * 2);
    p.proj = (bf16_t*)take((size_t)T * DIN * 2);
    p.proj2 = (bf16_t*)take((size_t)T * (DIN - 4096) * 2);
    p.y = (bf16_t*)take((size_t)T * D * 2);
    p.h = (float*)take((size_t)T * D * 4);
    p.xn2 = (bf16_t*)take((size_t)T * D * 2);
    p.act = (bf16_t*)take((size_t)(ACT_ROWS + NE * 256) * DFF * 2);
    p.outp = (bf16_t*)take((size_t)ACT_ROWS * D * 2);
    p.img_in = (unsigned char*)take((size_t)20 * 1048576);
    p.img_out = (unsigned char*)take((size_t)8 * 1048576);
    p.img_gu = (unsigned char*)take((size_t)NE * 16 * 524288);
    p.img_dn = (unsigned char*)take((size_t)NE * 8 * 524288);
    if (off > ws_size) { fprintf(stderr, "workspace too small: need %zu have %zu\n", off, ws_size); return; }

    static int grid = 0;
    if (!grid) {
        int dev = 0, cus = 0, per_cu = 0;
        (void)hipGetDevice(&dev);
        (void)hipDeviceGetAttribute(&cus, hipDeviceAttributeMultiprocessorCount, dev);
        (void)hipFuncSetAttribute((const void*)k_mega, hipFuncAttributeMaxDynamicSharedMemorySize, LDS_TOTAL);
        (void)hipOccupancyMaxActiveBlocksPerMultiprocessor(&per_cu, (const void*)k_mega, 512, LDS_TOTAL);
        if (per_cu < 1) { fprintf(stderr, "occupancy query says 0 blocks per CU\n"); per_cu = 1; }
        grid = cus * 1;
    }
    (void)hipMemsetAsync(p.bar, 0, SYNC_WORDS * 4, stream);
    k_mega<<<grid, 512, LDS_TOTAL, stream>>>(p);
}
```

```cpp
#define MOE_LAG2 15
#define MOE_LAG3 15
#include <hip/hip_runtime.h>
#include <stdint.h>
#include <stdio.h>

namespace {
constexpr int T = 8192, D = 2048, DIN = 5120, DC = 1024, NE = 32, DFF = 2048, SEQ = 4096;
constexpr int NPAIR = T * 4, ACT_ROWS = NPAIR + 256;
constexpr float EPS = 1e-5f;

#define LAS3 __attribute__((address_space(3)))
typedef short bf16x8 __attribute__((ext_vector_type(8)));
typedef float f32x4 __attribute__((ext_vector_type(4)));
typedef unsigned u32x4 __attribute__((ext_vector_type(4)));
typedef unsigned u32x2 __attribute__((ext_vector_type(2)));
typedef unsigned short bf16_t;

constexpr int GBK = 64, GHTB = 128 * 64 * 2;
constexpr int GEMM_LDS = 8 * GHTB;

__device__ __forceinline__ unsigned cvt_pk_bf16(float lo, float hi) {
    unsigned r; asm("v_cvt_pk_bf16_f32 %0, %1, %2" : "=v"(r) : "v"(lo), "v"(hi)); return r;
}
__device__ __forceinline__ float bf16_lo(unsigned u) { return __uint_as_float(u << 16); }
__device__ __forceinline__ float bf16_hi(unsigned u) { return __uint_as_float(u & 0xffff0000u); }

__device__ __forceinline__ void dma16(const void* sbase, unsigned voff, unsigned lds_dst) {
    unsigned keep;
    asm volatile("s_mov_b32 %0, m0\n\ts_mov_b32 m0, %3\n\ts_nop 2\n\tglobal_load_lds_dwordx4 %1, %2\n\ts_mov_b32 m0, %0"
                 : "=&s"(keep) : "v"(voff), "s"(sbase), "s"(lds_dst) : "memory");
}
#define G_WAIT_V(n) asm volatile("s_waitcnt vmcnt(" #n ")" ::: "memory")
#define G_WAIT_L(n) asm volatile("s_waitcnt lgkmcnt(" #n ")" ::: "memory")
#define G_BAR do { asm volatile("" ::: "memory"); __builtin_amdgcn_s_barrier(); asm volatile("" ::: "memory"); } while (0)
#define G_SCHED __builtin_amdgcn_sched_barrier(0)

template <int LDB, int VAR = 0>
__device__ __forceinline__ void gemm_kloop(f32x4 (&acc)[2][2][4][2], const bf16_t* __restrict__ A, const unsigned (&aoff)[2][2],
                                           const float* __restrict__ B, unsigned boff, int nt, LAS3 char* lds, int tid, int wid, size_t astep = GBK, size_t bstep = (size_t)GBK * LDB) {
    const int lane = tid & 63, wr = wid >> 2, wc = wid & 3, fr = lane & 15, fq = lane >> 4;
    const int c0 = fq ^ (fr >> 1);
    const int a_rd0 = (wr * 64 + fr) * 128 + c0 * 16, a_rd1 = (wr * 64 + fr) * 128 + (c0 ^ 4) * 16;
    const int b_rd0 = (wc * 16 + fr) * 128 + ((c0 ^ (wc & 1)) * 16), b_rd1 = (wc * 16 + fr) * 128 + ((c0 ^ (wc & 1) ^ 4) * 16);
    const int k8 = wid, n4 = tid & 63, bhalf = n4 >> 5, nloc = (n4 & 31) * 4;
    const int sw0 = (((n4 & 3) * 2) & 7) ^ ((n4 >> 2) & 1), sw1 = (((n4 & 3) * 2 + 1) & 7) ^ ((n4 >> 2) & 1);
    const int b_wr0 = (4 + bhalf) * GHTB + nloc * 128 + ((k8 ^ sw0) << 4);
    const int b_wr1 = (4 + bhalf) * GHTB + (nloc + 2) * 128 + ((k8 ^ sw1) << 4);
    const unsigned boffb = boff * 4u;
    const unsigned lds_u = (unsigned)(unsigned long)lds;
    const unsigned bw_a0 = lds_u + (unsigned)b_wr0, bw_a1 = lds_u + (unsigned)b_wr1;
    const int a_dma0 = wid * 1024, a_dma1 = (8 + wid) * 1024;

#define SA_(b, h) (((b) * 2 + (h)) * GHTB)
#define SB_(b, h) ((4 + (b) * 2 + (h)) * GHTB)
#define STAGE_A(b, h, kt) do { const bf16_t* _g = A + (size_t)(kt) * astep; \
        dma16((const void*)_g, aoff[h][0], lds_u + SA_(b, h) + a_dma0); \
        dma16((const void*)_g, aoff[h][1], lds_u + SA_(b, h) + a_dma1); } while (0)
#define BLOAD2(R, kt, j0) asm volatile("s_nop 4\n\tglobal_load_dwordx4 %0, %2, %3\n\tglobal_load_dwordx4 %1, %2, %4" \
        : "=&v"(R[(j0) & 3]), "=&v"(R[((j0) & 3) + 1]) : "v"(boffb), "s"(B + (size_t)(kt) * bstep + (size_t)(j0) * LDB), "s"(B + (size_t)(kt) * bstep + (size_t)((j0) + 1) * LDB) : "memory")
#define BWAIT(R, n) asm volatile("s_waitcnt vmcnt(" #n ")" : "+v"(R[0]), "+v"(R[1]), "+v"(R[2]), "+v"(R[3]) :: "memory")
#define BWRITE_H(R, b, hi) do { _Pragma("unroll") for (int _i = 0; _i < 4; ++_i) { u32x2 _w; \
            _w.x = cvt_pk_bf16(R[0][_i], R[1][_i]); _w.y = cvt_pk_bf16(R[2][_i], R[3][_i]); \
            asm volatile("ds_write_b64 %0, %1 offset:%2" :: "v"((_i < 2) ? bw_a0 : bw_a1), "v"(_w), "n"((b) * 2 * GHTB + (_i & 1) * 128 + (hi) * 8) : "memory"); } } while (0)
#define LDA(dst, b, h) do { _Pragma("unroll") for (int _m = 0; _m < 4; ++_m) { \
        dst[_m][0] = *(LAS3 const bf16x8*)(lds + SA_(b, h) + a_rd0 + _m * 2048); \
        dst[_m][1] = *(LAS3 const bf16x8*)(lds + SA_(b, h) + a_rd1 + _m * 2048); } } while (0)
#define LDB_(dst, b, h) do { _Pragma("unroll") for (int _n = 0; _n < 2; ++_n) { \
        dst[_n][0] = *(LAS3 const bf16x8*)(lds + SB_(b, h) + b_rd0 + _n * 8192); \
        dst[_n][1] = *(LAS3 const bf16x8*)(lds + SB_(b, h) + b_rd1 + _n * 8192); } } while (0)
#define MMA(ai, bj, Af, Bf) do { __builtin_amdgcn_s_setprio(1); \
        _Pragma("unroll") for (int _m = 0; _m < 4; ++_m) _Pragma("unroll") for (int _n = 0; _n < 2; ++_n) _Pragma("unroll") for (int _k = 0; _k < 2; ++_k) \
            acc[ai][bj][_m][_n] = __builtin_amdgcn_mfma_f32_16x16x32_bf16(Bf[_n][_k], Af[_m][_k], acc[ai][bj][_m][_n], 0, 0, 0); \
        __builtin_amdgcn_s_setprio(0); } while (0)

    f32x4 blo[4], bhi[4];
    bf16x8 At[4][2], B0[2][2], B1[2][2];
#pragma unroll
    for (int ai = 0; ai < 2; ++ai)
#pragma unroll
        for (int bj = 0; bj < 2; ++bj)
#pragma unroll
            for (int m = 0; m < 4; ++m)
#pragma unroll
                for (int n = 0; n < 2; ++n) acc[ai][bj][m][n] = (f32x4){0.f, 0.f, 0.f, 0.f};

    __builtin_amdgcn_s_waitcnt(0);
    const int p1 = (1 < nt) ? 1 : 0;
    BLOAD2(blo, 0, 0); BLOAD2(blo, 0, 2); BLOAD2(bhi, 0, 4); BLOAD2(bhi, 0, 6); STAGE_A(0, 0, 0); STAGE_A(0, 1, 0);
    BWAIT(blo, 4); BWAIT(bhi, 4); BWRITE_H(blo, 0, 0); BWRITE_H(bhi, 0, 1);
    BLOAD2(blo, p1, 0); BLOAD2(blo, p1, 2); STAGE_A(1, 0, p1); BLOAD2(bhi, p1, 4);
    G_WAIT_V(2);
    G_WAIT_L(0);
    { int wr1 = wid >> 2; asm volatile("" : "+s"(wr1)); if (wr1 == 1) G_BAR; }
    G_BAR;
    for (int t = 0; t < nt; t += 2) {
        const int t1 = (t + 1 < nt) ? t + 1 : nt - 1, t2 = (t + 2 < nt) ? t + 2 : nt - 1, t3 = (t + 3 < nt) ? t + 3 : nt - 1;
        LDB_(B0, 0, 0); G_SCHED; LDA(At, 0, 0); BLOAD2(bhi, t1, 6); STAGE_A(1, 1, t1);
        G_WAIT_L(8); G_BAR; G_WAIT_L(0); MMA(0, 0, At, B0); G_BAR; G_SCHED;
        LDB_(B1, 0, 1); BWAIT(blo, 8); BWRITE_H(blo, 1, 0); BLOAD2(blo, t2, 0);
        G_BAR; G_WAIT_L(0); MMA(0, 1, At, B1); G_BAR;
        LDA(At, 0, 1); BLOAD2(blo, t2, 2); STAGE_A(0, 0, t2);
        G_BAR; G_WAIT_L(0); MMA(1, 0, At, B0); G_BAR; G_SCHED;
        BWAIT(bhi, 8); BWRITE_H(bhi, 1, 1); BLOAD2(bhi, t2, 4);
        G_WAIT_V(8); G_WAIT_L(0); G_BAR; MMA(1, 1, At, B1); G_BAR;
        LDB_(B0, 1, 0); G_SCHED; LDA(At, 1, 0); BLOAD2(bhi, t2, 6); STAGE_A(0, 1, t2);
        G_WAIT_L(8); G_BAR; G_WAIT_L(0); MMA(0, 0, At, B0); G_BAR; G_SCHED;
        LDB_(B1, 1, 1); BWAIT(blo, 8); BWRITE_H(blo, 0, 0); BLOAD2(blo, t3, 0);
        G_BAR; G_WAIT_L(0); MMA(0, 1, At, B1); G_BAR;
        LDA(At, 1, 1); BLOAD2(blo, t3, 2); STAGE_A(1, 0, t3);
        G_BAR; G_WAIT_L(0); MMA(1, 0, At, B0); G_BAR; G_SCHED;
        BWAIT(bhi, 8); BWRITE_H(bhi, 0, 1); BLOAD2(bhi, t3, 4);
        G_WAIT_V(8); G_WAIT_L(0); G_BAR; MMA(1, 1, At, B1); G_BAR;
    }
    G_WAIT_V(0); G_WAIT_L(0);
    { int wr0 = wid >> 2; asm volatile("" : "+s"(wr0)); if (wr0 == 0) G_BAR; }
    G_BAR;
#undef SA_
#undef SB_
#undef STAGE_A
#undef BLOAD2
#undef BWRITE_H
#undef BWAIT
#undef LDA
#undef LDB_
#undef MMA
}

typedef int v8i32 __attribute__((ext_vector_type(8)));
typedef short v2s16 __attribute__((ext_vector_type(2)));
typedef int i32x4 __attribute__((ext_vector_type(4)));
#ifndef F8_WSCALE
#define F8_WSCALE 0.00390625f
#endif
template <int LDB, int ROWB = 0, int ASTEP = 128>
__device__ __forceinline__ void gemm_kloop_f8(f32x4 (&acc)[2][2][4][2], const unsigned char* __restrict__ A, const unsigned (&aoff)[2][2],
                                              const float* __restrict__ B, unsigned boff, int nt, LAS3 char* lds, int tid, int wid, unsigned char* __restrict__ img, int pam = 1, int pbm = 1) {
    const int lane = tid & 63, wr = wid >> 2, wc = wid & 3, fr = lane & 15, fq = lane >> 4;
    const int c0 = fq ^ (fr >> 1);
    const int a_rd0 = (wr * 64 + fr) * 128 + c0 * 16, a_rd1 = (wr * 64 + fr) * 128 + (c0 ^ 4) * 16;
    const int b_rd0 = (wc * 16 + fr) * 128 + ((c0 ^ (wc & 1)) * 16), b_rd1 = (wc * 16 + fr) * 128 + ((c0 ^ (wc & 1) ^ 4) * 16);
    const int k8 = wid, n4 = tid & 63, bhalf = n4 >> 5, nloc = (n4 & 31) * 4;
    const int sw0 = (((n4 & 3) * 2) & 7) ^ ((n4 >> 2) & 1), sw1 = (((n4 & 3) * 2 + 1) & 7) ^ ((n4 >> 2) & 1);
    const int b_wr0 = (4 + bhalf) * GHTB + nloc * 128 + ((k8 ^ sw0) << 4);
    const int b_wr1 = (4 + bhalf) * GHTB + (nloc + 2) * 128 + ((k8 ^ sw1) << 4);
    const unsigned boffb = boff * 4u;
    const unsigned lds_u = (unsigned)(unsigned long)lds;
    const unsigned bw_a0 = lds_u + (unsigned)b_wr0, bw_a1 = lds_u + (unsigned)b_wr1;
    const int a_dma0 = wid * 1024, a_dma1 = (8 + wid) * 1024;
    const size_t bstep = (size_t)128 * LDB * pbm, astepb = (size_t)ASTEP * pam;
    const unsigned cp_lds = lds_u + 4 * GHTB + (unsigned)wid * 4096u + (unsigned)lane * 16u;
    const unsigned char* cp_g = (const unsigned char*)((uintptr_t)img - (uintptr_t)(lds_u + 4 * GHTB));
    u32x4 cp0, cp1;
#define CPRD(b, h) asm volatile("ds_read_b128 %0, %2 offset:%3\n\tds_read_b128 %1, %2 offset:%4" : "=&v"(cp0), "=&v"(cp1) : "v"(cp_lds), "n"((b) * 2 * GHTB + (h) * 2048), "n"((b) * 2 * GHTB + (h) * 2048 + 1024) : "memory")
#define CPST(tc, h) asm volatile("s_nop 4\n\tglobal_store_dwordx4 %2, %0, %3 sc1\n\tglobal_store_dwordx4 %2, %1, %3 offset:1024 sc1\n\ts_nop 1" :: "v"(cp0), "v"(cp1), "v"(cp_lds), "s"(cp_g + (size_t)(tc) * 32768 + (h) * 2048) : "memory")

#define SA_(b, h) (((b) * 2 + (h)) * GHTB)
#define SB_(b, h) ((4 + (b) * 2 + (h)) * GHTB)
#define STAGE_A(b, h, kt) do { const unsigned char* _g = A + (size_t)(kt) * astepb; \
        dma16((const void*)(_g + (size_t)((h) * 128) * ROWB), ROWB ? aoff[0][0] : aoff[h][0], lds_u + SA_(b, h) + a_dma0); \
        dma16((const void*)(_g + (size_t)((h) * 128 + 64) * ROWB), ROWB ? aoff[0][0] : aoff[h][1], lds_u + SA_(b, h) + a_dma1); } while (0)
#define QLOAD(R, kt, q) do { \
        asm volatile("s_nop 4\n\tglobal_load_dwordx4 %0, %2, %3 nt\n\tglobal_load_dwordx4 %1, %2, %4 nt" : "=&v"(R[0]), "=&v"(R[1]) \
            : "v"(boffb), "s"(B + (size_t)(kt) * bstep + (size_t)(4 * (q)) * LDB), "s"(B + (size_t)(kt) * bstep + (size_t)(4 * (q) + 1) * LDB) : "memory"); \
        asm volatile("s_nop 4\n\tglobal_load_dwordx4 %0, %2, %3 nt\n\tglobal_load_dwordx4 %1, %2, %4 nt" : "=&v"(R[2]), "=&v"(R[3]) \
            : "v"(boffb), "s"(B + (size_t)(kt) * bstep + (size_t)(4 * (q) + 2) * LDB), "s"(B + (size_t)(kt) * bstep + (size_t)(4 * (q) + 3) * LDB) : "memory"); } while (0)
#define QWAIT4(R, n) QWAIT(R, n)
#define QWAIT(R, n) asm volatile("s_waitcnt vmcnt(" #n ")" : "+v"(R[0]), "+v"(R[1]), "+v"(R[2]), "+v"(R[3]) :: "memory")
#define QCVTW(R, b, q) do { _Pragma("unroll") for (int _i = 0; _i < 4; ++_i) { \
            cvd = __builtin_amdgcn_cvt_scalef32_pk_fp8_f32(cvd, R[0][_i], R[1][_i], F8_WSCALE, false); \
            cvd = __builtin_amdgcn_cvt_scalef32_pk_fp8_f32(cvd, R[2][_i], R[3][_i], F8_WSCALE, true); \
            asm volatile("ds_write_b32 %0, %1 offset:%2" :: "v"((_i < 2) ? bw_a0 : bw_a1), "v"(cvd), "n"((b) * 2 * GHTB + (_i & 1) * 128 + (q) * 4) : "memory"); } } while (0)
#define LDA1(dst, b, h, m) do { \
        dst.lo = *(LAS3 const i32x4*)(lds + SA_(b, h) + a_rd0 + (m) * 2048); \
        dst.hi = *(LAS3 const i32x4*)(lds + SA_(b, h) + a_rd1 + (m) * 2048); } while (0)
#define LDB4(dst, b) do { _Pragma("unroll") for (int _h = 0; _h < 2; ++_h) _Pragma("unroll") for (int _n = 0; _n < 2; ++_n) { \
        dst[_h * 2 + _n].lo = *(LAS3 const i32x4*)(lds + SB_(b, _h) + b_rd0 + _n * 8192); \
        dst[_h * 2 + _n].hi = *(LAS3 const i32x4*)(lds + SB_(b, _h) + b_rd1 + _n * 8192); } } while (0)
#define MF4(ai, m, slot) do { _Pragma("unroll") for (int _j = 0; _j < 4; ++_j) \
            acc[ai][_j >> 1][m][_j & 1] = __builtin_amdgcn_mfma_scale_f32_16x16x128_f8f6f4(Bx[_j], slot, acc[ai][_j >> 1][m][_j & 1], 0, 0, 0, 0x7f7f7f77, 1, 0x7f7f7f77); } while (0)
#define MMA16(ai, b, h) do { __builtin_amdgcn_s_setprio(1); MF4(ai, 0, A0); G_SCHED; LDA1(A0, b, h, 2); G_SCHED; MF4(ai, 1, A1); G_SCHED; LDA1(A1, b, h, 3); G_SCHED; \
        G_WAIT_L(2); MF4(ai, 2, A0); G_SCHED; G_WAIT_L(0); MF4(ai, 3, A1); __builtin_amdgcn_s_setprio(0); } while (0)
#define MMA16C(ai, b, h, tc) do { __builtin_amdgcn_s_setprio(1); MF4(ai, 0, A0); G_SCHED; LDA1(A0, b, h, 2); CPRD(b, 0); G_SCHED; MF4(ai, 1, A1); G_SCHED; LDA1(A1, b, h, 3); G_SCHED; \
        G_WAIT_L(2); MF4(ai, 2, A0); G_SCHED; CPST(tc, 0); CPRD(b, 1); G_WAIT_L(2); MF4(ai, 3, A1); G_SCHED; G_WAIT_L(0); CPST(tc, 1); __builtin_amdgcn_s_setprio(0); } while (0)

    f32x4 s0[4], s1[4];
    v2s16 cvd; asm("" : "=v"(cvd));
    v8i32 A0, A1, Bx[4];
#pragma unroll
    for (int ai = 0; ai < 2; ++ai)
#pragma unroll
        for (int bj = 0; bj < 2; ++bj)
#pragma unroll
            for (int m = 0; m < 4; ++m)
#pragma unroll
                for (int n = 0; n < 2; ++n) acc[ai][bj][m][n] = (f32x4){0.f, 0.f, 0.f, 0.f};

    const int p1 = (1 < nt) ? 1 : 0;
    QLOAD(acc[0][0][0], 0, 0); QLOAD(acc[0][0][2], 0, 1); QLOAD(acc[0][1][0], 0, 2); QLOAD(acc[0][1][2], 0, 3);
    STAGE_A(0, 0, 0); STAGE_A(0, 1, 0);
    QLOAD(s0, p1, 0); QLOAD(s1, p1, 1);
    __builtin_amdgcn_s_waitcnt(0);
    QWAIT4(acc[0][0][0], 0); QWAIT4(acc[0][0][2], 0); QWAIT4(acc[0][1][0], 0); QWAIT4(acc[0][1][2], 0); QWAIT(s0, 0); QWAIT(s1, 0);
    QCVTW(acc[0][0][0], 0, 0); QCVTW(acc[0][0][2], 0, 1); QCVTW(acc[0][1][0], 0, 2); QCVTW(acc[0][1][2], 0, 3);
#pragma unroll
    for (int bj = 0; bj < 2; ++bj)
#pragma unroll
        for (int m = 0; m < 4; ++m)
#pragma unroll
            for (int n = 0; n < 2; ++n) acc[0][bj][m][n] = (f32x4){0.f, 0.f, 0.f, 0.f};
    G_WAIT_L(0);
    { int wr1 = wid >> 2; asm volatile("" : "+s"(wr1)); if (wr1 == 1) G_BAR; }
    G_BAR;
#define KTILE(b, tc, tn1, tn2) do { \
          \
        LDB4(Bx, b); G_SCHED; LDA1(A0, b, 0, 0); LDA1(A1, b, 0, 1); \
        QWAIT(s0, 6); QCVTW(s0, (b) ^ 1, 0); QLOAD(s0, tn1, 2); QWAIT(s1, 6); QCVTW(s1, (b) ^ 1, 1); QLOAD(s1, tn1, 3); STAGE_A((b) ^ 1, 0, tn1); \
        G_WAIT_V(10); G_BAR; G_WAIT_L(0); MMA16C(0, b, 0, tc); G_BAR; G_SCHED; \
          \
        LDA1(A0, b, 1, 0); LDA1(A1, b, 1, 1); \
        QWAIT(s0, 10); QCVTW(s0, (b) ^ 1, 2); QLOAD(s0, tn2, 0); QWAIT(s1, 10); QCVTW(s1, (b) ^ 1, 3); QLOAD(s1, tn2, 1); STAGE_A((b) ^ 1, 1, tn1); \
        G_WAIT_V(14); G_WAIT_L(0); G_BAR; MMA16(1, b, 1); G_BAR; G_SCHED; } while (0)
    for (int t = 0; t < nt; t += 2) {
        const int t1 = (t + 1 < nt) ? t + 1 : nt - 1, t2 = (t + 2 < nt) ? t + 2 : nt - 1, t3 = (t + 3 < nt) ? t + 3 : nt - 1;
        KTILE(0, t, t1, t2);
        KTILE(1, t1, t2, t3);
    }
    G_WAIT_V(0); G_WAIT_L(0);
    { int wr0 = wid >> 2; asm volatile("" : "+s"(wr0)); if (wr0 == 0) G_BAR; }
    G_BAR;
#undef KTILE
#undef SA_
#undef SB_
#undef STAGE_A
#undef QLOAD
#undef QWAIT
#undef QCVTW
#undef LDA1
#undef MF4
#undef MMA16
#undef MMA16C
#undef LDB4
#undef QWAIT4
#undef CPRD
#undef CPST
}


__device__ __forceinline__ int lane_id() { int r; asm volatile("v_mbcnt_lo_u32_b32 %0, -1, 0\n\tv_mbcnt_hi_u32_b32 %0, -1, %0" : "=v"(r)); return r; }
#define SWZ_XOR(v, o) __int_as_float(__builtin_amdgcn_ds_swizzle(__float_as_int(v), ((o) << 10) | 0x1F))
__device__ __forceinline__ float half_sum32(float v) {
    v += SWZ_XOR(v, 16); v += SWZ_XOR(v, 8); v += SWZ_XOR(v, 4); v += SWZ_XOR(v, 2); v += SWZ_XOR(v, 1);
    return v;
}
__device__ __forceinline__ float xor32(float v) { const int l = lane_id(); return __int_as_float(__builtin_amdgcn_ds_bpermute((l ^ 32) << 2, __float_as_int(v))); }
__device__ __forceinline__ float wave_sum(float v) { v = half_sum32(v); return v + xor32(v); }
typedef int v8i32d __attribute__((ext_vector_type(8)));
typedef int i32x4d __attribute__((ext_vector_type(4)));
template <bool F8, bool BSW = false, int ROWB = 0, bool ACCUM = false, int ASTEP = 128>
__device__ __forceinline__ void gemm_kloop_dma(f32x4 (&acc)[2][2][4][2], const unsigned char* __restrict__ A, const unsigned (&aoff)[2][2],
                                               const unsigned char* __restrict__ img, int nt, LAS3 char* lds, int tid, int wid, int kbase = 0) {
    constexpr int KMASK = F8 ? 15 : 31;
#define KT_(kt) ((kbase + (kt)) & KMASK)
    const int lane = tid & 63, wr = wid >> 2, wc = wid & 3, fr = lane & 15, fq = lane >> 4;
    const int c0 = fq ^ (fr >> 1);
    const int a_rd0 = (wr * 64 + fr) * 128 + c0 * 16, a_rd1 = (wr * 64 + fr) * 128 + (c0 ^ 4) * 16;
    const int cb = BSW ? (c0 ^ (wc & 1)) : c0;
    const int b_rd0 = (wc * 16 + fr) * 128 + cb * 16, b_rd1 = (wc * 16 + fr) * 128 + (cb ^ 4) * 16;
    const unsigned lds_u = (unsigned)(unsigned long)lds;
    LAS3 const char* ap0 = lds + a_rd0; LAS3 const char* ap1 = lds + a_rd1; LAS3 const char* bp0 = lds + 4 * GHTB + b_rd0; LAS3 const char* bp1 = lds + 4 * GHTB + b_rd1;
    asm volatile("" : "+v"(ap0), "+v"(ap1), "+v"(bp0), "+v"(bp1));
    const int dma0 = wid * 1024, dma1 = (8 + wid) * 1024;
    const unsigned boffl = (unsigned)lane * 16u;

#define SA_(b, h) (((b) * 2 + (h)) * GHTB)
#define SB_(b, h) ((4 + (b) * 2 + (h)) * GHTB)
#define STG_A(b, h, kt) do { const unsigned char* _g = A + (size_t)KT_(kt) * ASTEP; \
        dma16((const void*)(_g + (size_t)((h) * 128) * ROWB), ROWB ? aoff[0][0] : aoff[h][0], lds_u + SA_(b, h) + dma0); \
        dma16((const void*)(_g + (size_t)((h) * 128 + 64) * ROWB), ROWB ? aoff[0][0] : aoff[h][1], lds_u + SA_(b, h) + dma1); } while (0)
#define STG_B(b, h, kt) do { const unsigned char* _g = img + (size_t)KT_(kt) * 32768 + (h) * 16384; \
        dma16((const void*)(_g + dma0), boffl, lds_u + SB_(b, h) + dma0); \
        dma16((const void*)(_g + dma1), boffl, lds_u + SB_(b, h) + dma1); } while (0)
#define LDA_(dst, b, h) do { _Pragma("unroll") for (int _m = 0; _m < 4; ++_m) { \
        dst[_m].lo = *(LAS3 const i32x4d*)(ap0 + SA_(b, h) + _m * 2048); \
        dst[_m].hi = *(LAS3 const i32x4d*)(ap1 + SA_(b, h) + _m * 2048); } } while (0)
#define LDBF(dst, b, h) do { _Pragma("unroll") for (int _n = 0; _n < 2; ++_n) { \
        dst[_n].lo = *(LAS3 const i32x4d*)(bp0 + (SB_(b, h) - 4 * GHTB) + _n * 8192); \
        dst[_n].hi = *(LAS3 const i32x4d*)(bp1 + (SB_(b, h) - 4 * GHTB) + _n * 8192); } } while (0)
#define MMAD(ai, bj, Af, Bf) do { __builtin_amdgcn_s_setprio(1); \
        _Pragma("unroll") for (int _m = 0; _m < 4; ++_m) _Pragma("unroll") for (int _n = 0; _n < 2; ++_n) { \
            if (F8) acc[ai][bj][_m][_n] = __builtin_amdgcn_mfma_scale_f32_16x16x128_f8f6f4(Bf[_n], Af[_m], acc[ai][bj][_m][_n], 0, 0, 0, 0x7f7f7f77, 1, 0x7f7f7f77); \
            else { const i32x4d _bl = Bf[_n].lo, _bh = Bf[_n].hi, _al = Af[_m].lo, _ah = Af[_m].hi;     \
                   acc[ai][bj][_m][_n] = __builtin_amdgcn_mfma_f32_16x16x32_bf16(__builtin_bit_cast(bf16x8, _bl), __builtin_bit_cast(bf16x8, _al), acc[ai][bj][_m][_n], 0, 0, 0); \
                   acc[ai][bj][_m][_n] = __builtin_amdgcn_mfma_f32_16x16x32_bf16(__builtin_bit_cast(bf16x8, _bh), __builtin_bit_cast(bf16x8, _ah), acc[ai][bj][_m][_n], 0, 0, 0); } } \
        __builtin_amdgcn_s_setprio(0); } while (0)

    v8i32d At[4], B0[2], B1[2];
    if (!ACCUM)
#pragma unroll
    for (int ai = 0; ai < 2; ++ai)
#pragma unroll
        for (int bj = 0; bj < 2; ++bj)
#pragma unroll
            for (int m = 0; m < 4; ++m)
#pragma unroll
                for (int n = 0; n < 2; ++n) acc[ai][bj][m][n] = (f32x4){0.f, 0.f, 0.f, 0.f};
    STG_B(0, 0, 0); STG_A(0, 0, 0); STG_B(0, 1, 0); STG_A(0, 1, 0);
    __builtin_amdgcn_s_waitcnt(0);
    { int wr1 = wid >> 2; asm volatile("" : "+s"(wr1)); if (wr1 == 1) G_BAR; }
    G_BAR;
    { const int p1 = (1 < nt) ? 1 : 0; STG_B(1, 0, p1); STG_A(1, 0, p1); STG_B(1, 1, p1); }
    G_WAIT_V(6); G_BAR;
    for (int t = 0; t < nt; t += 2) {
        const int t1 = (t + 1 < nt) ? t + 1 : nt - 1, t2 = (t + 2 < nt) ? t + 2 : nt - 1, t3 = (t + 3 < nt) ? t + 3 : nt - 1;
        LDBF(B0, 0, 0); G_SCHED; LDA_(At, 0, 0); STG_A(1, 1, t1);
        G_WAIT_L(8); G_BAR; G_WAIT_L(0); MMAD(0, 0, At, B0); G_BAR; G_SCHED;
        LDBF(B1, 0, 1); STG_B(0, 0, t2);
        G_BAR; G_WAIT_L(0); MMAD(0, 1, At, B1); G_BAR;
        LDA_(At, 0, 1); STG_A(0, 0, t2);
        G_BAR; G_WAIT_L(0); MMAD(1, 0, At, B0); G_BAR; G_SCHED;
        STG_B(0, 1, t2);
        G_WAIT_V(6); G_BAR; MMAD(1, 1, At, B1); G_BAR;
        LDBF(B0, 1, 0); G_SCHED; LDA_(At, 1, 0); STG_A(0, 1, t2);
        G_WAIT_L(8); G_BAR; G_WAIT_L(0); MMAD(0, 0, At, B0); G_BAR; G_SCHED;
        LDBF(B1, 1, 1); STG_B(1, 0, t3);
        G_BAR; G_WAIT_L(0); MMAD(0, 1, At, B1); G_BAR;
        LDA_(At, 1, 1); STG_A(1, 0, t3);
        G_BAR; G_WAIT_L(0); MMAD(1, 0, At, B0); G_BAR; G_SCHED;
        STG_B(1, 1, t3);
        G_WAIT_V(6); G_BAR; MMAD(1, 1, At, B1); G_BAR;
    }
    G_WAIT_V(0); G_WAIT_L(0);
    { int wr0 = wid >> 2; asm volatile("" : "+s"(wr0)); if (wr0 == 0) G_BAR; }
    G_BAR;
#undef SA_
#undef SB_
#undef STG_A
#undef STG_B
#undef LDA_
#undef LDBF
#undef MMAD
#undef KT_
}

template <bool F8, int LDB>
__device__ __forceinline__ void convert_tile(const float* __restrict__ W, int col0, int col1, int nkt, unsigned char* __restrict__ img, LAS3 char* lds, int wid) {
    constexpr int RPT = F8 ? 16 : 8;
    int lane = lane_id(); asm volatile("" : "+v"(lane));
    const int n4 = lane, half = n4 >> 5, nloc = (n4 & 31) * 4;
    const float* src = W + (size_t)(wid * RPT) * LDB + ((n4 < 32) ? col0 + n4 * 4 : col1 + (n4 - 32) * 4);
    for (int kt = 0; kt < nkt; ++kt) {
        f32x4 r[RPT];
#pragma unroll
        for (int j = 0; j < RPT; ++j) r[j] = *(const f32x4*)(src + (size_t)(kt * (RPT * 8) + j) * LDB);
        LAS3 char* buf = lds + (kt & 1) * 32768;
#pragma unroll
        for (int i = 0; i < 4; ++i) {
            u32x4 w;
            if (F8) {
#pragma unroll
                for (int q = 0; q < 4; ++q) {
                    int d = __builtin_amdgcn_cvt_pk_fp8_f32(r[4 * q][i] * 256.0f, r[4 * q + 1][i] * 256.0f, 0, false);
                    d = __builtin_amdgcn_cvt_pk_fp8_f32(r[4 * q + 2][i] * 256.0f, r[4 * q + 3][i] * 256.0f, d, true);
                    w[q] = (unsigned)d;
                }
            } else {
                w.x = cvt_pk_bf16(r[0][i], r[1][i]); w.y = cvt_pk_bf16(r[2][i], r[3][i]); w.z = cvt_pk_bf16(r[4][i], r[5][i]); w.w = cvt_pk_bf16(r[6][i], r[7][i]);
            }
            const int row = nloc + i;
            *(LAS3 u32x4*)(buf + half * 16384 + row * 128 + ((wid ^ ((row >> 1) & 7)) << 4)) = w;
        }
        __syncthreads();
#pragma unroll
        for (int j = 0; j < 4; ++j) {
            const u32x4 v = *(LAS3 const u32x4*)(buf + wid * 4096 + j * 1024 + lane * 16);
            *(u32x4*)(img + (size_t)kt * 32768 + wid * 4096 + j * 1024 + lane * 16) = v;
        }
    }
    __syncthreads();
}

template <int LDB>
__device__ __forceinline__ void convert_image(const float* __restrict__ W, int col0, int col1, unsigned char* __restrict__ img, LAS3 char* lds, int wid) {
    int lane = lane_id(); asm volatile("" : "+v"(lane));
    const int n4 = lane, half = n4 >> 5, nloc = (n4 & 31) * 4;
    const float* src = W + (size_t)(wid * 16) * LDB + ((n4 < 32) ? col0 + n4 * 4 : col1 + (n4 - 32) * 4);
    const unsigned cpo = (unsigned)(wid * 4096 + lane * 16);
#define CI_LOAD(R, kt) do { _Pragma("unroll") for (int _j = 0; _j < 16; ++_j) R[_j] = __builtin_nontemporal_load((const f32x4*)(src + (size_t)((kt) * 128 + _j) * LDB)); } while (0)
#define CI_CONV(R, kt) do { LAS3 char* _buf = lds + ((kt) & 1) * 32768; \
        _Pragma("unroll") for (int _i = 0; _i < 4; ++_i) { u32x4 _w; \
            _Pragma("unroll") for (int _q = 0; _q < 4; ++_q) { v2s16 _d; asm("" : "=v"(_d)); \
                _d = __builtin_amdgcn_cvt_scalef32_pk_fp8_f32(_d, R[4 * _q][_i], R[4 * _q + 1][_i], F8_WSCALE, false); \
                _d = __builtin_amdgcn_cvt_scalef32_pk_fp8_f32(_d, R[4 * _q + 2][_i], R[4 * _q + 3][_i], F8_WSCALE, true); \
                _w[_q] = __builtin_bit_cast(unsigned, _d); } \
            const int _row = nloc + _i; \
            *(LAS3 u32x4*)(_buf + half * 16384 + _row * 128 + ((wid ^ ((_row >> 1) & 7)) << 4)) = _w; } \
        __syncthreads(); \
        _Pragma("unroll") for (int _j = 0; _j < 4; ++_j) { const u32x4 _v = *(LAS3 const u32x4*)(_buf + wid * 4096 + _j * 1024 + lane * 16); \
            asm volatile("s_nop 4\n\tglobal_store_dwordx4 %0, %1, %2 sc1\n\ts_nop 1" :: "v"(cpo + (unsigned)(_j * 1024)), "v"(_v), "s"(img + (size_t)(kt) * 32768) : "memory"); } } while (0)
    f32x4 ra[16], rb[16];
    CI_LOAD(ra, 0);
    for (int kt = 0; kt < 16; kt += 2) {
        CI_LOAD(rb, kt + 1); G_SCHED;
        CI_CONV(ra, kt); G_SCHED;
        CI_LOAD(ra, (kt + 2 < 16) ? kt + 2 : 15); G_SCHED;
        CI_CONV(rb, kt + 1); G_SCHED;
    }
    asm volatile("s_waitcnt vmcnt(0)" ::: "memory");
    __syncthreads();
#undef CI_LOAD
#undef CI_CONV
}

__device__ __forceinline__ float gelu_exact(float x) { return 0.5f * x * (1.0f + erff(x * 0.70710678118654752f)); }
__device__ __forceinline__ float bf2f(bf16_t v) { return __uint_as_float((unsigned)v << 16); }
__device__ __forceinline__ bf16_t f2bf(float v) { return (bf16_t)(cvt_pk_bf16(v, 0.f) & 0xffffu); }

struct GemmArgs {
    const bf16_t* A; const float* B; const float* bias; const float* R;
    void* C;
    const int* list; const int* cnt;
    int abase;
};

struct TileSync {
    int* flag;
    unsigned* qctr;
    unsigned qtag;
    LAS3 unsigned* qslot;
    int* dep; int depn;
    int* pend;
};

__device__ __forceinline__ int ld_early(const int* ptr) { int r; unsigned z;
    asm volatile("v_mov_b32 %1, 0\n\ts_nop 4\n\tglobal_load_dword %0, %1, %2 sc1" : "=&v"(r), "=&v"(z) : "s"(ptr) : "memory"); return r; }
#define LD_WAIT(r) asm volatile("s_waitcnt vmcnt(0)" : "+v"(r) :: "memory")
__device__ __forceinline__ int ld_now(const int* ptr) { int r = ld_early(ptr); LD_WAIT(r); return r; }
__device__ __forceinline__ unsigned inc_early(unsigned* ptr) { unsigned r, z;
    asm volatile("v_mov_b32 %1, 0\n\tv_mov_b32 %0, 1\n\ts_nop 4\n\tglobal_atomic_add %0, %1, %0, %2 sc0" : "=&v"(r), "=&v"(z) : "s"(ptr) : "memory"); return r; }

constexpr int EST_BF16 = 528;
constexpr int EST_F8 = 144;
constexpr int LDS_BIAS = 256 * EST_BF16 + 3072;
__device__ __forceinline__ void epi_stage_bf16(const f32x4 (&v)[2][2], int r, int colw, LAS3 char* lds) {
#pragma unroll
    for (int bj = 0; bj < 2; ++bj)
#pragma unroll
        for (int n = 0; n < 2; ++n) { u32x2 o; o.x = cvt_pk_bf16(v[bj][n][0], v[bj][n][1]); o.y = cvt_pk_bf16(v[bj][n][2], v[bj][n][3]);
            *(LAS3 u32x2*)(lds + r * EST_BF16 + (bj * 128 + n * 64 + colw) * 2) = o; }
}
__device__ __forceinline__ void epi_flush_bf16(bf16_t* C, size_t ld, int grow0, int col0, int nvalid, LAS3 char* lds, int tid) {
    __syncthreads();
    const int chunk = tid & 31, r0 = tid >> 5;
#pragma unroll 4
    for (int it = 0; it < 16; ++it) { const int row = it * 16 + r0;
        if (row < nvalid) { const u32x4 q = *(LAS3 const u32x4*)(lds + row * EST_BF16 + chunk * 16); *(u32x4*)(C + ((unsigned)(grow0 + row) * (unsigned)ld + (unsigned)(col0 + chunk * 8))) = q; } }
    __syncthreads();
}
__device__ __forceinline__ void epi_flush_f8(unsigned char* C, size_t ld, int grow0, int col0, int nvalid, LAS3 char* lds, int tid) {
    __syncthreads();
    const int chunk = tid & 7, r0 = tid >> 3;
#pragma unroll
    for (int it = 0; it < 4; ++it) { const int row = it * 64 + r0;
        if (row < nvalid) { const u32x4 q = *(LAS3 const u32x4*)(lds + row * EST_F8 + chunk * 16);
            const unsigned off = ((((unsigned)grow0 >> 8) * (unsigned)(ld >> 7) + ((unsigned)col0 >> 7)) * 256u + (unsigned)row) * 128u + (unsigned)(chunk * 16);
            asm volatile("s_nop 4\n\tglobal_store_dwordx4 %0, %1, %2 sc1 nt\n\ts_nop 1" :: "v"(off), "v"(q), "s"(C) : "memory"); } }
    __syncthreads();
}

constexpr int EST_F8W = 272;
__device__ __forceinline__ void epi_flush_f8w(unsigned char* C, size_t ld, int grow0, int col0, int nvalid, LAS3 char* lds, int tid) {
    __syncthreads();
    const int chunk = tid & 15, r0 = tid >> 4;
#pragma unroll
    for (int it = 0; it < 8; ++it) { const int row = it * 32 + r0;
        if (row < nvalid) { const u32x4 q = *(LAS3 const u32x4*)(lds + row * EST_F8W + chunk * 16);
            const unsigned off = (unsigned)(grow0 + row) * (unsigned)ld + (unsigned)(col0 + chunk * 16);
            asm volatile("s_nop 4\n\tglobal_store_dwordx4 %0, %1, %2 nt\n\ts_nop 1" :: "v"(off), "v"(q), "s"(C) : "memory"); } }
    __syncthreads();
}
template <int EPI, int VAR = 0>
__device__ __forceinline__ void gemm_tile(const GemmArgs& g, int pm, int pn, int e, int ebase, int ecnt, LAS3 char* lds, int wid, unsigned char* img, const TileSync& sy) {
    constexpr int LDB = (EPI == 0) ? DIN : (EPI == 2) ? 2 * DFF : D;
    int tid = wid * 64 + lane_id(); asm volatile("" : "+v"(tid));
    const int lane = tid & 63;
    unsigned aoff[2][2];
#pragma unroll
    for (int h = 0; h < 2; ++h)
#pragma unroll
        for (int i = 0; i < 2; ++i) {
            const int rih = (i * 8 + wid) * 8 + (lane >> 3);
            const int chunk = (lane & 7) ^ ((rih >> 1) & 7);
            int r = pm * 256 + h * 128 + rih;
            unsigned grow;
            if (EPI == 2) { if (r >= ecnt) r = ecnt - 1; grow = (unsigned)(g.list[e * T + r] >> 2); }
            else if (EPI == 3) { grow = (unsigned)(((g.abase >> 8) + pm) * (16 * 256) + h * 128 + rih); }
            else grow = (unsigned)r;
            aoff[h][i] = (EPI == 3) ? (grow * 128u + (unsigned)(chunk * 16)) : (EPI >= 2) ? (grow * (unsigned)D + (unsigned)(chunk * 16)) : (grow * (unsigned)D + (unsigned)(chunk * 8)) * 2u;
        }
    const int k8 = wid, n4 = tid & 63;
    int col;
    if (EPI == 2) col = (n4 < 32) ? pn * 128 + n4 * 4 : DFF + pn * 128 + (n4 - 32) * 4;
    else col = pn * 256 + n4 * 4;
    const unsigned boff = (unsigned)(k8 * ((EPI >= 2) ? 16 : 8)) * (unsigned)LDB + (unsigned)col;
    const float* Bp = g.B;
    if (EPI == 2) Bp += (size_t)e * D * (2 * DFF);
    if (EPI == 3) Bp += (size_t)e * DFF * D;
    if (EPI >= 2 && tid < 256) {
        float bvv;
        if (EPI == 2) bvv = (tid < 128) ? g.bias[(size_t)e * (2 * DFF) + pn * 128 + tid] : g.bias[(size_t)e * (2 * DFF) + DFF + pn * 128 + (tid - 128)] + 1.0f;
        else bvv = g.bias[(size_t)e * D + pn * 256 + tid];
        *(LAS3 float*)(lds + LDS_BIAS + tid * 4) = bvv;
    }
    if (EPI >= 2) {
        if (tid == 0) {
            if (sy.dep) { unsigned sp = 0; while (ld_now(sy.dep) < sy.depn) { __builtin_amdgcn_s_sleep(8); if (++sp > (1u << 20)) break; }
                __builtin_amdgcn_fence(__ATOMIC_ACQUIRE, "agent"); asm volatile("s_waitcnt vmcnt(0)" ::: "memory"); } }
        if (sy.dep) __syncthreads();
    }
    f32x4 acc[2][2][4][2];
    if (EPI >= 2) gemm_kloop_f8<LDB, (EPI == 3) ? 128 : 0, (EPI == 3) ? 32768 : 128>(acc, (const unsigned char*)g.A, aoff, Bp, boff, D / 128, lds, tid, wid, img);
    else gemm_kloop<LDB, VAR>(acc, g.A, aoff, Bp, boff, D / GBK, lds, tid, wid);
    int tz = wid * 64 + lane_id(); asm volatile("" : "+v"(tz));
    if (EPI >= 2 && sy.pend && tz == 0) __hip_atomic_fetch_add(sy.pend, 1, __ATOMIC_RELAXED, __HIP_MEMORY_SCOPE_AGENT);
    unsigned nx = 0;
    if (EPI >= 2 && tz == 0) nx = inc_early(sy.qctr);
    if (EPI >= 2 && tz == 0) __hip_atomic_store(sy.flag, 1, __ATOMIC_RELAXED, __HIP_MEMORY_SCOPE_AGENT);
    const int wid2 = tz >> 6, lane2 = tz & 63;
    const int row0 = (wid2 >> 2) * 64 + (lane2 & 15), colw = (wid2 & 3) * 16 + (lane2 >> 4) * 4;
    if (EPI == 0) {
#pragma unroll
        for (int ai = 0; ai < 2; ++ai)
#pragma unroll
            for (int m = 0; m < 4; ++m) {
                f32x4 v[2][2];
#pragma unroll
                for (int bj = 0; bj < 2; ++bj)
#pragma unroll
                    for (int n = 0; n < 2; ++n) v[bj][n] = acc[ai][bj][m][n];
                epi_stage_bf16(v, ai * 128 + row0 + m * 16, colw, lds);
            }
        epi_flush_bf16((bf16_t*)g.C, DIN, pm * 256, pn * 256, 256, lds, tz);
    } else if (EPI == 1) {
        float* C = (float*)g.C;
#pragma unroll
        for (int ai = 0; ai < 2; ++ai)
#pragma unroll
            for (int m = 0; m < 4; ++m) {
                const size_t ro = (size_t)(pm * 256 + ai * 128 + row0 + m * 16) * D + pn * 256 + colw;
#pragma unroll
                for (int bj = 0; bj < 2; ++bj)
#pragma unroll
                    for (int n = 0; n < 2; ++n) { const f32x4 xr = *(const f32x4*)(g.R + ro + bj * 128 + n * 64);
                        *(f32x4*)(C + ro + bj * 128 + n * 64) = acc[ai][bj][m][n] + xr; }
            }
    } else if (EPI == 2) {
        unsigned char* C = (unsigned char*)g.C;
        f32x4 bgate[2], bup1[2];
#pragma unroll
        for (int n = 0; n < 2; ++n) { bgate[n] = *(LAS3 const f32x4*)(lds + LDS_BIAS + (n * 64 + colw) * 4); bup1[n] = *(LAS3 const f32x4*)(lds + LDS_BIAS + (128 + n * 64 + colw) * 4); }
#pragma unroll
        for (int ai = 0; ai < 2; ++ai)
#pragma unroll
            for (int m = 0; m < 4; ++m) {
                const int r = pm * 256 + ai * 128 + row0 + m * 16;
                {
                    LAS3 char* rp = lds + (ai * 128 + row0 + m * 16) * EST_F8 + colw;
#pragma unroll
                    for (int n = 0; n < 2; ++n) {
                        float o[4];
#pragma unroll
                        for (int j = 0; j < 4; j += 2) {
                            typedef float f32x2 __attribute__((ext_vector_type(2)));
                            f32x2 gt = (f32x2){acc[ai][0][m][n][j], acc[ai][0][m][n][j + 1]} + (f32x2){bgate[n][j], bgate[n][j + 1]};
                            f32x2 up = (f32x2){acc[ai][1][m][n][j], acc[ai][1][m][n][j + 1]} + (f32x2){bup1[n][j], bup1[n][j + 1]};
                            gt.x = fminf(gt.x, 7.0f); gt.y = fminf(gt.y, 7.0f);
                            up.x = __builtin_amdgcn_fmed3f(up.x, -6.0f, 8.0f); up.y = __builtin_amdgcn_fmed3f(up.y, -6.0f, 8.0f);
                            const f32x2 xe = gt * (-2.45546696f);
                            f32x2 ex; ex.x = __builtin_amdgcn_exp2f(xe.x); ex.y = __builtin_amdgcn_exp2f(xe.y);
                            const f32x2 den = ex + 1.0f;
                            f32x2 rc; rc.x = __builtin_amdgcn_rcpf(den.x); rc.y = __builtin_amdgcn_rcpf(den.y);
                            const f32x2 res = (gt * rc) * up;
                            o[j] = res.x; o[j + 1] = res.y;
                        }
                        int w = __builtin_amdgcn_cvt_pk_fp8_f32(o[0], o[1], 0, false);
                        w = __builtin_amdgcn_cvt_pk_fp8_f32(o[2], o[3], w, true);
                        *(LAS3 int*)(rp + n * 64) = w;
                    }
                }
            }
        { const int nv = ecnt - pm * 256; epi_flush_f8(C, DFF, g.abase + pm * 256, pn * 128, nv < 256 ? nv : 256, lds, tz); }
    } else {
        bf16_t* C = (bf16_t*)g.C;
        f32x4 bv[2][2];
#pragma unroll
        for (int bj = 0; bj < 2; ++bj)
#pragma unroll
            for (int n = 0; n < 2; ++n) bv[bj][n] = *(LAS3 const f32x4*)(lds + LDS_BIAS + (bj * 128 + n * 64 + colw) * 4);
#pragma unroll
        for (int ai = 0; ai < 2; ++ai)
#pragma unroll
            for (int m = 0; m < 4; ++m) {
                LAS3 char* rp = lds + (ai * 128 + row0 + m * 16) * EST_F8W + colw;
#pragma unroll
                for (int bj = 0; bj < 2; ++bj)
#pragma unroll
                    for (int n = 0; n < 2; ++n) { const f32x4 v = acc[ai][bj][m][n] + bv[bj][n];
                        int w = __builtin_amdgcn_cvt_pk_fp8_f32(v[0], v[1], 0, false); w = __builtin_amdgcn_cvt_pk_fp8_f32(v[2], v[3], w, true);
                        *(LAS3 int*)(rp + bj * 128 + n * 64) = w; }
            }
        { const int nv = ecnt - pm * 256; epi_flush_f8w((unsigned char*)g.C, D, ebase + pm * 256, pn * 256, nv < 256 ? nv : 256, lds, tz); }
    }
    if (EPI >= 2 && tz == 0) { LD_WAIT(nx); *sy.qslot = sy.qtag | nx; }
}


template <int EPI>
__device__ __forceinline__ void gemm_tile_img(const GemmArgs& g, int pm, int pn, int e, int ebase, int ecnt, LAS3 char* lds, int wid, const unsigned char* img, const TileSync& sy, int kh = -1) {
    int tid = wid * 64 + lane_id(); asm volatile("" : "+v"(tid));
    const int lane = tid & 63;
    int fl0 = 1, dp0 = 0;
    if (EPI >= 2) { fl0 = ld_early(sy.flag); dp0 = ld_early(sy.dep ? sy.dep : sy.flag); }
    unsigned aoff[2][2];
#pragma unroll
    for (int h = 0; h < 2; ++h)
#pragma unroll
        for (int i = 0; i < 2; ++i) {
            const int rih = (i * 8 + wid) * 8 + (lane >> 3);
            const int chunk = (lane & 7) ^ ((rih >> 1) & 7);
            int r = pm * 256 + h * 128 + rih;
            unsigned grow;
            if (EPI == 2) { if (r >= ecnt) r = ecnt - 1; grow = (unsigned)(g.list[e * T + r] >> 2); }
            else if (EPI == 3) { grow = (unsigned)(((g.abase >> 8) + pm) * (16 * 256) + h * 128 + rih); }
            else grow = (unsigned)r;
            aoff[h][i] = (EPI == 3) ? (grow * 128u + (unsigned)(chunk * 16)) : (EPI >= 2) ? (grow * (unsigned)D + (unsigned)(chunk * 16)) : (grow * (unsigned)D + (unsigned)(chunk * 8)) * 2u;
        }
    if (EPI >= 2) {
        if (tid < 256) {
            float bvv;
            if (EPI == 2) bvv = (tid < 128) ? g.bias[(size_t)e * (2 * DFF) + pn * 128 + tid] : g.bias[(size_t)e * (2 * DFF) + DFF + pn * 128 + (tid - 128)] + 1.0f;
            else bvv = g.bias[(size_t)e * D + pn * 256 + tid];
            *(LAS3 float*)(lds + LDS_BIAS + tid * 4) = bvv;
        }
        asm volatile("s_waitcnt vmcnt(0)" : "+v"(fl0), "+v"(dp0) :: "memory");
        if (tid == 0) {
            unsigned sp = 0;
            if (fl0 == 0) while (ld_now(sy.flag) == 0) { __builtin_amdgcn_s_sleep(8); if (++sp > (1u << 20)) break; }
            if (sy.dep && dp0 < sy.depn) { while (ld_now(sy.dep) < sy.depn) { __builtin_amdgcn_s_sleep(8); if (++sp > (1u << 20)) break; } }
            __builtin_amdgcn_fence(__ATOMIC_ACQUIRE, "agent"); asm volatile("s_waitcnt vmcnt(0)" ::: "memory"); }
        __syncthreads();
    }
    f32x4 acc[2][2][4][2];
    gemm_kloop_dma<(EPI >= 2), false, (EPI == 2) ? 0 : (EPI == 3) ? 128 : 2 * D, false, (EPI == 3) ? 32768 : 128>(acc, (const unsigned char*)g.A, aoff, img, (EPI >= 2) ? D / 128 : (EPI == 0 && kh >= 0) ? D / 128 : D / 64, lds, tid, wid, (EPI == 0 && kh > 0) ? D / 128 : 0);
    int tz = wid * 64 + lane_id(); asm volatile("" : "+v"(tz));
    if (EPI >= 2 && sy.pend && tz == 0) __hip_atomic_fetch_add(sy.pend, 1, __ATOMIC_RELAXED, __HIP_MEMORY_SCOPE_AGENT);
    unsigned nx = 0;
    if (EPI >= 2 && tz == 0) nx = inc_early(sy.qctr);
    const int wid2 = tz >> 6, lane2 = tz & 63;
    const int row0 = (wid2 >> 2) * 64 + (lane2 & 15), colw = (wid2 & 3) * 16 + (lane2 >> 4) * 4;
    if (EPI == 0) {
#pragma unroll
        for (int ai = 0; ai < 2; ++ai)
#pragma unroll
            for (int m = 0; m < 4; ++m) {
                f32x4 v[2][2];
#pragma unroll
                for (int bj = 0; bj < 2; ++bj)
#pragma unroll
                    for (int n = 0; n < 2; ++n) v[bj][n] = acc[ai][bj][m][n];
                epi_stage_bf16(v, ai * 128 + row0 + m * 16, colw, lds);
            }
        if (kh > 0) epi_flush_bf16((bf16_t*)g.R, DIN - 4096, pm * 256, pn * 256 - 4096, 256, lds, tz);
        else epi_flush_bf16((bf16_t*)g.C, DIN, pm * 256, pn * 256, 256, lds, tz);
    } else if (EPI == 1) {
        float* C = (float*)g.C;
#pragma unroll
        for (int ai = 0; ai < 2; ++ai)
#pragma unroll
            for (int m = 0; m < 4; ++m) {
                const size_t ro = (size_t)(pm * 256 + ai * 128 + row0 + m * 16) * D + pn * 256 + colw;
#pragma unroll
                for (int bj = 0; bj < 2; ++bj)
#pragma unroll
                    for (int n = 0; n < 2; ++n) { const f32x4 xr = *(const f32x4*)(g.R + ro + bj * 128 + n * 64);
                        *(f32x4*)(C + ro + bj * 128 + n * 64) = acc[ai][bj][m][n] + xr; }
            }
    } else if (EPI == 2) {
        unsigned char* C = (unsigned char*)g.C;
        f32x4 bgate[2], bup1[2];
#pragma unroll
        for (int n = 0; n < 2; ++n) { bgate[n] = *(LAS3 const f32x4*)(lds + LDS_BIAS + (n * 64 + colw) * 4); bup1[n] = *(LAS3 const f32x4*)(lds + LDS_BIAS + (128 + n * 64 + colw) * 4); }
#pragma unroll
        for (int ai = 0; ai < 2; ++ai)
#pragma unroll
            for (int m = 0; m < 4; ++m) {
                const int r = pm * 256 + ai * 128 + row0 + m * 16;
                {
                    LAS3 char* rp = lds + (ai * 128 + row0 + m * 16) * EST_F8 + colw;
#pragma unroll
                    for (int n = 0; n < 2; ++n) {
                        float o[4];
#pragma unroll
                        for (int j = 0; j < 4; j += 2) {
                            typedef float f32x2 __attribute__((ext_vector_type(2)));
                            f32x2 gt = (f32x2){acc[ai][0][m][n][j], acc[ai][0][m][n][j + 1]} + (f32x2){bgate[n][j], bgate[n][j + 1]};
                            f32x2 up = (f32x2){acc[ai][1][m][n][j], acc[ai][1][m][n][j + 1]} + (f32x2){bup1[n][j], bup1[n][j + 1]};
                            gt.x = fminf(gt.x, 7.0f); gt.y = fminf(gt.y, 7.0f);
                            up.x = __builtin_amdgcn_fmed3f(up.x, -6.0f, 8.0f); up.y = __builtin_amdgcn_fmed3f(up.y, -6.0f, 8.0f);
                            const f32x2 xe = gt * (-2.45546696f);
                            f32x2 ex; ex.x = __builtin_amdgcn_exp2f(xe.x); ex.y = __builtin_amdgcn_exp2f(xe.y);
                            const f32x2 den = ex + 1.0f;
                            f32x2 rc; rc.x = __builtin_amdgcn_rcpf(den.x); rc.y = __builtin_amdgcn_rcpf(den.y);
                            const f32x2 res = (gt * rc) * up;
                            o[j] = res.x; o[j + 1] = res.y;
                        }
                        int w = __builtin_amdgcn_cvt_pk_fp8_f32(o[0], o[1], 0, false);
                        w = __builtin_amdgcn_cvt_pk_fp8_f32(o[2], o[3], w, true);
                        *(LAS3 int*)(rp + n * 64) = w;
                    }
                }
            }
        { const int nv = ecnt - pm * 256; epi_flush_f8(C, DFF, g.abase + pm * 256, pn * 128, nv < 256 ? nv : 256, lds, tz); }
    } else {
        bf16_t* C = (bf16_t*)g.C;
        f32x4 bv[2][2];
#pragma unroll
        for (int bj = 0; bj < 2; ++bj)
#pragma unroll
            for (int n = 0; n < 2; ++n) bv[bj][n] = *(LAS3 const f32x4*)(lds + LDS_BIAS + (bj * 128 + n * 64 + colw) * 4);
#pragma unroll
        for (int ai = 0; ai < 2; ++ai)
#pragma unroll
            for (int m = 0; m < 4; ++m) {
                LAS3 char* rp = lds + (ai * 128 + row0 + m * 16) * EST_F8W + colw;
#pragma unroll
                for (int bj = 0; bj < 2; ++bj)
#pragma unroll
                    for (int n = 0; n < 2; ++n) { const f32x4 v = acc[ai][bj][m][n] + bv[bj][n];
                        int w = __builtin_amdgcn_cvt_pk_fp8_f32(v[0], v[1], 0, false); w = __builtin_amdgcn_cvt_pk_fp8_f32(v[2], v[3], w, true);
                        *(LAS3 int*)(rp + bj * 128 + n * 64) = w; }
            }
        { const int nv = ecnt - pm * 256; epi_flush_f8w((unsigned char*)g.C, D, ebase + pm * 256, pn * 256, nv < 256 ? nv : 256, lds, tz); }
    }
    if (EPI >= 2 && tz == 0) { LD_WAIT(nx); *sy.qslot = sy.qtag | nx; }
}

#define XB_TMO      128
#define XB_XCNT(j)  (256  + 64 * (j))
#define XB_XSUB(j)  (1280 + 64 * (j))
#define XB_XGEN(j)  (2304 + 64 * (j))
#define XB_TOP      3328
#define XB_TOPGEN   3392
#define XCD_BAR_WORDS 3456
#define XB_SPIN_CAP (1u << 18)
#define LAS __attribute__((address_space(3)))

__device__ __forceinline__ unsigned xb_ld(unsigned* p)              { return __hip_atomic_load(p, __ATOMIC_RELAXED, __HIP_MEMORY_SCOPE_AGENT); }
__device__ __forceinline__ unsigned xb_add(unsigned* p, unsigned v) { return __hip_atomic_fetch_add(p, v, __ATOMIC_RELAXED, __HIP_MEMORY_SCOPE_AGENT); }
__device__ __forceinline__ unsigned xb_xcc_id() { return (unsigned)__builtin_amdgcn_s_getreg((3 << 11) | 20) & 0xFu; }
#define XB_SPIN(cond, bar) do { unsigned _sp = 0; while (cond) { __builtin_amdgcn_s_sleep(1); \
    if ((++_sp & 255u) == 0u) { if (xb_ld(&(bar)[XB_TMO])) break; if (_sp > XB_SPIN_CAP) { atomicAdd(&(bar)[XB_TMO], 1u); break; } } } } while (0)

struct XcdBarrier {
    unsigned* bar; unsigned x;
    volatile LAS unsigned* st;
};
__device__ __forceinline__ XcdBarrier xcd_barrier_post(unsigned* bar, volatile LAS unsigned* st, int tid) {
    XcdBarrier b; b.bar = bar; b.x = xb_xcc_id(); b.st = st;
    if (tid == 0) (void)xb_add(&bar[XB_XCNT(b.x)], 1u);
    return b;
}
__device__ __forceinline__ void xcd_barrier_complete(unsigned* bar, unsigned x, unsigned& nloc, unsigned& nx) {
    const unsigned G = gridDim.x * gridDim.y * gridDim.z;
    unsigned sum, cnt, mine, sp = 0u;
    for (;;) {
        sum = 0u; cnt = 0u; mine = 0u;
#pragma unroll
        for (unsigned j = 0; j < 16; ++j) { const unsigned c = xb_ld(&bar[XB_XCNT(j)]); sum += c; cnt += (c > 0u) ? 1u : 0u; mine = (j == x) ? c : mine; }
        if (sum == G) break;
        __builtin_amdgcn_s_sleep(1);
        if ((++sp & 255u) == 0u) { if (xb_ld(&bar[XB_TMO])) break; if (sp > XB_SPIN_CAP) { atomicAdd(&bar[XB_TMO], 1u); break; } }
    }
    nloc = mine > 0u ? mine : 1u; nx = cnt > 0u ? cnt : 1u;
}
__device__ __forceinline__ void xcd_barrier(const XcdBarrier& b, int tid) {
    asm volatile("s_waitcnt vmcnt(0)" ::: "memory");
    __syncthreads();
    if (tid == 0) {
        unsigned* bar = b.bar;
        __builtin_amdgcn_s_waitcnt(0);
        unsigned nloc = b.st[0], nx = b.st[1];
        if (nloc == 0u) { xcd_barrier_complete(bar, b.x, nloc, nx); b.st[0] = nloc; b.st[1] = nx; }
        const unsigned old = xb_add(&bar[XB_XSUB(b.x)], 1u);
        const unsigned gen = old / nloc;
        if (old + 1u == (gen + 1u) * nloc) {
            __builtin_amdgcn_fence(__ATOMIC_RELEASE, "agent");
            asm volatile("s_waitcnt vmcnt(0)" ::: "memory");
            const unsigned og = xb_add(&bar[XB_TOP], 1u);
            const unsigned tg = og / nx;
            if (og + 1u == (tg + 1u) * nx) xb_add(&bar[XB_TOPGEN], 1u);
            else XB_SPIN(xb_ld(&bar[XB_TOPGEN]) == tg, bar);
            __builtin_amdgcn_fence(__ATOMIC_ACQUIRE, "agent");
            xb_add(&bar[XB_XGEN(b.x)], 1u);
            asm volatile("s_waitcnt vmcnt(0)" ::: "memory");
        } else {
            XB_SPIN(xb_ld(&bar[XB_XGEN(b.x)]) == gen, bar);
            __builtin_amdgcn_fence(__ATOMIC_ACQUIRE, "agent");
            asm volatile("s_waitcnt vmcnt(0)" ::: "memory");
        }
    }
    __syncthreads();
}

struct Params {
    const float *x, *ln_mix_g, *w_in, *conv_w, *sgu_ln_g, *sgu_ln_b, *sgu_w, *sgu_b, *gn_conv, *gn_sgu, *w_out, *ln_ffn_g, *w_router, *b_router,
                *w_gate_up, *b_gate_up, *w_down, *b_down, *ln_final_g;
    float* out;
    unsigned* bar; int* cnt; int* list; int* sel; float* gates;
    bf16_t *xn, *proj, *proj2, *y, *xn2, *act, *outp; float* h;
    unsigned char *img_in, *img_out;
    unsigned char *img_gu, *img_dn;
    int* flag;
    unsigned* qctr;
    int* done;
};
constexpr int LDS_MISC = 256 * EST_BF16;
constexpr int LDS_TOTAL = LDS_MISC + 8192;

__device__ __forceinline__ void phase_rmsnorm(const float* __restrict__ x, const float* __restrict__ g, bf16_t* __restrict__ y, int wid) {
    int lane = lane_id(); asm volatile("" : "+v"(lane));
    for (int t = blockIdx.x * 8 + wid; t < T; t += gridDim.x * 8) {
        const float* xr = x + (size_t)t * D;
        f32x4 v[8]; float s = 0.f;
#pragma unroll
        for (int j = 0; j < 8; ++j) { v[j] = *(const f32x4*)(xr + j * 256 + lane * 4); s += v[j][0] * v[j][0] + v[j][1] * v[j][1] + v[j][2] * v[j][2] + v[j][3] * v[j][3]; }
        s = wave_sum(s);
        const float r = rsqrtf(s * (1.0f / D) + EPS);
#pragma unroll
        for (int j = 0; j < 8; ++j) {
            const f32x4 gg = *(const f32x4*)(g + j * 256 + lane * 4);
            u32x2 o; o.x = cvt_pk_bf16(v[j][0] * r * gg[0], v[j][1] * r * gg[1]); o.y = cvt_pk_bf16(v[j][2] * r * gg[2], v[j][3] * r * gg[3]);
            *(u32x2*)(y + (size_t)t * D + j * 256 + lane * 4) = o;
        }
    }
}

__device__ __forceinline__ float gelu_f(float v) {
    const float av = fabsf(v), dd = av * 0.2316418882f + 1.0f;
    const float tt = __builtin_amdgcn_rcpf(dd);
    float q = tt * 0.5307027145f + (-0.7265760135f); q = q * tt + 0.7107068705f; q = q * tt + (-0.142248368f); q = q * tt + 0.127414796f; q = q * tt;
    const float e = __builtin_amdgcn_exp2f((v * v) * (-0.72134752044f));
    const float m = v * (q * e);
    return v < 0.f ? m : v - m;
}
typedef float f32x16 __attribute__((ext_vector_type(16)));

__device__ __forceinline__ void phase_mixer(const Params& p, LAS3 char* lds, int wid) {
    int lane = lane_id(); asm volatile("" : "+v"(lane));
    const int n = lane & 31, kh = lane >> 5;
    const bf16_t* __restrict__ proj = p.proj;
    LAS3 float* stat = (LAS3 float*)(lds + 32768);
    const int nunits = (T / 128) * 16;
    for (int it = 0; it * (int)gridDim.x < nunits; ++it) {
        const int b = blockIdx.x;
        int u = it * gridDim.x + b;
        if (u >= nunits) break;
        int chunk, g;
        if ((gridDim.x & 15) == 0) { chunk = (b >> 4) + (gridDim.x >> 4) * it; g = ((b & 15) + 8 * (it & 1)) & 15; } else { chunk = u >> 4; g = u & 15; }
        const int t0 = chunk * 128;
        if (g < 8) {
            const int c = g * 128 + 2 * lane;
            const int r0 = t0 + 16 * wid;
            const bf16_t* base = proj + (size_t)r0 * DIN + c;
            const float w00 = p.conv_w[c], w01 = p.conv_w[c + 1], w10 = p.conv_w[DC + c], w11 = p.conv_w[DC + c + 1], w20 = p.conv_w[2 * DC + c], w21 = p.conv_w[2 * DC + c + 1];
            const float g0 = p.gn_conv[c], g1 = p.gn_conv[c + 1];
            const bool has_hist = ((r0 % SEQ) != 0);
            float z2a = 0.f, z2b = 0.f, z1a = 0.f, z1b = 0.f;
            if (has_hist) {
                const unsigned c2 = *(const unsigned*)(base - 2 * (ptrdiff_t)DIN + DC), h2 = *(const unsigned*)(base - 2 * (ptrdiff_t)DIN + 2 * DC);
                const unsigned c1 = *(const unsigned*)(base - (ptrdiff_t)DIN + DC), h1 = *(const unsigned*)(base - (ptrdiff_t)DIN + 2 * DC);
                z2a = bf16_lo(c2) * bf16_lo(h2); z2b = bf16_hi(c2) * bf16_hi(h2); z1a = bf16_lo(c1) * bf16_lo(h1); z1b = bf16_hi(c1) * bf16_hi(h1);
            }
#pragma unroll 1
            for (int hb = 0; hb < 16; hb += 8) {
                unsigned bg[8], cg[8], hg[8];
#pragma unroll
                for (int i = 0; i < 8; ++i) { bg[i] = *(const unsigned*)(base + (size_t)(hb + i) * DIN); cg[i] = *(const unsigned*)(base + (size_t)(hb + i) * DIN + DC); hg[i] = *(const unsigned*)(base + (size_t)(hb + i) * DIN + 2 * DC); }
#pragma unroll
                for (int i = 0; i < 8; ++i) {
                    const float z0a = bf16_lo(cg[i]) * bf16_lo(hg[i]), z0b = bf16_hi(cg[i]) * bf16_hi(hg[i]);
                    const float ya = bf16_lo(bg[i]) * (w00 * z2a + w10 * z1a + w20 * z0a);
                    const float yb = bf16_hi(bg[i]) * (w01 * z2b + w11 * z1b + w21 * z0b);
                    z2a = z1a; z2b = z1b; z1a = z0a; z1b = z0b;
                    const float ss = wave_sum(ya * ya + yb * yb);
                    const float rs = rsqrtf(ss * (1.0f / 128.0f) + EPS);
                    *(unsigned*)(p.y + (size_t)(r0 + hb + i) * D + c) = cvt_pk_bf16(ya * rs * g0, yb * rs * g1);
                }
            }
            __syncthreads(); __syncthreads(); __syncthreads();
        } else {
            const int hd = g - 8;
            {
                const int s0 = 16 * wid + 8 * kh;
                const bf16_t* vb = proj + (size_t)(t0 + s0) * DIN + 4096 + hd * 128 + 4 * n;
                const bf16_t* vb2 = p.proj2 + (size_t)(t0 + s0) * (DIN - 4096) + hd * 128 + 4 * n;
                u32x2 raw[8], raw2[8];
#pragma unroll
                for (int j = 0; j < 8; ++j) { raw[j] = *(const u32x2*)(vb + (size_t)j * DIN); raw2[j] = *(const u32x2*)(vb2 + (size_t)j * (DIN - 4096)); }
                const f32x4 lg = *(const f32x4*)(p.sgu_ln_g + hd * 128 + 4 * n), lb = *(const f32x4*)(p.sgu_ln_b + hd * 128 + 4 * n);
                float vn[8][4];
#pragma unroll
                for (int j = 0; j < 8; ++j) {
                    const float a0 = gelu_f(bf16_lo(raw[j].x) + bf16_lo(raw2[j].x)), a1 = gelu_f(bf16_hi(raw[j].x) + bf16_hi(raw2[j].x)), a2 = gelu_f(bf16_lo(raw[j].y) + bf16_lo(raw2[j].y)), a3 = gelu_f(bf16_hi(raw[j].y) + bf16_hi(raw2[j].y));
                    const float mu = half_sum32((a0 + a1) + (a2 + a3)) * (1.0f / 128.0f);
                    const float d0 = a0 - mu, d1 = a1 - mu, d2 = a2 - mu, d3 = a3 - mu;
                    const float rs = rsqrtf(half_sum32((d0 * d0 + d1 * d1) + (d2 * d2 + d3 * d3)) * (1.0f / 128.0f) + EPS);
                    vn[j][0] = d0 * rs * lg[0] + lb[0]; vn[j][1] = d1 * rs * lg[1] + lb[1]; vn[j][2] = d2 * rs * lg[2] + lb[2]; vn[j][3] = d3 * rs * lg[3] + lb[3];
                }
                __syncthreads();
#pragma unroll
                for (int c = 0; c < 4; ++c) {
                    u32x4 f; f.x = cvt_pk_bf16(vn[0][c], vn[1][c]); f.y = cvt_pk_bf16(vn[2][c], vn[3][c]); f.z = cvt_pk_bf16(vn[4][c], vn[5][c]); f.w = cvt_pk_bf16(vn[6][c], vn[7][c]);
                    *(LAS3 u32x4*)(lds + ((wid * 4 + c) * 64 + lane) * 16) = f;
                }
            }
            __syncthreads();
            {
                const int mt = wid >> 1, cp = (wid & 1) * 2;
                const int trow = 32 * mt + n;
                const float* Wr = p.sgu_w + (size_t)hd * 16384 + (size_t)trow * 128 + 8 * kh;
                f32x16 acc0, acc1;
#pragma unroll
                for (int r = 0; r < 16; ++r) { acc0[r] = 0.f; acc1[r] = 0.f; }
                for (int ks = 0; ks <= 2 * mt + 1; ++ks) {
                    const f32x4 wa = *(const f32x4*)(Wr + 16 * ks), wb = *(const f32x4*)(Wr + 16 * ks + 4);
                    const int sb = 16 * ks + 8 * kh;
                    float wv[8] = {wa[0], wa[1], wa[2], wa[3], wb[0], wb[1], wb[2], wb[3]};
#pragma unroll
                    for (int j = 0; j < 8; ++j) wv[j] = (sb + j <= trow) ? wv[j] : 0.f;
                    u32x4 af; af.x = cvt_pk_bf16(wv[0], wv[1]); af.y = cvt_pk_bf16(wv[2], wv[3]); af.z = cvt_pk_bf16(wv[4], wv[5]); af.w = cvt_pk_bf16(wv[6], wv[7]);
                    const u32x4 b0 = *(LAS3 const u32x4*)(lds + ((ks * 4 + cp) * 64 + lane) * 16);
                    const u32x4 b1 = *(LAS3 const u32x4*)(lds + ((ks * 4 + cp + 1) * 64 + lane) * 16);
                    acc0 = __builtin_amdgcn_mfma_f32_32x32x16_bf16(__builtin_bit_cast(bf16x8, af), __builtin_bit_cast(bf16x8, b0), acc0, 0, 0, 0);
                    acc1 = __builtin_amdgcn_mfma_f32_32x32x16_bf16(__builtin_bit_cast(bf16x8, af), __builtin_bit_cast(bf16x8, b1), acc1, 0, 0, 0);
                }
                const bf16_t* ub = proj + (size_t)t0 * DIN + 3072 + hd * 128 + 4 * n + cp;
                float ya[16], yb[16];
#pragma unroll
                for (int r = 0; r < 16; ++r) {
                    const int tt = 32 * mt + (r & 3) + 8 * (r >> 2) + 4 * kh;
                    const unsigned uu = *(const unsigned*)(ub + (size_t)tt * DIN);
                    const float bias = p.sgu_b[hd * 128 + tt];
                    ya[r] = gelu_f(bf16_lo(uu)) * (acc0[r] + bias);
                    yb[r] = gelu_f(bf16_hi(uu)) * (acc1[r] + bias);
                    const float ps = half_sum32(ya[r] * ya[r] + yb[r] * yb[r]);
                    if (n == 0) stat[tt * 2 + (wid & 1)] = ps;
                }
                __syncthreads();
                const float g0 = p.gn_sgu[hd * 128 + 4 * n + cp], g1 = p.gn_sgu[hd * 128 + 4 * n + cp + 1];
#pragma unroll
                for (int r = 0; r < 16; ++r) {
                    const int tt = 32 * mt + (r & 3) + 8 * (r >> 2) + 4 * kh;
                    const float rs = rsqrtf((stat[tt * 2] + stat[tt * 2 + 1]) * (1.0f / 128.0f) + EPS);
                    *(unsigned*)(p.y + (size_t)(t0 + tt) * D + DC + hd * 128 + 4 * n + cp) = cvt_pk_bf16(ya[r] * rs * g0, yb[r] * rs * g1);
                }
            }
        }
    }
}

__device__ __forceinline__ void phase_router(const Params& p, LAS3 char* lds, int wid) {
    LAS3 float* part = (LAS3 float*)lds;
    LAS3 float* ssqp = (LAS3 float*)(lds + 34816);
    LAS3 float* logit = (LAS3 float*)(lds + 36864);
    LAS3 float* rstd = (LAS3 float*)(lds + 41984);
    LAS3 int* lhist = (LAS3 int*)(lds + 42240);
    LAS3 int* gbase = (LAS3 int*)(lds + 42368);
    int lane = lane_id(); asm volatile("" : "+v"(lane));
    const int n = lane & 31, kh = lane >> 5, tid = wid * 64 + lane;
    for (int grp = blockIdx.x; grp < T / 32; grp += gridDim.x) {
        const int t0 = grp * 32;
        __syncthreads();
        if (tid < 32) lhist[tid] = 0;
        {
            const float* hrow = p.h + (size_t)(t0 + n) * D + wid * 256 + 4 * kh;
            const float* grow = p.ln_ffn_g + wid * 256 + 4 * kh;
            const float* wrow = p.w_router + (size_t)(wid * 256 + 4 * kh) * 32 + n;
            f32x16 acc;
#pragma unroll
            for (int r = 0; r < 16; ++r) acc[r] = 0.f;
            float ssq = 0.f;
#pragma unroll 1
            for (int jj = 0; jj < 32; jj += 8) {
                f32x4 hv[8], gv[8];
#pragma unroll
                for (int j = 0; j < 8; ++j) { hv[j] = *(const f32x4*)(hrow + 8 * (jj + j)); gv[j] = *(const f32x4*)(grow + 8 * (jj + j)); }
#pragma unroll
                for (int j = 0; j < 8; ++j)
#pragma unroll
                    for (int i = 0; i < 4; ++i) {
                        const float a = hv[j][i];
                        ssq += a * a;
                        const float bw = wrow[(size_t)(8 * (jj + j) + i) * 32];
                        acc = __builtin_amdgcn_mfma_f32_32x32x2f32(a * gv[j][i], bw, acc, 0, 0, 0);
                    }
            }
            ssq += xor32(ssq);
            if (kh == 0) ssqp[wid * 32 + n] = ssq;
#pragma unroll
            for (int r = 0; r < 16; ++r) part[(wid * 32 + ((r & 3) + 8 * (r >> 2) + 4 * kh)) * 33 + n] = acc[r];
        }
        __syncthreads();
        if (tid < 32) { float s = 0.f;
#pragma unroll
            for (int w = 0; w < 8; ++w) s += ssqp[w * 32 + tid];
            rstd[tid] = rsqrtf(s * (1.0f / D) + EPS); }
        __syncthreads();
#pragma unroll
        for (int i = 0; i < 2; ++i) {
            const int idx = tid + 512 * i, tk = idx >> 5, e = idx & 31;
            float s = 0.f;
#pragma unroll
            for (int w = 0; w < 8; ++w) s += part[(w * 32 + tk) * 33 + e];
            logit[tk * 33 + e] = s * rstd[tk] + p.b_router[e];
        }
        __syncthreads();
        int se[4] = {0, 0, 0, 0}, sl[4] = {0, 0, 0, 0}; float sx[4] = {0.f, 0.f, 0.f, 0.f}; float sden = 1.f;
        if (tid < 32) {
            float v0 = 0.f; sden = 0.f;
#pragma unroll
            for (int k = 0; k < 4; ++k) {
                int bi = 0; float bv = -3.0e38f;
                for (int i = 0; i < 32; ++i) { const float l = logit[tid * 33 + i]; if (l > bv) { bv = l; bi = i; } }
                logit[tid * 33 + bi] = -3.4e38f;
                if (k == 0) v0 = bv;
                sx[k] = __expf(bv - v0); sden += sx[k];
                se[k] = bi; sl[k] = atomicAdd((int*)&lhist[bi], 1);
            }
        }
        __syncthreads();
        if (tid < 32) { const int c = lhist[tid]; gbase[tid] = c ? atomicAdd(&p.cnt[tid], c) : 0; }
        __syncthreads();
        if (tid < 32) {
            const int t = t0 + tid;
            const float inv = 1.0f / sden;
#pragma unroll
            for (int k = 0; k < 4; ++k) {
                const int slot = gbase[se[k]] + sl[k];
                p.gates[t * 4 + k] = sx[k] * inv;
                p.list[se[k] * T + slot] = t * 4 + k;
                p.sel[t * 4 + k] = (se[k] << 16) | slot;
            }
        }
#pragma unroll 1
        for (int q = 0; q < 4; ++q) {
            const int tk = wid * 4 + q;
            const float r = rstd[tk];
            const float* hr = p.h + (size_t)(t0 + tk) * D;
#pragma unroll
            for (int j = 0; j < 8; ++j) {
                const f32x4 hv = *(const f32x4*)(hr + j * 256 + lane * 4), gg = *(const f32x4*)(p.ln_ffn_g + j * 256 + lane * 4);
                int o = __builtin_amdgcn_cvt_pk_fp8_f32(hv[0] * r * gg[0], hv[1] * r * gg[1], 0, false);
                o = __builtin_amdgcn_cvt_pk_fp8_f32(hv[2] * r * gg[2], hv[3] * r * gg[3], o, true);
                *(int*)((unsigned char*)p.xn2 + (size_t)(t0 + tk) * D + j * 256 + lane * 4) = o;
            }
        }
    }
}

__device__ __forceinline__ void phase_final(const Params& p, LAS3 char* lds, int wid) {
    LAS3 int* base = (LAS3 int*)(lds + LDS_MISC + 2048);
    int lane = lane_id(); asm volatile("" : "+v"(lane));
    if (wid == 0 && lane == 0) { int a = 0; for (int i = 0; i < NE; ++i) { base[i] = a; a += p.cnt[i]; } }
    __syncthreads();
    for (int t = blockIdx.x * 8 + wid; t < T; t += gridDim.x * 8) {
        float gk[4]; const unsigned char* op[4];
#pragma unroll
        for (int k = 0; k < 4; ++k) { const int s = p.sel[t * 4 + k]; gk[k] = p.gates[t * 4 + k]; op[k] = (const unsigned char*)p.outp + (size_t)(base[s >> 16] + (s & 0xffff)) * D; }
        f32x4 v[8]; float ss = 0.f;
#pragma unroll
        for (int j = 0; j < 8; ++j) {
            const int c = j * 256 + lane * 4;
            f32x4 a = *(const f32x4*)(p.h + (size_t)t * D + c);
#pragma unroll
            for (int k = 0; k < 4; ++k) { const int o = *(const int*)(op[k] + c);
                typedef float f32x2 __attribute__((ext_vector_type(2)));
                const f32x2 lo = __builtin_amdgcn_cvt_pk_f32_fp8(o, false), hi = __builtin_amdgcn_cvt_pk_f32_fp8(o, true);
                a[0] += gk[k] * lo.x; a[1] += gk[k] * lo.y; a[2] += gk[k] * hi.x; a[3] += gk[k] * hi.y; }
            v[j] = a; ss += a[0] * a[0] + a[1] * a[1] + a[2] * a[2] + a[3] * a[3];
        }
        ss = wave_sum(ss);
        const float r = rsqrtf(ss * (1.0f / D) + EPS);
#pragma unroll
        for (int j = 0; j < 8; ++j) { const int c = j * 256 + lane * 4; const f32x4 gg = *(const f32x4*)(p.ln_final_g + c);
            f32x4 o; o[0] = v[j][0] * r * gg[0]; o[1] = v[j][1] * r * gg[1]; o[2] = v[j][2] * r * gg[2]; o[3] = v[j][3] * r * gg[3];
            *(f32x4*)(p.out + (size_t)t * D + c) = o; }
    }
}

__device__ __forceinline__ void expert_span(const int* cnt, int e, int& ebase, int& ecnt, int& abase) {
    const int l = lane_id();
    const int c = (l < NE) ? cnt[l] : 0;
    ebase = __builtin_amdgcn_readfirstlane((int)wave_sum((l < e) ? (float)c : 0.0f));
    abase = 256 * __builtin_amdgcn_readfirstlane((int)wave_sum((l < e) ? (float)((c + 255) >> 8) : 0.0f));
    ecnt = __builtin_amdgcn_readlane(c, e);
}

#ifndef MOE_MERGED
#define MOE_MERGED 1
#endif
#ifndef MOE_LAG2
#define MOE_LAG2 8
#define MOE_LAG3 8
#endif
__device__ __forceinline__ int wave_imax(int v) {
#define SWZ_XORI(v, o) __builtin_amdgcn_ds_swizzle(v, ((o) << 10) | 0x1F)
    v = max(v, SWZ_XORI(v, 16)); v = max(v, SWZ_XORI(v, 8)); v = max(v, SWZ_XORI(v, 4)); v = max(v, SWZ_XORI(v, 2)); v = max(v, SWZ_XORI(v, 1));
    const int l = lane_id(); return max(v, __builtin_amdgcn_ds_bpermute((l ^ 32) << 2, v));
#undef SWZ_XORI
}
template <int EPI>
__device__ __forceinline__ int* moe_phase(const Params& p, LAS3 char* lds, int wid, int* pend_in) {
    constexpr int NCQ = (EPI == 2) ? 2 : 1, NS = NE * NCQ, NCOL = NCQ * 8, MOE_LAG = (EPI == 2) ? MOE_LAG2 : MOE_LAG3;
    unsigned* qctr = p.qctr + ((EPI == 2) ? 0 : 8);
    LAS3 unsigned* slot = (LAS3 unsigned*)(lds + LDS_MISC + 64);
    constexpr int NSL = NS + MOE_LAG;
    LAS3 int* pre = (LAS3 int*)(lds + LDS_MISC + 4096);
    LAS3 int* mtv = (LAS3 int*)(lds + LDS_MISC + 768);
    static_assert(NSL + 1 <= 128, "prefix table size");
    __syncthreads();
    LAS3 int* xcnt = (LAS3 int*)(lds + LDS_MISC + 1024);
    { const int t0 = wid * 64 + lane_id(); if (t0 < NE) { const int c = p.cnt[t0]; mtv[t0] = (c + 255) >> 8; xcnt[t0] = c; } }
    __syncthreads();
    { const int t0 = wid * 64 + lane_id(); if (t0 == 8) { int a = 0, b = 0; for (int i = 0; i < NE; ++i) { const int c = xcnt[i]; xcnt[32 + i] = a; xcnt[64 + i] = b; a += c; b += 256 * ((c + 255) >> 8); } } }
    { const int t0 = wid * 64 + lane_id();
      if (t0 < 8) { int a = 0; LAS3 int* pq = pre + t0 * 128;
          for (int s = 0; s <= NSL; ++s) { pq[s] = a;
              if (s < NSL) { int nv = (s < NS && mtv[t0 + 8 * (s / NCOL)] > 0) ? 1 : 0; const int sc = s - MOE_LAG;
                  if (EPI == 2 && s < MOE_LAG3 && mtv[t0 + 8 * (s >> 3)] > 0) nv += 1;
                  if (sc >= 0 && sc < NS) nv += mtv[t0 + 8 * (sc / NCOL)];
                  a += nv; } } } }
    __syncthreads();
    const int q0 = (int)(xb_xcc_id() & 7u);
    GemmArgs g{};
    if (EPI == 2) { g.A = p.xn2; g.B = p.w_gate_up; g.C = p.act; g.bias = p.b_gate_up; g.list = p.list; }
    else { g.A = p.act; g.B = p.w_down; g.C = p.outp; g.bias = p.b_down; }
    __syncthreads();
    { const int t0 = wid * 64 + lane_id(); if (t0 == 0) { unsigned c0 = inc_early(&qctr[q0]); LD_WAIT(c0); slot[0] = ((unsigned)q0 << 20) | c0; } }
    int* pend = pend_in;
    int par = 0;
    for (;;) {
        __syncthreads();
        const unsigned code = (unsigned)__builtin_amdgcn_readfirstlane((int)slot[par]);
        if (code == 0xFFFFFFFFu) break;
        const int qq = (int)(code >> 20), i = (int)(code & 0xFFFFFu);
        bool ran = false;
        LAS3 int* pq = pre + qq * 128;
        const int total = __builtin_amdgcn_readfirstlane(pq[NSL]);
        if (i < total) {
            int s, j;
            { const int l = lane_id();
              const bool c1 = (l + 1 <= NSL) && (pq[(l + 1 <= NSL) ? l + 1 : 0] <= i), c2 = (l + 65 <= NSL) && (pq[(l + 65 <= NSL) ? l + 65 : 0] <= i);
              s = __builtin_popcountll(__builtin_amdgcn_ballot_w64(c1)) + __builtin_popcountll(__builtin_amdgcn_ballot_w64(c2));
              j = i - __builtin_amdgcn_readfirstlane(pq[s]); }
            const bool hasP = (s < NS) && (__builtin_amdgcn_readfirstlane(mtv[qq + 8 * ((s < NS) ? s / NCOL : 0)]) > 0);
            const bool conv = hasP && j == 0;
            const bool hasX = (EPI == 2) && (s < MOE_LAG3) && (__builtin_amdgcn_readfirstlane(mtv[qq + 8 * ((s < MOE_LAG3) ? (s >> 3) : 0)]) > 0);
            const bool xconv = hasX && j == (hasP ? 1 : 0);
            const int k = conv ? 0 : j - (hasP ? 1 : 0) - (hasX ? 1 : 0);
            const int sl = conv ? s : s - MOE_LAG;
            if (xconv) {
                const int e = qq + 8 * (s >> 3), pn = s & 7;
                convert_image<D>(p.w_down + (size_t)e * DFF * D, pn * 256, pn * 256 + 128, p.img_dn + (size_t)(e * 8 + pn) * 524288, lds, wid);
                const int t0 = wid * 64 + lane_id();
                if (t0 == 0) { __hip_atomic_store(p.flag + NE * 16 + e * 8 + pn, 1, __ATOMIC_RELAXED, __HIP_MEMORY_SCOPE_AGENT); unsigned c0 = inc_early(&qctr[qq]); LD_WAIT(c0); slot[par ^ 1] = ((unsigned)qq << 20) | c0; }
                ran = true;
            } else if (sl >= 0 && sl < NS) {
                const int e = qq + 8 * (sl / NCOL), pn = sl % NCOL;
                const int ecnt = __builtin_amdgcn_readfirstlane(xcnt[e]), ebase = __builtin_amdgcn_readfirstlane(xcnt[32 + e]), abase = __builtin_amdgcn_readfirstlane(xcnt[64 + e]); g.abase = abase;
                if (k < ((ecnt + 255) >> 8)) {
                    TileSync sy{}; sy.flag = p.flag + ((EPI == 2) ? 0 : NE * 16) + e * NCOL + pn; sy.qctr = qctr + qq; sy.qtag = (unsigned)qq << 20; sy.qslot = slot + (par ^ 1);
                    if (MOE_MERGED) { sy.pend = pend; if (EPI == 3) { sy.dep = p.done + e * 32 + k; sy.depn = 16; } }
                    unsigned char* img = ((EPI == 2) ? p.img_gu : p.img_dn) + (size_t)(e * NCOL + pn) * 524288;
                    if (conv) {
                        const bool have = (EPI == 3) && (__builtin_amdgcn_readfirstlane(ld_now(sy.flag)) != 0);
                        if (have) { }
                        else if (EPI == 2) convert_image<2 * DFF>(p.w_gate_up + (size_t)e * D * (2 * DFF), pn * 128, DFF + pn * 128, img, lds, wid);
                        else convert_image<D>(p.w_down + (size_t)e * DFF * D, pn * 256, pn * 256 + 128, img, lds, wid);
                        const int t0 = wid * 64 + lane_id();
                        if (t0 == 0) { __hip_atomic_store(sy.flag, 1, __ATOMIC_RELAXED, __HIP_MEMORY_SCOPE_AGENT); unsigned c0 = inc_early(&qctr[qq]); LD_WAIT(c0); slot[par ^ 1] = ((unsigned)qq << 20) | c0; }
                    } else {
                        gemm_tile_img<EPI>(g, k, pn, e, ebase, ecnt, lds, wid, img, sy);
                        pend = (MOE_MERGED && EPI == 2) ? p.done + e * 32 + k : nullptr;
                    }
                    ran = true;
                }
            }
            if (!ran) { const int t0 = wid * 64 + lane_id();
                if (t0 == 0) { unsigned c0 = inc_early(&qctr[qq]); LD_WAIT(c0); slot[par ^ 1] = ((unsigned)qq << 20) | c0; } }
        } else {
            const int t0 = wid * 64 + lane_id();
            if (t0 == 0) { unsigned cv[8];
                unsigned qx; asm volatile("s_getreg_b32 %0, hwreg(HW_REG_XCC_ID, 0, 3)" : "=s"(qx));
#pragma unroll
                for (int d = 0; d < 8; ++d) cv[d] = (unsigned)ld_early((const int*)&qctr[(qx + d) & 7u]);
#pragma unroll
                for (int d = 0; d < 8; ++d) LD_WAIT(cv[d]);
                unsigned c = 0xFFFFFFFFu;
#pragma unroll
                for (int d = 7; d >= 0; --d) if (cv[d] < (unsigned)pre[((qx + d) & 7u) * 128 + NSL]) c = (qx + d) & 7u;
                if (c != 0xFFFFFFFFu) { const unsigned cq = (unsigned)__builtin_amdgcn_readfirstlane((int)c); unsigned c0 = inc_early(&qctr[cq]); LD_WAIT(c0); c = (cq << 20) | c0; }
                slot[par ^ 1] = c; }
        }
        par ^= 1;
    }
    return pend;
}

__global__ void __launch_bounds__(512, 2) k_mega(Params p) {
    extern __shared__ __attribute__((aligned(16))) char smem[];
    LAS3 char* lds = (LAS3 char*)smem;
    volatile LAS unsigned* xbw = (volatile LAS unsigned*)(lds + LDS_MISC);
    int wid = __builtin_amdgcn_readfirstlane((int)(threadIdx.x >> 6)); asm volatile("" : "+s"(wid));
    const int tid0 = wid * 64 + lane_id();
    if (tid0 == 0) { xbw[0] = 0u; xbw[1] = 0u; xbw[2] = 0u; xbw[3] = 0u; }
    __syncthreads();
    XcdBarrier bar = xcd_barrier_post(p.bar, xbw, tid0);
    const int nb = gridDim.x;
    const int vb = ((nb & 7) == 0) ? (int)(blockIdx.x & 7) * (nb >> 3) + (int)(blockIdx.x >> 3) : (int)blockIdx.x;

    if (blockIdx.x == 0 && tid0 < NE) p.cnt[tid0] = 0;
    phase_rmsnorm(p.x, p.ln_mix_g, p.xn, wid);
    for (int it = vb; it < 28 * 16; it += nb) {
        const int tile = it >> 4, kq = it & 15;
        if (tile < 20) convert_tile<false, DIN>(p.w_in + (size_t)kq * 128 * DIN, tile * 256, tile * 256 + 128, 2, p.img_in + (size_t)tile * 1048576 + (size_t)kq * 2 * 32768, lds, wid);
        else convert_tile<false, D>(p.w_out + (size_t)kq * 128 * D, (tile - 20) * 256, (tile - 20) * 256 + 128, 2, p.img_out + (size_t)(tile - 20) * 1048576 + (size_t)kq * 2 * 32768, lds, wid);
    }
    xcd_barrier(bar, wid * 64 + lane_id());
    { GemmArgs g{}; g.A = p.xn; g.C = p.proj; g.R = (const float*)p.proj2;
      for (int u = vb; u < 32 * 16 + 256; u += nb) {
          int pm, pn, kh = -1;
          if (nb == 256) { const int r = u >> 8, x = (u >> 5) & 7, j = u & 31; pm = 8 * (x & 3) + (j & 7);
              if (u < 32 * 16) pn = 8 * r + 4 * (x >> 2) + (j >> 3); else { pn = 16 + (j >> 3); kh = x >> 2; } }
          else if (u < 32 * 16) { pm = u & 31; pn = u >> 5; }
          else { const int v = u - 32 * 16; pn = 16 + (v >> 6); pm = v & 31; kh = (v >> 5) & 1; }
          gemm_tile_img<0>(g, pm, pn, 0, 0, T, lds, wid, p.img_in + (size_t)pn * 1048576, TileSync{}, kh); } }
    xcd_barrier(bar, wid * 64 + lane_id());
    phase_mixer(p, lds, wid);
    xcd_barrier(bar, wid * 64 + lane_id());
    { GemmArgs g{}; g.A = p.y; g.C = p.h; g.R = p.x;
      for (int u = vb; u < 32 * 8; u += nb) { int pm = u & 31, pn = u >> 5;
          if (nb == 256) { const int x = (u >> 5) & 7, j = u & 31; pm = 8 * (x & 3) + (j & 7); pn = 4 * (x >> 2) + (j >> 3); }
          gemm_tile_img<1>(g, pm, pn, 0, 0, T, lds, wid, p.img_out + (size_t)pn * 1048576, TileSync{}); } }
    xcd_barrier(bar, wid * 64 + lane_id());
    phase_router(p, lds, wid);
    xcd_barrier(bar, wid * 64 + lane_id());
    { int* pend = moe_phase<2>(p, lds, wid, nullptr);
      if (pend) {
          asm volatile("s_waitcnt vmcnt(0)" ::: "memory"); __syncthreads();
          const int t0 = wid * 64 + lane_id(); if (t0 == 0) __hip_atomic_fetch_add(pend, 1, __ATOMIC_RELAXED, __HIP_MEMORY_SCOPE_AGENT); }
      if (!MOE_MERGED) xcd_barrier(bar, wid * 64 + lane_id());
      (void)moe_phase<3>(p, lds, wid, nullptr); }
    xcd_barrier(bar, wid * 64 + lane_id());
    phase_final(p, lds, wid);
}
}

extern "C" void kernel_launch(void* const* d_in, const int* in_sizes, int n_in, void* d_out, int out_size, void* d_ws, size_t ws_size,
                              hipStream_t stream) {
    Params p{};
    p.x = (const float*)d_in[0]; p.ln_mix_g = (const float*)d_in[1]; p.w_in = (const float*)d_in[2]; p.conv_w = (const float*)d_in[3];
    p.sgu_ln_g = (const float*)d_in[4]; p.sgu_ln_b = (const float*)d_in[5]; p.sgu_w = (const float*)d_in[6]; p.sgu_b = (const float*)d_in[7];
    p.gn_conv = (const float*)d_in[8]; p.gn_sgu = (const float*)d_in[9]; p.w_out = (const float*)d_in[10]; p.ln_ffn_g = (const float*)d_in[11];
    p.w_router = (const float*)d_in[12]; p.b_router = (const float*)d_in[13]; p.w_gate_up = (const float*)d_in[14]; p.b_gate_up = (const float*)d_in[15];
    p.w_down = (const float*)d_in[16]; p.b_down = (const float*)d_in[17]; p.ln_final_g = (const float*)d_in[18];
    p.out = (float*)d_out;

    char* ws = (char*)d_ws;
    size_t off = 0;
    auto take = [&](size_t bytes) { char* q = ws + off; off += (bytes + 255) & ~(size_t)255; return q; };
    constexpr int SYNC_WORDS = XCD_BAR_WORDS + NE * 24 + 64 + NE * 32;
    p.bar = (unsigned*)take(SYNC_WORDS * 4);
    p.flag = (int*)(p.bar + XCD_BAR_WORDS); p.qctr = p.bar + XCD_BAR_WORDS + NE * 24; p.done = (int*)(p.bar + XCD_BAR_WORDS + NE * 24 + 64);
    p.cnt = (int*)take(256);
    p.list = (int*)take((size_t)NE * T * 4);
    p.sel = (int*)take((size_t)NPAIR * 4);
    p.gates = (float*)take((size_t)NPAIR * 4);
    p.xn = (bf16_t*)take((size_t)T * D * 2);
    p.proj = (bf16_t*)take((size_t)T * DIN * 2);
    p.proj2 = (bf16_t*)take((size_t)T * (DIN - 4096) * 2);
    p.y = (bf16_t*)take((size_t)T * D * 2);
    p.h = (float*)take((size_t)T * D * 4);
    p.xn2 = (bf16_t*)take((size_t)T * D * 2);
    p.act = (bf16_t*)take((size_t)(ACT_ROWS + NE * 256) * DFF * 2);
    p.outp = (bf16_t*)take((size_t)ACT_ROWS * D * 2);
    p.img_in = (unsigned char*)take((size_t)20 * 1048576);
    p.img_out = (unsigned char*)take((size_t)8 * 1048576);
    p.img_gu = (unsigned char*)take((size_t)NE * 16 * 524288);
    p.img_dn = (unsigned char*)take((size_t)NE * 8 * 524288);
    if (off > ws_size) { fprintf(stderr, "workspace too small: need %zu have %zu\n", off, ws_size); return; }

    static int grid = 0;
    if (!grid) {
        int dev = 0, cus = 0, per_cu = 0;
        (void)hipGetDevice(&dev);
        (void)hipDeviceGetAttribute(&cus, hipDeviceAttributeMultiprocessorCount, dev);
        (void)hipFuncSetAttribute((const void*)k_mega, hipFuncAttributeMaxDynamicSharedMemorySize, LDS_TOTAL);
        (void)hipOccupancyMaxActiveBlocksPerMultiprocessor(&per_cu, (const void*)k_mega, 512, LDS_TOTAL);
        if (per_cu < 1) { fprintf(stderr, "occupancy query says 0 blocks per CU\n"); per_cu = 1; }
        grid = cus * 1;
    }
    (void)hipMemsetAsync(p.bar, 0, SYNC_WORDS * 4, stream);
    k_mega<<<grid, 512, LDS_TOTAL, stream>>>(p);
}
```
